# Optimizing an MI355X kernel written in HIP

```python
import jax, jax.numpy as jnp
from jax import lax
import numpy as np

D_MODEL = 1024
BATCH = 1
SEQ = 16384
DEPTH = 4

N_MIXERS = 2
N_HEADS = 16
HEAD_DIM = D_MODEL // N_HEADS
MOBA_BLOCK = 256
MOBA_TOPK = 3
Q_CHUNK = 128
POOL_WINDOWS = (2, 4, 8, 16)
N_POOL_GROUPS = len(POOL_WINDOWS)
POOL_GROUP_DIM = D_MODEL // N_POOL_GROUPS
D_FF = ((8 * D_MODEL // 3 + 127) // 128) * 128
N_ATTN_LAYERS = (DEPTH + N_MIXERS - 1) // N_MIXERS
N_POOL_LAYERS = DEPTH // N_MIXERS
EPS = 1e-6
NEG = -1e30

kernel_name = "hybrid_moba_pool_macaron"


def rmsnorm(x, g):
    xf = x.astype(jnp.float32)
    y = xf * lax.rsqrt(jnp.mean(xf * xf, axis=-1, keepdims=True) + EPS)
    return (y * g.astype(jnp.float32)).astype(x.dtype)


def swiglu(h, w_gate, w_up, w_down):
    return (jax.nn.silu(h @ w_gate) * (h @ w_up)) @ w_down


def alibi_slopes(n_heads):
    return jnp.exp2(-8.0 * jnp.arange(1, n_heads + 1, dtype=jnp.float32) / n_heads)


def moba_attention(h, w_qkv, w_o):
    B, S, D = h.shape
    H, dh, BS = N_HEADS, HEAD_DIM, MOBA_BLOCK
    qkv = h @ w_qkv
    q, k, v = jnp.split(qkv, 3, axis=-1)
    q = q.reshape(B, S, H, dh).astype(jnp.float32) * (dh ** -0.5)
    k = k.reshape(B, S, H, dh).astype(jnp.float32)
    v = v.reshape(B, S, H, dh).astype(jnp.float32)
    nb = -(-S // BS)
    pad = nb * BS - S
    k_pad = jnp.pad(k, ((0, 0), (0, pad), (0, 0), (0, 0)))
    v_pad = jnp.pad(v, ((0, 0), (0, pad), (0, 0), (0, 0)))
    k_blk = k_pad.reshape(B, nb, BS, H, dh).transpose(0, 3, 1, 2, 4)
    v_blk = v_pad.reshape(B, nb, BS, H, dh).transpose(0, 3, 1, 2, 4)
    k_mean = jnp.mean(k_blk, axis=3)
    slopes = alibi_slopes(H)
    n_sel = min(MOBA_TOPK, nb)
    b_ix = jnp.arange(B)[:, None, None, None]
    h_ix = jnp.arange(H)[None, None, :, None]

    def chunk(ci):
        t0 = ci * Q_CHUNK
        qc = lax.dynamic_slice_in_dim(q, t0, Q_CHUNK, axis=1)
        tpos = t0 + jnp.arange(Q_CHUNK, dtype=jnp.int32)
        j = t0 // BS
        gate = jnp.einsum('bchd,bhnd->bchn', qc, k_mean)
        gate = jnp.where(jnp.arange(nb) < j, gate, NEG)
        _, sel = lax.top_k(gate, n_sel)
        valid = jnp.arange(n_sel) < j
        kg = k_blk[b_ix, h_ix, sel]
        vg = v_blk[b_ix, h_ix, sel]
        kpos_sel = sel[..., None] * BS + jnp.arange(BS, dtype=jnp.int32)
        dist_sel = (tpos[None, :, None, None, None] - kpos_sel).astype(jnp.float32)
        s_sel = jnp.einsum('bchd,bchksd->bchks', qc, kg)
        s_sel = s_sel - slopes[None, None, :, None, None] * dist_sel
        s_sel = jnp.where(valid[None, None, None, :, None], s_sel, NEG)
        k_own = lax.dynamic_slice_in_dim(k_pad, j * BS, BS, axis=1)
        v_own = lax.dynamic_slice_in_dim(v_pad, j * BS, BS, axis=1)
        kpos_own = j * BS + jnp.arange(BS, dtype=jnp.int32)
        dist_own = tpos[:, None] - kpos_own[None, :]
        s_own = jnp.einsum('bchd,bshd->bchs', qc, k_own)
        s_own = s_own - slopes[None, None, :, None] * dist_own.astype(jnp.float32)[None, :, None, :]
        s_own = jnp.where((dist_own >= 0)[None, :, None, :], s_own, NEG)
        scores = jnp.concatenate([s_sel.reshape(B, Q_CHUNK, H, n_sel * BS), s_own], axis=-1)
        p = jax.nn.softmax(scores, axis=-1)
        p_sel = p[..., :n_sel * BS].reshape(B, Q_CHUNK, H, n_sel, BS)
        o = (jnp.einsum('bchks,bchksd->bchd', p_sel, vg)
             + jnp.einsum('bchs,bshd->bchd', p[..., n_sel * BS:], v_own))
        return o

    outs = lax.map(chunk, jnp.arange(S // Q_CHUNK, dtype=jnp.int32))
    o = outs.transpose(1, 0, 2, 3, 4).reshape(B, S, D).astype(h.dtype)
    return o @ w_o


def pool_mixer(h, w_pool, scale):
    B, S, D = h.shape
    G = POOL_GROUP_DIM
    hf = h.astype(jnp.float32)
    csum = jnp.concatenate([jnp.zeros((B, 1, D), jnp.float32), lax.cumsum(hf, axis=1)], axis=1)
    t = jnp.arange(S, dtype=jnp.int32)
    groups = []
    for g, w in enumerate(POOL_WINDOWS):
        c = csum[:, :, g * G:(g + 1) * G]
        lo = jnp.maximum(t + 1 - w, 0)
        win_sum = c[:, 1:] - c[:, lo]
        cnt = jnp.minimum(t + 1, w).astype(jnp.float32)
        groups.append(win_sum / cnt[None, :, None] - hf[:, :, g * G:(g + 1) * G])
    y = jnp.stack(groups, axis=2).astype(h.dtype)
    y = jnp.einsum('bsgc,gce->bsge', y, w_pool).reshape(B, S, D)
    return y * scale


def setup_inputs(seed: int = 0) -> dict:
    key = jax.random.key(seed)
    ks = jax.random.split(key, 11)
    f32 = jnp.float32
    x = jax.random.normal(ks[0], (BATCH, SEQ, D_MODEL), f32)
    ln_gains = 1.0 + 0.02 * jax.random.normal(ks[1], (DEPTH, 3, D_MODEL), f32)
    ffn_w_gate = jax.random.normal(ks[2], (DEPTH, 2, D_MODEL, D_FF), f32) * D_MODEL ** -0.5
    ffn_w_up = jax.random.normal(ks[3], (DEPTH, 2, D_MODEL, D_FF), f32) * D_MODEL ** -0.5
    ffn_w_down = jax.random.normal(ks[4], (DEPTH, 2, D_FF, D_MODEL), f32) * D_FF ** -0.5
    attn_w_qkv = jax.random.normal(ks[5], (N_ATTN_LAYERS, D_MODEL, 3 * D_MODEL), f32) * D_MODEL ** -0.5
    attn_w_o = jax.random.normal(ks[6], (N_ATTN_LAYERS, D_MODEL, D_MODEL), f32) * D_MODEL ** -0.5
    pool_w = jax.random.normal(ks[7], (N_POOL_LAYERS, N_POOL_GROUPS, POOL_GROUP_DIM, POOL_GROUP_DIM), f32) * POOL_GROUP_DIM ** -0.5
    pool_scale = 1.0 + 0.1 * jax.random.normal(ks[8], (N_POOL_LAYERS, D_MODEL), f32)
    final_gain = 1.0 + 0.02 * jax.random.normal(ks[9], (D_MODEL,), f32)
    return {"x": x, "ln_gains": ln_gains, "ffn_w_gate": ffn_w_gate, "ffn_w_up": ffn_w_up,
            "ffn_w_down": ffn_w_down, "attn_w_qkv": attn_w_qkv, "attn_w_o": attn_w_o,
            "pool_w": pool_w, "pool_scale": pool_scale, "final_gain": final_gain}


def reference(x, ln_gains, ffn_w_gate, ffn_w_up, ffn_w_down, attn_w_qkv, attn_w_o, pool_w, pool_scale, final_gain):
    for i in range(DEPTH):
        h = rmsnorm(x, ln_gains[i, 0])
        x = x + 0.5 * swiglu(h, ffn_w_gate[i, 0], ffn_w_up[i, 0], ffn_w_down[i, 0])
        h = rmsnorm(x, ln_gains[i, 1])
        m = i // N_MIXERS
        if i % N_MIXERS == 0:
            x = x + moba_attention(h, attn_w_qkv[m], attn_w_o[m])
        else:
            x = x + pool_mixer(h, pool_w[m], pool_scale[m])
        h = rmsnorm(x, ln_gains[i, 2])
        x = x + 0.5 * swiglu(h, ffn_w_gate[i, 1], ffn_w_up[i, 1], ffn_w_down[i, 1])
    return rmsnorm(x, final_gain)
```

```cpp
#include <hip/hip_runtime.h>
#include <cstdio>
#include <cstdint>
#include <type_traits>
__device__ __forceinline__ float shx(float v, int mask, int lane) { return __builtin_bit_cast(float, __builtin_amdgcn_ds_bpermute((lane ^ mask) << 2, __builtin_bit_cast(int, v))); }
__device__ __forceinline__ unsigned shxu(unsigned v, int mask, int lane) { return (unsigned)__builtin_amdgcn_ds_bpermute((lane ^ mask) << 2, (int)v); }
__device__ __forceinline__ int shi(int v, int src) { return __builtin_amdgcn_ds_bpermute(src << 2, v); }
__device__ __forceinline__ int mk_lane() { int l; asm volatile("v_mbcnt_lo_u32_b32 %0, -1, 0\n\tv_mbcnt_hi_u32_b32 %0, -1, %0" : "=v"(l)); return l; }
namespace pg8 {
#define PG8_LAS __attribute__((address_space(3)))
typedef unsigned short bf16_t;
typedef short bf16x8 __attribute__((ext_vector_type(8)));
typedef float f32x4 __attribute__((ext_vector_type(4)));
typedef unsigned u32x4 __attribute__((ext_vector_type(4)));
constexpr int BM = 256, BK = 64, HALF = 128, HTB = HALF * BK * 2  , STAGE_BYTES = 8 * HTB, NXCD = 8, WGM = 8;

__host__ __device__ __forceinline__ int lds_byte(int r, int c) { const int st = (r >> 4) * 2 + (c >> 5), rr = r & 15, cc = c & 31, ob = rr * 64 + cc * 2; return st * 1024 + (ob ^ (((ob >> 9) & 1) << 5)); }
__host__ __device__ __forceinline__ void stage_rc(int b, int& R, int& C) { const int st = b / 1024, sb = b % 1024, swz = sb ^ (((sb >> 9) & 1) << 5); R = (st >> 1) * 16 + swz / 64; C = (st & 1) * 32 + (swz % 64) / 2; }
__host__ __device__ __forceinline__ int perm32(int rho) { const int n = rho >> 4, i = rho & 15; return 8 * (i >> 2) + 4 * n + (i & 3); }

struct Unit { int pm, pn, idx; };
struct Gemm { const bf16_t* A; const bf16_t* Bt; int M, N, K; };

struct StaticOrder {
    int nM, nN, nwg, G, c;
    __host__ __device__ void init(int M, int N, int G_, int c_) { nM = M / BM; nN = N / BM; nwg = nM * nN; G = G_; c = c_; }
    __host__ __device__ bool next(int i, Unit& u) const {
        const long L = (long)i * G + c; if (L >= nwg) return false;
        int wgid = (int)L; { const int q = nwg / NXCD, r = nwg % NXCD, xcd = wgid % NXCD, off = wgid / NXCD; wgid = (xcd < r ? xcd * (q + 1) : r * (q + 1) + (xcd - r) * q) + off; }
        const int nig = WGM * nN, gid = wgid / nig, fm = gid * WGM, gsz = (nM - fm) < WGM ? (nM - fm) : WGM;
        u.pm = fm + ((wgid % nig) % gsz); u.pn = (wgid % nig) / gsz; u.idx = i; return true;
    }
    __device__ __forceinline__ void a_ready(const Unit&) const {}
    __device__ __forceinline__ void done(const Unit&) const {}
};

__device__ __forceinline__ unsigned cvt_pk_bf16(float lo, float hi) { unsigned r; asm volatile("v_cvt_pk_bf16_f32 %0, %1, %2" : "=v"(r) : "v"(lo), "v"(hi)); return r; }
typedef float f32x2 __attribute__((ext_vector_type(2)));
template <class Epi, class Sched, bool ALIGN_EPI = false, bool SP2 = false>
__device__ __forceinline__ void gemm_phase(PG8_LAS unsigned char* lds, const Gemm g, const Sched& S, const Epi& E, const int wave0) {
    int tid_ = wave0 * 64 + mk_lane(); asm volatile("" : "+v"(tid_));
    const int tid = tid_, wid = __builtin_amdgcn_readfirstlane(tid >> 6), lane = tid & 63, wr = wid >> 2, wc = wid & 3, fr = lane & 15, fq = lane >> 4;
    const int K = g.K, nt = K / BK;
    unsigned voffA[2], voffB[2];
#pragma unroll
    for (int i = 0; i < 2; ++i) { int R, C; stage_rc(tid * 16 + i * 8192, R, C); const int Rb = Epi::PERM ? ((R & ~31) + perm32(R & 31)) : R;
        voffA[i] = (unsigned)(R * K + C) * 2u; voffB[i] = (unsigned)(Rb * K + C) * 2u; }
    const size_t kstep = (size_t)(BK * 2);
    const size_t hstep = (size_t)HALF * K * 2;
    const size_t tstep = 2 * hstep;
    const unsigned ldsw = (unsigned)wid * 1024u;
    const int aoff = lds_byte(wr * 64 + fr, fq * 8), boff = lds_byte(wc * 32 + fr, fq * 8);
#define PG8_SA(b, h) (((b) * 2 + (h)) * HTB)
#define PG8_SB(b, h) ((4 + (b) * 2 + (h)) * HTB)
#define PG8_STAGE(bufoff, gbase, voff) do { _Pragma("unroll") for (int _i = 0; _i < 2; ++_i) \
        __builtin_amdgcn_global_load_lds((const unsigned*)((const char*)(gbase) + (voff)[_i]), (PG8_LAS unsigned*)(lds + (bufoff) + ldsw + _i * 8192), 16, 0, 0); } while (0)
#define PG8_LDA(dst, b, h) do { _Pragma("unroll") for (int m = 0; m < 4; ++m) _Pragma("unroll") for (int k = 0; k < 2; ++k) dst[m][k] = *(const PG8_LAS bf16x8*)(lds + PG8_SA(b, h) + aoff + m * 2048 + k * 1024); } while (0)
#define PG8_LDB(dst, b, h) do { _Pragma("unroll") for (int n = 0; n < 2; ++n) _Pragma("unroll") for (int k = 0; k < 2; ++k) dst[n][k] = *(const PG8_LAS bf16x8*)(lds + PG8_SB(b, h) + boff + n * 2048 + k * 1024); } while (0)
#define PG8_MMA(ai, bj, At, Bt) do { __builtin_amdgcn_s_setprio(1); _Pragma("unroll") for (int m = 0; m < 4; ++m) _Pragma("unroll") for (int n = 0; n < 2; ++n) _Pragma("unroll") for (int k = 0; k < 2; ++k) \
        acc[ai][bj][m][n] = __builtin_amdgcn_mfma_f32_16x16x32_bf16(Bt[n][k], At[m][k], acc[ai][bj][m][n], 0, 0, 0); __builtin_amdgcn_s_setprio(0); } while (0)
#define PG8_WAIT_V(n) asm volatile("s_waitcnt vmcnt(" #n ")" ::: "memory")
#define PG8_WAIT_L(n) asm volatile("s_waitcnt lgkmcnt(" #n ")" ::: "memory")
#define PG8_BAR __builtin_amdgcn_s_barrier()
#define PG8_SCHED __builtin_amdgcn_sched_barrier(0)
    Unit cur, nxt; int ui = 0;
    if (!S.next(0, cur)) return;
    f32x4 acc[2][2][4][2];
    typename Epi::Pre pre;
    if constexpr (Epi::PRELOAD) E.pre_issue(pre, cur, wr, wc, fr, fq);
    else {
#pragma unroll
    for (int a = 0; a < 2; ++a)
#pragma unroll
        for (int b = 0; b < 2; ++b)
#pragma unroll
            for (int m = 0; m < 4; ++m)
#pragma unroll
                for (int n = 0; n < 2; ++n) acc[a][b][m][n] = (f32x4){0.f, 0.f, 0.f, 0.f};
    }
    bf16x8 At[4][2], B0[2][2], B1[2][2];
    const char* cA = (const char*)g.A + (size_t)cur.pm * tstep; const char* cB = (const char*)g.Bt + (size_t)cur.pn * tstep;
    S.a_ready(cur);
    if constexpr (SP2) {
        PG8_STAGE(PG8_SB(0, 0), cB, voffB); PG8_STAGE(PG8_SB(0, 1), cB + hstep, voffB); PG8_STAGE(PG8_SA(0, 0), cA, voffA); PG8_STAGE(PG8_SA(0, 1), cA + hstep, voffA);
        if constexpr (Epi::PRELOAD) E.pre_finish(acc, pre);
        if (wr == 1) PG8_BAR;
        PG8_WAIT_V(2); PG8_BAR;
        PG8_STAGE(PG8_SB(1, 0), cB + kstep, voffB); PG8_STAGE(PG8_SA(1, 0), cA + kstep, voffA); PG8_STAGE(PG8_SB(1, 1), cB + hstep + kstep, voffB);
        PG8_WAIT_V(6); PG8_BAR;
    } else {
        PG8_STAGE(PG8_SB(0, 0), cB, voffB); PG8_STAGE(PG8_SA(0, 0), cA, voffA); PG8_STAGE(PG8_SB(0, 1), cB + hstep, voffB); PG8_STAGE(PG8_SA(0, 1), cA + hstep, voffA);
        if constexpr (Epi::PRELOAD) E.pre_finish(acc, pre);
        if (wr == 1) PG8_BAR;
        PG8_WAIT_V(4); PG8_BAR;
        PG8_STAGE(PG8_SB(1, 0), cB + kstep, voffB); PG8_STAGE(PG8_SA(1, 0), cA + kstep, voffA); PG8_STAGE(PG8_SB(1, 1), cB + hstep + kstep, voffB);
        PG8_WAIT_V(6); PG8_BAR;
    }
    for (;;) {
        const bool has_next = S.next(ui + 1, nxt);
        const char* nA = has_next ? (const char*)g.A + (size_t)nxt.pm * tstep : cA; const char* nB = has_next ? (const char*)g.Bt + (size_t)nxt.pn * tstep : cB;
        for (int t = 0; t < nt; t += 2) {
            const bool last = (t == nt - 2);
            const char* a1 = cA + (size_t)(t + 1) * kstep;
            const char* a2 = last ? nA : cA + (size_t)(t + 2) * kstep; const char* b2 = last ? nB : cB + (size_t)(t + 2) * kstep;
            const char* a3 = a2 + kstep; const char* b3 = b2 + kstep;
            if (last && has_next) S.a_ready(nxt);
            if constexpr (SP2) {
            PG8_STAGE(PG8_SA(1, 1), a1 + hstep, voffA); PG8_SCHED; PG8_LDB(B0, 0, 0); PG8_LDB(B1, 0, 1); PG8_SCHED; PG8_LDA(At, 0, 0);
            PG8_WAIT_V(8); PG8_WAIT_L(0); PG8_BAR; PG8_MMA(0, 0, At, B0); PG8_MMA(0, 1, At, B1); PG8_BAR; PG8_SCHED;
            PG8_STAGE(PG8_SB(0, 0), b2, voffB); PG8_STAGE(PG8_SB(0, 1), b2 + hstep, voffB); PG8_STAGE(PG8_SA(0, 0), a2, voffA); PG8_SCHED; PG8_LDA(At, 0, 1);
            PG8_WAIT_V(8); PG8_WAIT_L(0); PG8_BAR; PG8_MMA(1, 0, At, B0); PG8_MMA(1, 1, At, B1); PG8_BAR; PG8_SCHED;
            PG8_STAGE(PG8_SA(0, 1), a2 + hstep, voffA); PG8_SCHED; PG8_LDB(B0, 1, 0); PG8_LDB(B1, 1, 1); PG8_SCHED; PG8_LDA(At, 1, 0);
            PG8_WAIT_V(8); PG8_WAIT_L(0); PG8_BAR; PG8_MMA(0, 0, At, B0); PG8_MMA(0, 1, At, B1); PG8_BAR; PG8_SCHED;
            PG8_STAGE(PG8_SB(1, 0), b3, voffB); PG8_STAGE(PG8_SB(1, 1), b3 + hstep, voffB); PG8_STAGE(PG8_SA(1, 0), a3, voffA); PG8_SCHED; PG8_LDA(At, 1, 1);
            PG8_WAIT_V(8); PG8_WAIT_L(0); PG8_BAR; PG8_MMA(1, 0, At, B0); PG8_MMA(1, 1, At, B1); PG8_BAR; PG8_SCHED;
            } else {
            PG8_LDB(B0, 0, 0); PG8_SCHED; PG8_LDA(At, 0, 0); PG8_STAGE(PG8_SA(1, 1), a1 + hstep, voffA);
            PG8_WAIT_L(8); PG8_BAR; PG8_WAIT_L(0); PG8_MMA(0, 0, At, B0); PG8_BAR; PG8_SCHED;
            PG8_LDB(B1, 0, 1); PG8_STAGE(PG8_SB(0, 0), b2, voffB);
            PG8_BAR; PG8_WAIT_L(0); PG8_MMA(0, 1, At, B1); PG8_BAR;
            PG8_LDA(At, 0, 1); PG8_STAGE(PG8_SA(0, 0), a2, voffA);
            PG8_BAR; PG8_WAIT_L(0); PG8_MMA(1, 0, At, B0); PG8_BAR; PG8_SCHED;
            PG8_STAGE(PG8_SB(0, 1), b2 + hstep, voffB);
            PG8_WAIT_V(6); PG8_BAR; PG8_MMA(1, 1, At, B1); PG8_BAR;
            PG8_LDB(B0, 1, 0); PG8_SCHED; PG8_LDA(At, 1, 0); PG8_STAGE(PG8_SA(0, 1), a2 + hstep, voffA);
            PG8_WAIT_L(8); PG8_BAR; PG8_WAIT_L(0); PG8_MMA(0, 0, At, B0); PG8_BAR; PG8_SCHED;
            PG8_LDB(B1, 1, 1); PG8_STAGE(PG8_SB(1, 0), b3, voffB);
            PG8_BAR; PG8_WAIT_L(0); PG8_MMA(0, 1, At, B1); PG8_BAR;
            PG8_LDA(At, 1, 1); PG8_STAGE(PG8_SA(1, 0), a3, voffA);
            PG8_BAR; PG8_WAIT_L(0); PG8_MMA(1, 0, At, B0); PG8_BAR; PG8_SCHED;
            PG8_STAGE(PG8_SB(1, 1), b3 + hstep, voffB);
            PG8_WAIT_V(6); PG8_BAR; PG8_MMA(1, 1, At, B1); PG8_BAR;
            }
        }
        if constexpr (ALIGN_EPI) { if (wr == 0) PG8_BAR; }
        if constexpr (!Epi::AFTER_DRAIN) { E(acc, cur, wr, wc, fr, fq); S.done(cur); }
        if (!has_next) break;
        if constexpr (Epi::PRELOAD) { typename Epi::Pre pre2; E.pre_issue(pre2, nxt, wr, wc, fr, fq); E.pre_finish(acc, pre2); }
        else {
#pragma unroll
        for (int a = 0; a < 2; ++a)
#pragma unroll
            for (int b = 0; b < 2; ++b)
#pragma unroll
                for (int m = 0; m < 4; ++m)
#pragma unroll
                    for (int n = 0; n < 2; ++n) acc[a][b][m][n] = (f32x4){0.f, 0.f, 0.f, 0.f};
        }
        cur = nxt; cA = nA; cB = nB; ++ui;
        if constexpr (ALIGN_EPI) { if (wr == 1) PG8_BAR; }
    }
    PG8_WAIT_V(0);
    if constexpr (!ALIGN_EPI) { if (wr == 0) PG8_BAR; }
    PG8_BAR;
    if constexpr (Epi::AFTER_DRAIN) { E.fused(acc, cur, wr, wc, fr, fq, lds, wid, lane); S.done(cur); }
#undef PG8_SA
#undef PG8_SB
#undef PG8_STAGE
#undef PG8_LDA
#undef PG8_LDB
#undef PG8_MMA
#undef PG8_WAIT_V
#undef PG8_WAIT_L
#undef PG8_BAR
#undef PG8_SCHED
}
}

#ifndef PROBE
#define PROBE 0
#endif
#ifndef PG8_SP2
#define PG8_SP2 true
#endif
#ifndef PG8_ALIGN
#define PG8_ALIGN true
#endif

#define GAS __attribute__((address_space(1)))
#define LAS __attribute__((address_space(3)))
typedef unsigned short bf16;
typedef pg8::f32x4 f32x4;
typedef pg8::f32x2 f32x2;
typedef pg8::u32x4 u32x4;
typedef pg8::bf16x8 bf16x8;
typedef unsigned u32x2 __attribute__((ext_vector_type(2)));
typedef GAS unsigned gu32;
#define RLX_AGENT __ATOMIC_RELAXED, __HIP_MEMORY_SCOPE_AGENT
#define LDS_WAIT() asm volatile("s_waitcnt lgkmcnt(0)" ::: "memory")
#define VM_WAIT() asm volatile("s_waitcnt vmcnt(0)" ::: "memory")
using pg8::cvt_pk_bf16;

constexpr int S_ = 16384, D_ = 1024, FF_ = 2816, NGU = 2 * FF_, NH = 16, HD = 64, NBLK = 64, BS = 256;
constexpr int NWAVES = 8;
constexpr float EPS = 1e-6f, LOG2E = 1.4426950408889634f;

constexpr size_t MiB = 1u << 20;
constexpr size_t WS_CTL = 0, CTL_ZERO_BYTES = 64 * 1024;
constexpr size_t WS_SSQ = 1 * MiB;
constexpr size_t WS_KPART = 2 * MiB;
constexpr size_t WS_SEL = 3 * MiB;
constexpr size_t WS_LSE = 4 * MiB;
constexpr size_t WS_QN2 = 348 * MiB;
constexpr size_t WS_WP = 7 * MiB;
constexpr size_t WS_WATT = 8 * MiB, WATT_STRIDE = 8 * MiB, WATT_WO = 6 * MiB;
constexpr size_t WS_WFFN = 24 * MiB, WFFN_STRIDE = 17301504, WFFN_WD = 11 * MiB;
constexpr size_t WS_XB = 156 * MiB;
constexpr size_t WS_BIG = 252 * MiB;
constexpr size_t WS_HALO = 349 * MiB;
constexpr size_t WS_SSQB = 351 * MiB;
constexpr size_t WS_END = 352 * MiB;
static_assert(WS_WFFN + 8 * WFFN_STRIDE == WS_XB, "ws map");
constexpr int CW_BAR = 4096, CW_QA = 8192;
static_assert((CW_QA + 64 * 16) * 4 <= (int)CTL_ZERO_BYTES && (CW_BAR + 3456) <= CW_QA, "control words inside the memset region");

constexpr int RING_BYTES = 131072, LDSCTL_OFF = RING_BYTES, MISC_OFF = LDSCTL_OFF + 320, RSTD_OFF = MISC_OFF + 128, LDS_BYTES = 147456;
static_assert(RSTD_OFF + 6 * 1024 <= LDS_BYTES, "LDS map");
constexpr int A_KS = 0, A_VT = 32768, A_LIST = 65536, A_CNT = A_LIST + 32768, A_OST = A_CNT + 256, A_OPITCH = 144;
static_assert(A_OST + 8 * 16 * A_OPITCH <= RING_BYTES, "attention LDS");

#define XB_TMO      128
#define XB_XCNT(j)  (256  + 64 * (j))
#define XB_XSUB(j)  (1280 + 64 * (j))
#define XB_XGEN(j)  (2304 + 64 * (j))
#define XB_TOP      3328
#define XB_TOPGEN   3392
#define XCD_BAR_WORDS 3456
#define XB_SPIN_CAP (1u << 18)

__device__ __forceinline__ unsigned xb_ld(unsigned* p)              { return __hip_atomic_load(p, __ATOMIC_RELAXED, __HIP_MEMORY_SCOPE_AGENT); }
__device__ __forceinline__ unsigned xb_add(unsigned* p, unsigned v) { return __hip_atomic_fetch_add(p, v, __ATOMIC_RELAXED, __HIP_MEMORY_SCOPE_AGENT); }
__device__ __forceinline__ unsigned xb_xcc_id() { return (unsigned)__builtin_amdgcn_s_getreg((3 << 11) | 20) & 0xFu; }
#define XB_SPIN(cond, bar) do { unsigned _sp = 0; while (cond) { __builtin_amdgcn_s_sleep(1); \
    if ((++_sp & 255u) == 0u) { if (xb_ld(&(bar)[XB_TMO])) break; if (_sp > XB_SPIN_CAP) { atomicAdd(&(bar)[XB_TMO], 1u); break; } } } } while (0)

struct XcdBarrier {
    unsigned* bar; unsigned x;
    volatile LAS unsigned* st;
};

__device__ __forceinline__ XcdBarrier xcd_barrier_post(unsigned* bar, volatile LAS unsigned* st, const bool thread0) {
    XcdBarrier b; b.bar = bar; b.x = xb_xcc_id(); b.st = st;
    if (thread0) (void)xb_add(&bar[XB_XCNT(b.x)], 1u);
    return b;
}
__device__ __forceinline__ void xcd_barrier_complete(unsigned* bar, unsigned x, unsigned& nloc, unsigned& nx) {
    const unsigned G = gridDim.x * gridDim.y * gridDim.z;
    unsigned sum, cnt, mine, sp = 0u;
    for (;;) {
        sum = 0u; cnt = 0u; mine = 0u;
#pragma unroll
        for (unsigned j = 0; j < 16; ++j) { const unsigned c = xb_ld(&bar[XB_XCNT(j)]); sum += c; cnt += (c > 0u) ? 1u : 0u; mine = (j == x) ? c : mine; }
        if (sum == G) break;
        __builtin_amdgcn_s_sleep(1);
        if ((++sp & 255u) == 0u) { if (xb_ld(&bar[XB_TMO])) break; if (sp > XB_SPIN_CAP) { atomicAdd(&bar[XB_TMO], 1u); break; } }
    }
    nloc = mine > 0u ? mine : 1u; nx = cnt > 0u ? cnt : 1u;
}

__device__ __forceinline__ void xcd_barrier(const XcdBarrier& b, const bool thread0) {
    asm volatile("s_waitcnt vmcnt(0)" ::: "memory");
    __syncthreads();
    if (thread0) {
        unsigned* bar = b.bar;
        __builtin_amdgcn_s_waitcnt(0);
        unsigned nloc = b.st[0], nx = b.st[1];
        if (nloc == 0u) { xcd_barrier_complete(bar, b.x, nloc, nx); b.st[0] = nloc; b.st[1] = nx; }
        const unsigned old = xb_add(&bar[XB_XSUB(b.x)], 1u);
        const unsigned gen = old / nloc;
        if (old + 1u == (gen + 1u) * nloc) {
            __builtin_amdgcn_fence(__ATOMIC_RELEASE, "agent");
            asm volatile("s_waitcnt vmcnt(0)" ::: "memory");
            const unsigned og = xb_add(&bar[XB_TOP], 1u);
            const unsigned tg = og / nx;
            if (og + 1u == (tg + 1u) * nx) xb_add(&bar[XB_TOPGEN], 1u);
            else XB_SPIN(xb_ld(&bar[XB_TOPGEN]) == tg, bar);
            __builtin_amdgcn_fence(__ATOMIC_ACQUIRE, "agent");
            xb_add(&bar[XB_XGEN(b.x)], 1u);
            asm volatile("s_waitcnt vmcnt(0)" ::: "memory");
        } else {
            XB_SPIN(xb_ld(&bar[XB_XGEN(b.x)]) == gen, bar);
            __builtin_amdgcn_fence(__ATOMIC_ACQUIRE, "agent");
            asm volatile("s_waitcnt vmcnt(0)" ::: "memory");
        }
    }
    __syncthreads();
}
__device__ __forceinline__ float row_rstd(const float* ssq, int row) {
    const f32x4* p = (const f32x4*)(ssq + (size_t)row * 16);
    const f32x4 a = p[0], b = p[1], c = p[2], d = p[3];
    const float s = (((a.x + a.y) + (a.z + a.w)) + ((b.x + b.y) + (b.z + b.w))) + (((c.x + c.y) + (c.z + c.w)) + ((d.x + d.y) + (d.z + d.w)));
    return __builtin_amdgcn_rsqf(s * (1.0f / 1024.0f) + EPS);
}
template <class Sched> __device__ __forceinline__ void rstd_table(LAS unsigned char* lds, const float* ssq, const Sched& S, const int wave0) {
    int tid = wave0 * 64 + mk_lane(); asm volatile("" : "+v"(tid));
    LAS float* T = (LAS float*)(lds + RSTD_OFF);
#pragma unroll
    for (int i2 = 0; i2 < 3; ++i2) { pg8::Unit u; const int i = 2 * i2 + (tid >> 8); if (S.next(i, u)) T[i * 256 + (tid & 255)] = row_rstd(ssq, u.pm * 256 + (tid & 255)); }
    __syncthreads();
}
__device__ __forceinline__ float bf_lo(unsigned w) { return __uint_as_float(w << 16); }
__device__ __forceinline__ float bf_hi(unsigned w) { return __uint_as_float(w & 0xffff0000u); }

struct EpiNull {
    static constexpr bool PERM = false, AFTER_DRAIN = false;
    float* dummy;
    __device__ __forceinline__ void operator()(const f32x4 (&acc)[2][2][4][2], const pg8::Unit& u, int wr, int wc, int fr, int fq) const {
        f32x4 s = {0.f, 0.f, 0.f, 0.f};
#pragma unroll
        for (int ai = 0; ai < 2; ++ai)
#pragma unroll
            for (int bj = 0; bj < 2; ++bj)
#pragma unroll
                for (int m = 0; m < 4; ++m)
#pragma unroll
                    for (int n = 0; n < 2; ++n) s += acc[ai][bj][m][n];
        dummy[(size_t)blockIdx.x * 512 + (wr * 4 + wc) * 64 + fq * 16 + fr] = (s.x + s.y) + (s.z + s.w);
    }
};
struct NoPre {};
struct EpiSwiGLU {
    static constexpr bool PERM = true, AFTER_DRAIN = false, PRELOAD = false; typedef NoPre Pre;
    bf16* H; LAS const float* rt; int nullmode;
    __device__ __forceinline__ void operator()(const f32x4 (&acc)[2][2][4][2], const pg8::Unit& u, int wr, int wc, int fr, int fq) const {
#if PROBE == 13
        if (nullmode) { EpiNull en{(float*)H}; en(acc, u, wr, wc, fr, fq); return; }
#endif
        const int row0 = u.pm * 256 + wr * 64 + fr, col0 = u.pn * 128 + wc * 32 + 8 * fq;
#pragma unroll
        for (int ai = 0; ai < 2; ++ai)
#pragma unroll
            for (int m = 0; m < 4; ++m) {
                const int row = row0 + ai * 128 + m * 16;
                const float rs = rt[u.idx * 256 + (row & 255)], rsl = rs * (-LOG2E), rs2 = rs * rs;
                float hv[8];
#pragma unroll
                for (int n = 0; n < 2; ++n)
#pragma unroll
                    for (int e = 0; e < 4; ++e) {
                        const float ga = acc[ai][0][m][n][e], ua = acc[ai][1][m][n][e];
                        const float ex = __builtin_amdgcn_exp2f(ga * rsl);
                        hv[n * 4 + e] = ((ga * ua) * rs2) * __builtin_amdgcn_rcpf(1.0f + ex);
                    }
                u32x4 w; w.x = cvt_pk_bf16(hv[0], hv[1]); w.y = cvt_pk_bf16(hv[2], hv[3]); w.z = cvt_pk_bf16(hv[4], hv[5]); w.w = cvt_pk_bf16(hv[6], hv[7]);
                *(u32x4*)(H + (size_t)row * FF_ + col0) = w;
            }
    }
};

template <bool POOL, int ALPHA2> struct EpiResid {
    static constexpr bool PERM = true, AFTER_DRAIN = false;
    static constexpr bool PRELOAD = !POOL;
    struct PreTile { u32x4 r[16]; };
    typedef typename std::conditional<POOL, NoPre, PreTile>::type Pre;
    static constexpr float alpha = 0.5f * (float)ALPHA2;
    bf16* xb; float* ssq; const float* cscale; bf16* halo;
    __device__ __forceinline__ void pre_issue(PreTile& pre, const pg8::Unit& u, int wr, int wc, int fr, int fq) const {
        const int row0 = u.pm * 256 + wr * 64 + fr, col0 = u.pn * 256 + wc * 32 + 8 * fq;
#pragma unroll
        for (int ai = 0; ai < 2; ++ai)
#pragma unroll
            for (int m = 0; m < 4; ++m)
#pragma unroll
                for (int bj = 0; bj < 2; ++bj) pre.r[(ai * 4 + m) * 2 + bj] = *(const u32x4*)(xb + (size_t)(row0 + ai * 128 + m * 16) * D_ + col0 + bj * 128);
    }
    __device__ __forceinline__ void pre_finish(f32x4 (&acc)[2][2][4][2], const PreTile& pre) const {
        const float ia = 1.0f / alpha;
#pragma unroll
        for (int ai = 0; ai < 2; ++ai)
#pragma unroll
            for (int m = 0; m < 4; ++m)
#pragma unroll
                for (int bj = 0; bj < 2; ++bj) { const u32x4 b = pre.r[(ai * 4 + m) * 2 + bj];
                    acc[ai][bj][m][0] = (f32x4){bf_lo(b.x), bf_hi(b.x), bf_lo(b.y), bf_hi(b.y)} * ia; acc[ai][bj][m][1] = (f32x4){bf_lo(b.z), bf_hi(b.z), bf_lo(b.w), bf_hi(b.w)} * ia; }
    }
    __device__ __forceinline__ void operator()(const f32x4 (&acc)[2][2][4][2], const pg8::Unit& u, int wr, int wc, int fr, int fq) const {
        const int pmr = POOL ? (u.pm & 63) : u.pm;
        const int row0 = pmr * 256 + wr * 64 + fr, col0 = u.pn * 256 + wc * 32 + 8 * fq;
        f32x4 cs[2][2];
#pragma unroll
        for (int bj = 0; bj < 2; ++bj)
#pragma unroll
            for (int n = 0; n < 2; ++n) { if (POOL) cs[bj][n] = *(const f32x4*)(cscale + col0 + bj * 128 + 4 * n) * alpha; }
#pragma unroll
        for (int ai = 0; ai < 2; ++ai) {
            u32x4 bx[4][2];
            if (POOL) {
#pragma unroll
            for (int m = 0; m < 4; ++m)
#pragma unroll
                for (int bj = 0; bj < 2; ++bj) bx[m][bj] = *(const u32x4*)(xb + (size_t)(row0 + ai * 128 + m * 16) * D_ + col0 + bj * 128);
            }
#pragma unroll
            for (int m = 0; m < 4; ++m) {
                const int row = row0 + ai * 128 + m * 16; float s = 0.f;
#pragma unroll
                for (int bj = 0; bj < 2; ++bj) {
                    f32x4 v0, v1;
                    if (POOL) { v0 = acc[ai][bj][m][0] * cs[bj][0]; v1 = acc[ai][bj][m][1] * cs[bj][1]; } else { v0 = acc[ai][bj][m][0] * alpha; v1 = acc[ai][bj][m][1] * alpha; }
                    if (POOL) { const u32x4 b = bx[m][bj]; v0 += (f32x4){bf_lo(b.x), bf_hi(b.x), bf_lo(b.y), bf_hi(b.y)}; v1 += (f32x4){bf_lo(b.z), bf_hi(b.z), bf_lo(b.w), bf_hi(b.w)}; }
                    s += ((v0.x * v0.x + v0.y * v0.y) + (v0.z * v0.z + v0.w * v0.w)) + ((v1.x * v1.x + v1.y * v1.y) + (v1.z * v1.z + v1.w * v1.w));
                    u32x4 w; w.x = cvt_pk_bf16(v0.x, v0.y); w.y = cvt_pk_bf16(v0.z, v0.w); w.z = cvt_pk_bf16(v1.x, v1.y); w.w = cvt_pk_bf16(v1.z, v1.w);
                    *(u32x4*)(xb + (size_t)row * D_ + col0 + bj * 128) = w;
                    if (!POOL && ai == 1 && m == 3) { if (halo && wr == 1) *(u32x4*)(halo + ((size_t)u.pm * 16 + fr) * D_ + col0 + bj * 128) = w; }
                }
                s += shx(s, 16, fq * 16 + fr); s += shx(s, 32, fq * 16 + fr);
                if (fq == 0) ssq[(size_t)row * 16 + u.pn * 4 + wc] = s;
            }
        }
    }
};

struct EpiQKV {
    static constexpr bool PERM = true, AFTER_DRAIN = false, PRELOAD = false; typedef NoPre Pre;
    bf16* QKV; LAS const float* rt; float* kpart;
    __device__ __forceinline__ void operator()(const f32x4 (&acc)[2][2][4][2], const pg8::Unit& u, int wr, int wc, int fr, int fq) const {
        const int t = u.pn >> 2, colt = (u.pn & 3) * 256;
        bf16* dst = QKV + (size_t)t * S_ * D_;
        const int row0 = u.pm * 256 + wr * 64 + fr, col0 = colt + wc * 32 + 8 * fq;
        f32x4 csum[2][2];
#pragma unroll
        for (int bj = 0; bj < 2; ++bj)
#pragma unroll
            for (int n = 0; n < 2; ++n) csum[bj][n] = (f32x4){0.f, 0.f, 0.f, 0.f};
#pragma unroll
        for (int ai = 0; ai < 2; ++ai)
#pragma unroll
            for (int m = 0; m < 4; ++m) {
                const int row = row0 + ai * 128 + m * 16;
                const float rs = rt[u.idx * 256 + (row & 255)];
#pragma unroll
                for (int bj = 0; bj < 2; ++bj) {
                    const f32x4 v0 = acc[ai][bj][m][0] * rs, v1 = acc[ai][bj][m][1] * rs;
                    u32x4 w; w.x = cvt_pk_bf16(v0.x, v0.y); w.y = cvt_pk_bf16(v0.z, v0.w); w.z = cvt_pk_bf16(v1.x, v1.y); w.w = cvt_pk_bf16(v1.z, v1.w);
                    *(u32x4*)(dst + (size_t)row * D_ + col0 + bj * 128) = w;
                    csum[bj][0] += v0; csum[bj][1] += v1;
                }
            }
        if (t == 1) {
#pragma unroll
            for (int bj = 0; bj < 2; ++bj)
#pragma unroll
                for (int n = 0; n < 2; ++n) {
                    f32x4 c = csum[bj][n];
#pragma unroll
                    for (int e = 0; e < 4; ++e) { float x = c[e]; x += shx(x, 1, fq * 16 + fr); x += shx(x, 2, fq * 16 + fr); x += shx(x, 4, fq * 16 + fr); x += shx(x, 8, fq * 16 + fr); c[e] = x; }
                    if (fr == 0) *(f32x4*)(kpart + ((size_t)wr * NBLK + u.pm) * D_ + col0 + bj * 128 + 4 * n) = c;
                }
        }
    }
};


struct PoolOrder {
    int G, c;
    __device__ __forceinline__ bool next(int i, pg8::Unit& u) const { const int L = i * G + c; if (L >= 256) return false; u.pm = L; u.pn = L >> 6; u.idx = i; return true; }
    __device__ __forceinline__ void a_ready(const pg8::Unit&) const {}
    __device__ __forceinline__ void done(const pg8::Unit&) const {}
};
__device__ __forceinline__ float wave_sum(float v, int lane) {
#pragma unroll
    for (int o = 1; o < 64; o <<= 1) v += shx(v, o, lane);
    return v;
}
__device__ __forceinline__ void tr_item(const float* src, int N, int k0, int n0, bf16* dst, int dpitch, int drow0, const float* gain, float cs, LAS float* scr, int lane) {
    f32x4 v[8];
#pragma unroll
    for (int i = 0; i < 8; ++i) v[i] = *(const f32x4*)(src + (size_t)(k0 + 8 * i + (lane >> 3)) * N + n0 + 4 * (lane & 7));
#pragma unroll
    for (int i = 0; i < 8; ++i) {
        const int kk = 8 * i + (lane >> 3);
        const float g = gain ? gain[k0 + kk] * cs : cs;
        LAS float* d = scr + kk * 33 + 4 * (lane & 7);
        d[0] = v[i].x * g; d[1] = v[i].y * g; d[2] = v[i].z * g; d[3] = v[i].w * g;
    }
    LDS_WAIT(); asm volatile("" ::: "memory");
    const int c = lane & 7;
#pragma unroll
    for (int j = 0; j < 4; ++j) {
        const int n = (lane >> 3) + 8 * j; const LAS float* s = scr + (8 * c) * 33 + n;
        u32x4 o; o.x = cvt_pk_bf16(s[0 * 33], s[1 * 33]); o.y = cvt_pk_bf16(s[2 * 33], s[3 * 33]); o.z = cvt_pk_bf16(s[4 * 33], s[5 * 33]); o.w = cvt_pk_bf16(s[6 * 33], s[7 * 33]);
        *(u32x4*)(dst + (size_t)(drow0 + n) * dpitch + k0 + 8 * c) = o;
    }
    LDS_WAIT(); asm volatile("" ::: "memory");
}
__device__ __forceinline__ unsigned char* launder_s(unsigned char* p) { unsigned long long v = (unsigned long long)p; asm volatile("" : "+s"(v)); return (unsigned char*)v; }
struct Ptrs {
    const float *x, *ln, *wg, *wu, *wd, *wqkv, *wo, *pw, *ps, *fg;
    float* out; unsigned char* ws;
};
__device__ __forceinline__ bf16* ws_wgu(unsigned char* ws, int f) { return (bf16*)(ws + WS_WFFN + (size_t)f * WFFN_STRIDE); }
__device__ __forceinline__ bf16* ws_wd(unsigned char* ws, int f) { return (bf16*)(ws + WS_WFFN + (size_t)f * WFFN_STRIDE + WFFN_WD); }
__device__ __forceinline__ bf16* ws_wqkv(unsigned char* ws, int a) { return (bf16*)(ws + WS_WATT + (size_t)a * WATT_STRIDE); }
__device__ __forceinline__ bf16* ws_wo(unsigned char* ws, int a) { return (bf16*)(ws + WS_WATT + (size_t)a * WATT_STRIDE + WATT_WO); }
__device__ __forceinline__ bf16* ws_wp(unsigned char* ws, int p) { return (bf16*)(ws + WS_WP + (size_t)p * 524288); }

constexpr int IT_F = 1408, IT_FFN = 3 * IT_F, IT_ATT = 2048, IT_QKV = 1536, IT_POOL = 128;
constexpr int IT_TOTAL = 8 * IT_FFN + 2 * IT_ATT + 2 * IT_POOL;
__device__ __forceinline__ void convert_items(const Ptrs& P, LAS unsigned char* lds, int it_lo, int it_hi, int ww, int n_ww, int wave, int lane) {
    LAS float* scr = (LAS float*)(lds + wave * 16384);
    for (int it = it_lo + ww; it < it_hi; it += n_ww) {
        if (it < 8 * IT_FFN) {
            const int f = it / IT_FFN, r = it % IT_FFN, m = r / IT_F, q = r % IT_F;
            if (m < 2) {
                const int kb = q / 88, nb = q % 88, n0 = 32 * nb;
                const float* src = (m == 0 ? P.wg : P.wu) + (size_t)f * D_ * FF_;
                const float* gain = P.ln + ((f >> 1) * 3 + ((f & 1) ? 2 : 0)) * D_;
                tr_item(src, FF_, 64 * kb, n0, ws_wgu(P.ws, f), D_, (n0 >> 7) * 256 + m * 128 + (n0 & 127), gain, 1.0f, scr, lane);
            } else {
                const int kb = q / 32, nb = q % 32;
                tr_item(P.wd + (size_t)f * D_ * FF_, D_, 64 * kb, 32 * nb, ws_wd(P.ws, f), FF_, 32 * nb, nullptr, 1.0f, scr, lane);
            }
        } else if (it < 8 * IT_FFN + 2 * IT_ATT) {
            const int r = it - 8 * IT_FFN, a = r / IT_ATT; int q = r % IT_ATT;
            if (q < IT_QKV) {
                const int kb = q / 96, nb = q % 96, n0 = 32 * nb;
                tr_item(P.wqkv + (size_t)a * D_ * 3 * D_, 3 * D_, 64 * kb, n0, ws_wqkv(P.ws, a), D_, n0, P.ln + ((2 * a) * 3 + 1) * D_, n0 < D_ ? 0.125f * LOG2E : 1.0f, scr, lane);
            } else {
                q -= IT_QKV; const int kb = q / 32, nb = q % 32;
                tr_item(P.wo + (size_t)a * D_ * D_, D_, 64 * kb, 32 * nb, ws_wo(P.ws, a), D_, 32 * nb, nullptr, 1.0f, scr, lane);
            }
        } else {
            const int r = it - 8 * IT_FFN - 2 * IT_ATT, p = r / IT_POOL, g = (r % IT_POOL) / 32, q = r % 32, kb = q / 8, nb = q % 8;
            tr_item(P.pw + (size_t)(p * 4 + g) * 65536, 256, 64 * kb, 32 * nb, ws_wp(P.ws, p), 256, g * 256 + 32 * nb, nullptr, 1.0f, scr, lane);
        }
    }
}
#ifndef TAILCONV
#define TAILCONV 1
#endif
__device__ __forceinline__ void phase_prologue(const Ptrs& P, LAS unsigned char* lds, const int wave0) {
    int tid = wave0 * 64 + mk_lane(); asm volatile("" : "+v"(tid)); const int lane = tid & 63, wave = __builtin_amdgcn_readfirstlane(tid >> 6); (void)lane; (void)wave;
    const int gw = blockIdx.x * NWAVES + wave, NGW = gridDim.x * NWAVES;
    if (TAILCONV && gridDim.x == 256) {
        convert_items(P, lds, 0, IT_FFN, gw, NGW, wave, lane);
    } else convert_items(P, lds, 0, IT_TOTAL, gw, NGW, wave, lane);
    bf16* XB = (bf16*)(P.ws + WS_XB); float* ssq = (float*)(P.ws + WS_SSQ);
    for (int row = gw; row < S_; row += NGW) {
        const f32x4* xr = (const f32x4*)(P.x + (size_t)row * D_) + lane;
        f32x4 v[4]; float s = 0.f;
#pragma unroll
        for (int j = 0; j < 4; ++j) { v[j] = xr[64 * j]; s += (v[j].x * v[j].x + v[j].y * v[j].y) + (v[j].z * v[j].z + v[j].w * v[j].w); }
        s = wave_sum(s, lane);
        u32x2* o8 = (u32x2*)(XB + (size_t)row * D_) + lane;
#pragma unroll
        for (int j = 0; j < 4; ++j) { u32x2 w; w.x = cvt_pk_bf16(v[j].x, v[j].y); w.y = cvt_pk_bf16(v[j].z, v[j].w); o8[64 * j] = w; }
        if (lane < 16) ssq[(size_t)row * 16 + lane] = lane == 0 ? s : 0.f;
    }
}

__device__ __forceinline__ void phase_final(const Ptrs& P, bool poison, const int wave0) {
    int tid = wave0 * 64 + mk_lane(); asm volatile("" : "+v"(tid)); const int lane = tid & 63, wave = __builtin_amdgcn_readfirstlane(tid >> 6); (void)lane; (void)wave;
    const int gw = blockIdx.x * NWAVES + wave, NGW = gridDim.x * NWAVES;
    const float* ssq = (const float*)(P.ws + WS_SSQ);
    const float qnan = __builtin_nanf("");
    for (int row = gw; row < S_; row += NGW) {
        const float rs = row_rstd(ssq, row);
        f32x4* xr = (f32x4*)(P.out + (size_t)row * D_) + lane; const f32x4* gr = (const f32x4*)P.fg + lane;
        const u32x2* h8 = (const u32x2*)((const bf16*)(P.ws + WS_XB) + (size_t)row * D_) + lane;
#pragma unroll
        for (int j = 0; j < 4; ++j) { const u32x2 hv = h8[64 * j]; f32x4 x4 = {bf_lo(hv.x), bf_hi(hv.x), bf_lo(hv.y), bf_hi(hv.y)};
            f32x4 v = x4 * gr[64 * j] * rs; if (poison) v = (f32x4){qnan, qnan, qnan, qnan}; xr[64 * j] = v; }
    }
}

__device__ __forceinline__ void phase_pool_elem(const bf16* xhi, const float* ssq, const float* gain, bf16* Y, const bf16* halo, LAS unsigned char* lds, const int wave0) {
    int tid = wave0 * 64 + mk_lane(); asm volatile("" : "+v"(tid)); const int lane = tid & 63, wave = __builtin_amdgcn_readfirstlane(tid >> 6); (void)lane; (void)wave;
    LAS float* rs = (LAS float*)lds;
    const int L = blockIdx.x, g = L >> 6, strip = wave >> 1;
    const int t0 = (L & 63) * 256 + strip * 64;
    if (tid < 320) { const int st = tid / 80, r = (L & 63) * 256 + st * 64 - 16 + tid % 80; rs[tid] = r >= 0 ? row_rstd(ssq, r) : 0.f; }
    __syncthreads();
    const int cg = 2 * (tid & 127), c = g * 256 + cg;
    const f32x2 gn = *(const f32x2*)(gain + c);
    f32x2 hist[16], S2 = {0.f, 0.f}, S4 = {0.f, 0.f}, S8 = {0.f, 0.f}, S16 = {0.f, 0.f};
#pragma unroll
    for (int i = 0; i < 16; ++i) hist[i] = (f32x2){0.f, 0.f};
    const int w = 2 << g;
    bf16* Yg = Y + (size_t)g * S_ * 256 + cg;
    LAS const float* rss = rs + strip * 80;
    unsigned hwv[80];
#pragma unroll
    for (int r = 0; r < 80; ++r) {
        const int row = t0 - 16 + r; hwv[r] = 0u;
        if (row >= 0) { const bf16* src = (r < 16 && strip == 0) ? halo + ((size_t)((L & 63) - 1) * 16 + r) * D_ + c : xhi + (size_t)row * D_ + c; hwv[r] = *(const unsigned*)src; }
    }
#pragma unroll
    for (int b = 0; b < 5; ++b) {
#pragma unroll
        for (int i = 0; i < 16; ++i) {
            const int r = 16 * b + i, row = t0 - 16 + r;
            const unsigned hw = hwv[r];
            const f32x2 hv = (f32x2){bf_lo(hw), bf_hi(hw)} * gn * rss[r];
            S16 += hv - hist[i]; S8 += hv - hist[(i + 8) & 15]; S4 += hv - hist[(i + 12) & 15]; S2 += hv - hist[(i + 14) & 15]; hist[i] = hv;
            if (b > 0) {
                const f32x2 sw = g == 0 ? S2 : g == 1 ? S4 : g == 2 ? S8 : S16;
                const int cnt = row + 1 < w ? row + 1 : w;
                const f32x2 y = sw * (1.0f / (float)cnt) - hv;
                *(unsigned*)(Yg + (size_t)row * 256) = cvt_pk_bf16(y.x, y.y);
            }
        }
    }
    asm volatile("s_waitcnt vmcnt(0)" ::: "memory");
    __builtin_amdgcn_fence(__ATOMIC_ACQUIRE, "agent");
    asm volatile("s_waitcnt vmcnt(0)" ::: "memory");
    __syncthreads();
}

__device__ __forceinline__ void top3_insert(float gt, unsigned n, float& v0, float& v1, float& v2, unsigned& i0, unsigned& i1, unsigned& i2) {
    const bool g0 = gt > v0, g1 = gt > v1, g2 = gt > v2;
    v2 = g1 ? v1 : (g2 ? gt : v2); i2 = g1 ? i1 : (g2 ? n : i2);
    v1 = g0 ? v0 : (g1 ? gt : v1); i1 = g0 ? i0 : (g1 ? n : i1);
    v0 = g0 ? gt : v0;             i0 = g0 ? n : i0;
}
__device__ __forceinline__ void phase_gate(const bf16* Q, const float* kpart, unsigned* sel, float* qn2, LAS unsigned char* lds, const int wave0) {
    int tid = wave0 * 64 + mk_lane(); asm volatile("" : "+v"(tid)); const int lane = tid & 63, wave = __builtin_amdgcn_readfirstlane(tid >> 6);
    const int fr = lane & 15, fq = lane >> 4;
    constexpr int KP = 144, LO = 64 * KP;
    for (int wgt = blockIdx.x; wgt < 256; wgt += gridDim.x) {
        const int h = wgt & 15, part = wgt >> 4;
        bf16x8 qa[8][2];
#pragma unroll
        for (int i = 0; i < 8; ++i) { const bf16* qrow = Q + (size_t)(part * 1024 + (wave + 8 * i) * 16 + fr) * D_ + h * 64; qa[i][0] = *(const bf16x8*)(qrow + 8 * fq); qa[i][1] = *(const bf16x8*)(qrow + 32 + 8 * fq); }
        {
            const int n = tid >> 3, d0 = (tid & 7) * 8;
            const float* pa = kpart + (size_t)n * D_ + h * 64 + d0; const float* pb = pa + (size_t)NBLK * D_;
            const f32x4 a0 = *(const f32x4*)pa, a1 = *(const f32x4*)(pa + 4), b0 = *(const f32x4*)pb, b1 = *(const f32x4*)(pb + 4);
            const f32x4 s0 = a0 + b0, s1 = a1 + b1;
            u32x4 hi; hi.x = cvt_pk_bf16(s0.x, s0.y); hi.y = cvt_pk_bf16(s0.z, s0.w); hi.z = cvt_pk_bf16(s1.x, s1.y); hi.w = cvt_pk_bf16(s1.z, s1.w);
            u32x4 lo; lo.x = cvt_pk_bf16(s0.x - bf_lo(hi.x), s0.y - bf_hi(hi.x)); lo.y = cvt_pk_bf16(s0.z - bf_lo(hi.y), s0.w - bf_hi(hi.y));
            lo.z = cvt_pk_bf16(s1.x - bf_lo(hi.z), s1.y - bf_hi(hi.z)); lo.w = cvt_pk_bf16(s1.z - bf_lo(hi.w), s1.w - bf_hi(hi.w));
            *(LAS u32x4*)(lds + n * KP + d0 * 2) = hi; *(LAS u32x4*)(lds + LO + n * KP + d0 * 2) = lo;
        }
        __syncthreads();
#pragma unroll
        for (int ti = 0; ti < 8; ++ti) {
            const int tile = wave + 8 * ti;
            const int t0 = part * 1024 + tile * 16, j = t0 >> 8, t = t0 + fr;
            const bf16x8 q0 = qa[ti][0], q1 = qa[ti][1];
            float v0 = -INFINITY, v1 = -INFINITY, v2 = -INFINITY; unsigned i0 = 255u, i1 = 255u, i2 = 255u;
            LAS const unsigned char* kp = lds + fr * KP + fq * 16;
#pragma unroll
            for (int bt = 0; bt < 4; ++bt) {
                if (16 * bt < j) {
                    const bf16x8 h0 = *(LAS const bf16x8*)(kp + bt * 16 * KP), h1 = *(LAS const bf16x8*)(kp + bt * 16 * KP + 64);
                    const bf16x8 l0 = *(LAS const bf16x8*)(kp + LO + bt * 16 * KP), l1 = *(LAS const bf16x8*)(kp + LO + bt * 16 * KP + 64);
                    f32x4 z = {0.f, 0.f, 0.f, 0.f};
                    z = __builtin_amdgcn_mfma_f32_16x16x32_bf16(l0, q0, z, 0, 0, 0); z = __builtin_amdgcn_mfma_f32_16x16x32_bf16(l1, q1, z, 0, 0, 0);
                    z = __builtin_amdgcn_mfma_f32_16x16x32_bf16(h0, q0, z, 0, 0, 0); z = __builtin_amdgcn_mfma_f32_16x16x32_bf16(h1, q1, z, 0, 0, 0);
#pragma unroll
                    for (int e = 0; e < 4; ++e) { const int n = 16 * bt + 4 * fq + e; if (n < j) top3_insert(z[e], (unsigned)n, v0, v1, v2, i0, i1, i2); }
                }
            }
#pragma unroll
            for (int sh = 16; sh <= 32; sh <<= 1) {
                const float p0 = shx(v0, sh, lane), p1 = shx(v1, sh, lane), p2 = shx(v2, sh, lane);
                const unsigned q0i = shxu(i0, sh, lane), q1i = shxu(i1, sh, lane), q2i = shxu(i2, sh, lane);
                if (q0i != 255u) top3_insert(p0, q0i, v0, v1, v2, i0, i1, i2);
                if (q1i != 255u) top3_insert(p1, q1i, v0, v1, v2, i0, i1, i2);
                if (q2i != 255u) top3_insert(p2, q2i, v0, v1, v2, i0, i1, i2);
            }
            float qq = 0.f;
#pragma unroll
            for (int i = 0; i < 8; ++i) { const float a = __uint_as_float((unsigned)(unsigned short)q0[i] << 16), b = __uint_as_float((unsigned)(unsigned short)q1[i] << 16); qq = __builtin_fmaf(a, a, qq); qq = __builtin_fmaf(b, b, qq); }
            qq += shx(qq, 16, lane); qq += shx(qq, 32, lane);
            if (fq == 0) { sel[(size_t)h * S_ + t] = i0 | (i1 << 8) | (i2 << 16) | 0xff000000u; qn2[(size_t)h * S_ + t] = qq; }
        }
        __syncthreads();
    }
}

template <bool CAUSAL>
__device__ __forceinline__ void attn_tile(LAS const unsigned char* Ks, LAS const unsigned char* Vt, bf16x8 q0, bf16x8 q1, float lcm, float slope2, int tq_rel, int nch, int fr, int fq,
                                          f32x4 (&o)[4], float& l_out) {
    const int rowbase = 8 * (fr >> 2) + (fr & 3), sw = (((fr >> 1) & 1) << 1) | (((fr >> 3) & 1) << 2);
    LAS const unsigned char* kp0 = Ks + rowbase * 128 + ((fq ^ sw) * 16);
    LAS const unsigned char* kp1 = Ks + rowbase * 128 + (((4 | fq) ^ sw) * 16);
    const float thr_f = (float)(tq_rel - 8 * fq);
    f32x4 s[16];
    bf16x8 kf[2][4];
#define AT_LOADK(buf, c) do { _Pragma("unroll") for (int u = 0; u < 2; ++u) { const int ro = (32 * (c) + 4 * u) * 128; \
        kf[buf][2 * u] = *(LAS const bf16x8*)(kp0 + ro); kf[buf][2 * u + 1] = *(LAS const bf16x8*)(kp1 + ro); } } while (0)
    AT_LOADK(0, 0);
#pragma unroll
    for (int c = 0; c < 8; ++c) {
        if (!CAUSAL || c < nch) {
            if (c < 7) { if (!CAUSAL || c + 1 < nch) AT_LOADK((c + 1) & 1, c + 1); }
            __builtin_amdgcn_sched_barrier(0);
            f32x4 c0, c1;
            float lcc = lcm, thc = thr_f; asm volatile("" : "+v"(lcc), "+v"(thc));
#pragma unroll
            for (int e = 0; e < 4; ++e) {
                c0[e] = __builtin_fmaf(slope2, (float)(32 * c + e), lcc); c1[e] = __builtin_fmaf(slope2, (float)(32 * c + 4 + e), lcc);
                if (CAUSAL) { c0[e] = __builtin_fmaf(fminf(thc - (float)(32 * c + e), 0.f), 1e9f, c0[e]); c1[e] = __builtin_fmaf(fminf(thc - (float)(32 * c + 4 + e), 0.f), 1e9f, c1[e]); }
            }
            const f32x4 z0 = __builtin_amdgcn_mfma_f32_16x16x32_bf16(kf[c & 1][0], q0, c0, 0, 0, 0);
            const f32x4 z1 = __builtin_amdgcn_mfma_f32_16x16x32_bf16(kf[c & 1][2], q0, c1, 0, 0, 0);
            s[2 * c] = __builtin_amdgcn_mfma_f32_16x16x32_bf16(kf[c & 1][1], q1, z0, 0, 0, 0);
            s[2 * c + 1] = __builtin_amdgcn_mfma_f32_16x16x32_bf16(kf[c & 1][3], q1, z1, 0, 0, 0);
        }
    }
#undef AT_LOADK
    const int lanev16 = (fq ^ (2 * (fr & 7))) * 16;
    LAS const unsigned char* vp = Vt + fr * 512;
    bf16x8 vf[2][4];
#define AT_LOADV(buf, c) do { const int co = (64 * (c)) ^ lanev16; \
        _Pragma("unroll") for (int dt = 0; dt < 4; ++dt) vf[buf][dt] = *(LAS const bf16x8*)(vp + dt * 8192 + co); } while (0)
    AT_LOADV(0, 0);
    float l0 = 0.f, l1 = 0.f, l2 = 0.f, l3 = 0.f;
#pragma unroll
    for (int kt = 0; kt < 16; ++kt) {
        if (!CAUSAL || (kt >> 1) < nch) {
#pragma unroll
            for (int e = 0; e < 4; ++e) s[kt][e] = __builtin_amdgcn_exp2f(s[kt][e]);
            l0 += s[kt][0]; l1 += s[kt][1]; l2 += s[kt][2]; l3 += s[kt][3];
        }
    }
    float l = (l0 + l1) + (l2 + l3);
    l += shx(l, 16, fq * 16 + fr); l += shx(l, 32, fq * 16 + fr);
#pragma unroll
    for (int dt = 0; dt < 4; ++dt) o[dt] = (f32x4){0.f, 0.f, 0.f, 0.f};
#pragma unroll
    for (int c = 0; c < 8; ++c) {
        if (!CAUSAL || c < nch) {
            if (c < 7) { if (!CAUSAL || c + 1 < nch) AT_LOADV((c + 1) & 1, c + 1); }
            u32x4 pw; pw.x = cvt_pk_bf16(s[2 * c][0], s[2 * c][1]); pw.y = cvt_pk_bf16(s[2 * c][2], s[2 * c][3]); pw.z = cvt_pk_bf16(s[2 * c + 1][0], s[2 * c + 1][1]); pw.w = cvt_pk_bf16(s[2 * c + 1][2], s[2 * c + 1][3]);
            const bf16x8 pf = __builtin_bit_cast(bf16x8, pw);
#pragma unroll
            for (int dt = 0; dt < 4; ++dt) o[dt] = __builtin_amdgcn_mfma_f32_16x16x32_bf16(vf[c & 1][dt], pf, o[dt], 0, 0, 0);
        }
    }
#undef AT_LOADV
    l_out = l;
}
__device__ __forceinline__ void kv_load(const bf16* K, const bf16* V, int n, int h, u32x4 (&kv)[4], u32x4 (&vv)[4], int tid, int wave, int lane) {
#pragma unroll
    for (int it = 0; it < 4; ++it) kv[it] = *(const u32x4*)(K + (size_t)(n * BS + it * 64 + (tid >> 3)) * D_ + h * 64 + (tid & 7) * 8);
#pragma unroll
    for (int it = 0; it < 4; ++it) vv[it] = *(const u32x4*)(V + (size_t)(n * BS + wave * 32 + (lane & 31)) * D_ + h * 64 + ((lane >> 5) * 4 + it) * 8);
}
__device__ __forceinline__ void kv_write(const u32x4 (&kv)[4], const u32x4 (&vv)[4], LAS unsigned char* lds, LAS unsigned* kmaxw, int tid, int wave, int lane) {
    float kn = 0.f;
#pragma unroll
    for (int it = 0; it < 4; ++it) { const int r = it * 64 + (tid >> 3), c16 = tid & 7, swz = (((r >> 1) & 1) << 1) | (((r >> 4) & 1) << 2);
        *(LAS u32x4*)(lds + A_KS + r * 128 + ((c16 ^ swz) * 16)) = kv[it];
        float sq = 0.f;
#pragma unroll
        for (int w = 0; w < 4; ++w) { const float a = bf_lo(kv[it][w]), b = bf_hi(kv[it][w]); sq = __builtin_fmaf(a, a, sq); sq = __builtin_fmaf(b, b, sq); }
        sq += shx(sq, 1, lane); sq += shx(sq, 2, lane); sq += shx(sq, 4, lane); kn = fmaxf(kn, sq); }
    kn = fmaxf(kn, shx(kn, 8, lane)); kn = fmaxf(kn, shx(kn, 16, lane)); kn = fmaxf(kn, shx(kn, 32, lane));
    if (lane == 0) __hip_atomic_fetch_max(kmaxw, __float_as_uint(kn), __ATOMIC_RELAXED, __HIP_MEMORY_SCOPE_WORKGROUP);
#pragma unroll
    for (int it = 0; it < 4; ++it) {
        const int key = wave * 32 + (lane & 31), pc = (lane >> 5) * 4 + it;
        const u32x4 v = vv[it];
        LAS unsigned char* vb = lds + A_VT + (pc * 8) * 512 + (key & 7) * 2; const int kc = key >> 3;
#define ST_VT(e, val) *(LAS unsigned short*)(vb + (e) * 512 + ((kc ^ (2 * (e))) * 16)) = (unsigned short)(val)
        ST_VT(0, v.x & 0xffffu); ST_VT(1, v.x >> 16); ST_VT(2, v.y & 0xffffu); ST_VT(3, v.y >> 16);
        ST_VT(4, v.z & 0xffffu); ST_VT(5, v.z >> 16); ST_VT(6, v.w & 0xffffu); ST_VT(7, v.w >> 16);
#undef ST_VT
    }
}
__device__ __forceinline__ bool alibi_dead(float slope2, int t, int n) { return slope2 * (float)(t - n * BS - (BS - 1)) >= 160.0f; }
__device__ __forceinline__ float head_slope2(int h) { return exp2f(-0.5f * (float)(h + 1)) * LOG2E; }

constexpr int SEL_NU = 1305;
__device__ const unsigned sel_unit_tab[SEL_NU] = {
    0x80406u, 0x80408u, 0x8040au, 0x8040bu, 0x8040cu, 0x8040du, 0x8040eu, 0x8040fu, 0xa0817u, 0xa0819u, 0xa081bu, 0xa081cu, 0xa081du, 0xa081eu, 0xa081fu, 0x12100bu,
    0x12100eu, 0x12100fu, 0x16141cu, 0x16144cu, 0x28240eu, 0x28240fu, 0x1a185au, 0x302c1cu, 0x302cacu, 0x1e1c6du, 0x1e1c6eu, 0x1e1c6fu, 0x22203bu, 0x22207bu, 0x22200du, 0xc0c27u,
    0xc0c09u, 0xc0c29u, 0xc0c2au, 0xc0c2bu, 0xc0c2cu, 0xc0c2du, 0xc0c2eu, 0xc0c2fu, 0x3c38ddu, 0x3c38deu, 0x3c38dfu, 0x68617bu, 0x56500eu, 0x56500fu, 0xa0814u, 0x26240bu,
    0x26248bu, 0x403c6du, 0x403c6eu, 0x403c6fu, 0x8079dcu, 0x8078ddu, 0x8079ddu, 0x8078deu, 0x8079deu, 0x8078dfu, 0x8079dfu, 0x262488u, 0x48440du, 0x2e2c4cu, 0x101008u, 0x101038u,
    0x10100au, 0x10103au, 0x10103bu, 0x10100cu, 0x10103cu, 0x10100du, 0x10103du, 0x10103eu, 0x10103fu, 0x48447bu, 0x6a658bu, 0x3230bcu, 0x4c491au, 0x6660acu, 0x3634c9u, 0x141419u,
    0x141449u, 0x14141bu, 0x14144bu, 0x14141du, 0x14144du, 0x14141eu, 0x14144eu, 0x14141fu, 0x14144fu, 0x3e3cedu, 0x3e3ceeu, 0x3e3cefu, 0x42403eu, 0x42407eu, 0x42403fu, 0x42407fu,
    0x18182au, 0x18182cu, 0x18185cu, 0x18182eu, 0x18182fu, 0x6c699bu, 0x141446u, 0x807decu, 0x807cedu, 0x807dedu, 0x807ceeu, 0x807deeu, 0x807cefu, 0x807defu, 0x52501eu, 0x52501fu,
    0x1c1c6au, 0x6864bcu, 0x20200au, 0x20200cu, 0x20203du, 0x20207du, 0x20203eu, 0x20207eu, 0x20203fu, 0x20207fu, 0x1c1c67u, 0x4e4d2au, 0x24248du, 0x24248eu, 0x24248fu, 0x28281bu,
    0x28289bu, 0x28281du, 0x28281eu, 0x28281fu, 0x6e6dabu, 0x30302cu, 0x30305cu, 0x3434ccu, 0x3838dcu, 0x40400cu, 0x40403du, 0x40407du, 0x4040fdu, 0x4040feu, 0x4040ffu, 0x282898u,
    0x6a68ccu, 0x3838d9u, 0x50501du, 0x8081fcu, 0x8080fdu, 0x8081fdu, 0x80806eu, 0x8080feu, 0x8081feu, 0x80806fu, 0x8080ffu, 0x8081ffu, 0x7071bbu, 0x34345au, 0x50513au, 0x80807du,
    0x101035u, 0x4a4c4eu, 0x4a4c4fu, 0x7275cbu, 0x46488du, 0x46488eu, 0x46488fu, 0x42450du, 0x42450eu, 0x42450fu, 0x7e806du, 0x3a3cecu, 0xc0c24u, 0x32346cu, 0x4a4c8bu, 0x2e302eu,
    0x2e302fu, 0x52554au, 0x3a3ce9u, 0x80860cu, 0x80850du, 0x80860du, 0x80843eu, 0x80847eu, 0x80850eu, 0x80860eu, 0x80843fu, 0x80847fu, 0x80850fu, 0x80860fu, 0x2a2c2bu, 0x2a2cabu,
    0x2a2c2du, 0x60404u, 0x60405u, 0x80815u, 0x80816u, 0x60407u, 0x80818u, 0x60409u, 0x8081au, 0x26284bu, 0x26284du, 0x26289du, 0x26284eu, 0x26289eu, 0x26284fu, 0x26289fu,
    0x5a5c4cu, 0x7479dbu, 0x585c2eu, 0x585c2fu, 0x36386au, 0x2a2ca8u, 0x1e203au, 0x1e207au, 0x1e203cu, 0x1e207cu, 0x262849u, 0x1e2077u, 0x1a1c69u, 0x1a1c1au, 0x1a1c6cu, 0x2e302au,
    0x484c4du, 0x484c9du, 0x484c9eu, 0x484c9fu, 0x6c70dcu, 0x44491du, 0x44491eu, 0x44491fu, 0x54595au, 0x767debu, 0x4c509bu, 0x161809u, 0x161829u, 0x161859u, 0x16182bu, 0x16185bu,
    0x16182du, 0x16185du, 0x16185eu, 0x16185fu, 0x3c40fcu, 0x5c605cu, 0x383c3cu, 0x383c7cu, 0x808a1cu, 0x80891du, 0x808a1du, 0x80891eu, 0x808a1eu, 0x80891fu, 0x808a1fu, 0x3c40f9u,
    0x40443bu, 0x161856u, 0x121428u, 0x121448u, 0x12144au, 0x6e74ecu, 0x7881fbu, 0x4e542du, 0x4a505du, 0x4a50adu, 0x4a505eu, 0x4a50aeu, 0x4a505fu, 0x4a50afu, 0x78803du, 0x565d6au,
    0x121417u, 0x2c30bbu, 0x383c7au, 0x5e646cu, 0x464d2du, 0x464d2eu, 0x464d2fu, 0x4e54abu, 0x42491cu, 0x282c5bu, 0x282c5du, 0x282cadu, 0x282c5eu, 0x282caeu, 0x282c5fu, 0x282cafu,
    0x7078fcu, 0x7a860bu, 0xe1037u, 0xe1018u, 0xe1039u, 0xe101au, 0x2c30b8u, 0x3e450cu, 0x282c59u, 0x24289au, 0x808e2cu, 0x808c8du, 0x808d2du, 0x808e2du, 0x808c8eu, 0x808d2eu,
    0x808e2eu, 0x808c8fu, 0x808d2fu, 0x808e2fu, 0x3e4509u, 0x3a408cu, 0x58617au, 0x7c8a1bu, 0x727d0cu, 0x5058bbu, 0x20244au, 0x20248au, 0x20248cu, 0xe1016u, 0x48513du, 0x48513eu,
    0x48513fu, 0x3238dbu, 0x202487u, 0x3a408au, 0x444d2cu, 0x7e8e2bu, 0x5a658au, 0x2e34cbu, 0x1c2079u, 0xa0c25u, 0xa0c26u, 0xa0c07u, 0xa0c28u, 0x404919u, 0x80923cu, 0x80909du,
    0x80913du, 0x80923du, 0x80909eu, 0x80913eu, 0x80923eu, 0x80909fu, 0x80913fu, 0x80923fu, 0x525ccbu, 0x2e34c8u, 0x2a306bu, 0x2a30bdu, 0x2a30beu, 0x2a30bfu, 0x80923bu, 0x60403u,
    0x80813u, 0x4a54bdu, 0x4a554du, 0x4a54beu, 0x4a554eu, 0x4a54bfu, 0x4a554fu, 0x56602cu, 0x1c2038u, 0x46513cu, 0x5c699au, 0x181c39u, 0x181c6bu, 0x121445u, 0x262caau, 0x343cebu,
    0x181c66u, 0x424d29u, 0x74851cu, 0x4c58cdu, 0x4c595du, 0x4c58ceu, 0x4c595eu, 0x4c58cfu, 0x4c595fu, 0x424c4bu, 0x80964bu, 0x80964cu, 0x8094adu, 0x8094bdu, 0x80954du, 0x80964du,
    0x80944eu, 0x80945eu, 0x8094aeu, 0x8094beu, 0x80954eu, 0x80964eu, 0x80944fu, 0x80945fu, 0x8094afu, 0x8094bfu, 0x80954fu, 0x80964fu, 0x5e6daau, 0x181c18u, 0x22289cu, 0x54601cu,
    0x48554cu, 0x222897u, 0x3a449cu, 0x141858u, 0x3038d8u, 0x76892cu, 0x2c34cdu, 0x2c34ceu, 0x2c34cfu, 0x6071bau, 0x141827u, 0x4e5d6du, 0x4e5d6eu, 0x4e5d6fu, 0x445139u, 0x3640fbu,
    0x64749cu, 0x1e2489u, 0x44505bu, 0x788d3cu, 0x60707cu, 0x4a595cu, 0x2830bau, 0x809a5bu, 0x809a5cu, 0x8098cdu, 0x80995du, 0x809a5du, 0x8098ceu, 0x80995eu, 0x809a5eu, 0x8098cfu,
    0x80995fu, 0x809a5fu, 0xe1034u, 0x7a904du, 0x6275cau, 0x2c341au, 0x5464dbu, 0x7a914cu, 0x1e2448u, 0x50617du, 0x50617eu, 0x50617fu, 0x465549u, 0x323ce8u, 0xa0c23u, 0x62748cu,
    0x7c945du, 0x46546bu, 0x4c5d6cu, 0x38450bu, 0x101447u, 0x6479dau, 0x7c955cu, 0x3c489au, 0x242ca7u, 0x5668ebu, 0x1a2076u, 0x809e6bu, 0x809e6cu, 0x809d6du, 0x809e6du, 0x809d6eu,
    0x809e6eu, 0x809d6fu, 0x809e6fu, 0x101407u, 0x7e996cu, 0x485959u, 0x667deau, 0x101426u, 0x2a34cau, 0x4e617cu, 0x3440f8u, 0x202899u, 0x586cfbu, 0x809d7cu, 0x3a491bu, 0x2a3469u,
    0x3e4caau, 0x141855u, 0x6881fau, 0x202819u, 0x4a5d69u, 0x161c68u, 0x50658cu, 0x50658du, 0x50658eu, 0x50658fu, 0x202858u, 0x5a710bu, 0x80a27bu, 0x80a18cu, 0x80a27cu, 0x80a17du,
    0x80a18du, 0x80a27du, 0x80a17eu, 0x80a18eu, 0x80a27eu, 0x80a17fu, 0x80a18fu, 0x80a27fu, 0x161c37u, 0x6a860au, 0x2630b7u, 0x4050bau, 0x3c4d2bu, 0x364508u, 0x303c3au, 0x2c38dau,
    0x4c6179u, 0x52699cu, 0x52699du, 0x52699eu, 0x52699fu, 0x5c751bu, 0x6c8a1au, 0x2c3879u, 0x72900du, 0x1c2486u, 0x222ca9u, 0xc1036u, 0x6e8e2au, 0x80a68bu, 0x80a59cu, 0x80a68cu,
    0x80a59du, 0x80a68du, 0x80a41eu, 0x80a59eu, 0x80a68eu, 0x80a41fu, 0x80a59fu, 0x80a68fu, 0xa0c05u, 0x5e792bu, 0x546dacu, 0x546dadu, 0x546daeu, 0x546dafu, 0x4254cau, 0x4e6589u,
    0x3e513bu, 0x384918u, 0x44595bu, 0x222c29u, 0x32404au, 0x2834c7u, 0x58703cu, 0x70923au, 0x222c68u, 0x2e3ceau, 0x607d3bu, 0x5671bcu, 0x5671bdu, 0x5671beu, 0x5671bfu, 0x121857u,
    0x506999u, 0x2e3c89u, 0x4458dau, 0x101444u, 0x72964au, 0xc1006u, 0x40554bu, 0x465d6bu, 0x182078u, 0x62814bu, 0x161c65u, 0x80aa9bu, 0x80a9acu, 0x80aa9cu, 0x80a9adu, 0x80aa9du,
    0x80a9aeu, 0x80aa9eu, 0x80a9afu, 0x80aa9fu, 0x3a4d28u, 0x5875ccu, 0x5875cdu, 0x5875ceu, 0x5875cfu, 0x3a4c0bu, 0x121836u, 0x182047u, 0x526da9u, 0x749a5au, 0x2430b9u, 0x3040fau,
    0x465ceau, 0x1e2896u, 0x2a38d7u, 0x769e6au, 0x243039u, 0x304099u, 0x769c2du, 0x5471b9u, 0x243078u, 0x60402u, 0x80812u, 0x3c5138u, 0x3c501bu, 0x78a27au, 0x80aeabu, 0x80adbcu,
    0x80aeacu, 0x80adbdu, 0x80aeadu, 0x80ac0eu, 0x80adbeu, 0x80aeaeu, 0x80ac0fu, 0x80adbfu, 0x80aeafu, 0x4860fau, 0x5675c9u, 0xc1033u, 0x32450au, 0x7aa68au, 0x3e5548u, 0x2c3ce7u,
    0x3244a9u, 0xa0c22u, 0x3e542bu, 0x4a650au, 0x7caa9au, 0x5879d9u, 0x64895bu, 0x202ca6u, 0x1a2457u, 0x7eaeaau, 0x182075u, 0x80b2bbu, 0x80b1ccu, 0x80b2bcu, 0x80b1cdu, 0x80b2bdu,
    0x80b02eu, 0x80b1ceu, 0x80b2beu, 0x80b02fu, 0x80b1cfu, 0x80b2bfu, 0x405958u, 0x668d6bu, 0x5a7de9u, 0x80b2bau, 0x3448b9u, 0x2e40f7u, 0x1a2428u, 0x74a01du, 0x121854u, 0x5c81f9u,
    0x425d68u, 0x80b6cau, 0x80b6cbu, 0x80b6ccu, 0x80b6cdu, 0x80b6ceu, 0x80b6cfu, 0x5e8609u, 0x2230b6u, 0x304507u, 0x446178u, 0x608a19u, 0xc1015u, 0x1a2485u, 0x628e29u, 0x466588u,
    0x324917u, 0x80badau, 0x80badbu, 0x80badcu, 0x80baddu, 0x80badeu, 0x80badfu, 0x2434c6u, 0x649239u, 0x486998u, 0x669649u, 0xe1443u, 0x344d27u, 0x141c64u, 0x162008u, 0x4a6da8u,
    0x689a59u, 0x1e2c09u, 0x80beeau, 0x80beebu, 0x80beecu, 0x80beedu, 0x80beeeu, 0x80beefu, 0x1c2895u, 0x2638d6u, 0x6a9e69u, 0x4c71b8u, 0x365137u, 0x6ca279u, 0x4e75c8u, 0xc1032u,
    0x6ea689u, 0x385547u, 0x283ce6u, 0x80c2fau, 0x80c2fbu, 0x80c2fcu, 0x80c2fdu, 0x80c2feu, 0x80c2ffu, 0x70aa99u, 0x40401u, 0x60811u, 0x80c21u, 0x5079d8u, 0x1e2ca5u, 0x72aea9u,
    0x162074u, 0x3a5957u, 0x527de8u, 0xe1425u, 0x74b2b9u, 0x2a40f6u, 0x76b6c9u, 0x101853u, 0x5481f8u, 0x80c70au, 0x80c70bu, 0x80c70cu, 0x80c70du, 0x80c70eu, 0x80c70fu, 0x3c5d67u,
    0x78bad9u, 0x568608u, 0x2030b5u, 0x7abee9u, 0x2c4506u, 0x2a400au, 0x3e6177u, 0x588a18u, 0x7cc2f9u, 0x182484u, 0x7ec709u, 0x5a8e28u, 0x80cb1au, 0x80cb1bu, 0x80cb1cu, 0x80cb1du,
    0x80cb1eu, 0x80cb1fu, 0x406587u, 0x80cb19u, 0x2e4916u, 0x2234c5u, 0x5c9238u, 0x426997u, 0x5e9648u, 0xe1442u, 0x304d26u, 0x121c63u, 0x446da7u, 0x609a58u, 0x52800cu, 0x80cf29u,
    0x80cf2au, 0x80cf2bu, 0x80cf2cu, 0x80cf2du, 0x80cf2eu, 0x80cf2fu, 0x1a2894u, 0x2438d5u, 0x629e68u, 0x4671b7u, 0x325136u, 0x64a278u, 0x4875c7u, 0x66a688u, 0xa1031u, 0x345546u,
    0x263ce5u, 0x68aa98u, 0x4a79d7u, 0x80d339u, 0x80d33au, 0x80d33bu, 0x80d33cu, 0x80d33du, 0x80d33eu, 0x80d33fu, 0x1c2ca4u, 0x6aaea8u, 0x142073u, 0x365956u, 0x4c7de7u, 0x6cb2b8u,
    0x40400u, 0x60810u, 0x80c20u, 0x2840f5u, 0x6eb6c8u, 0x4e81f7u, 0x101852u, 0x385d66u, 0x70bad8u, 0x508607u, 0x1e30b4u, 0x72bee8u, 0x2a4505u, 0x80d749u, 0x80d74au, 0x80d74bu,
    0x80d74cu, 0x80d74du, 0x80d74eu, 0x80d74fu, 0x3a6176u, 0x528a17u, 0x74c2f8u, 0x162483u, 0x76c708u, 0x548e27u, 0x3c6586u, 0x78cb18u, 0x2c4915u, 0x2034c4u, 0x569237u, 0x7acf28u,
    0x3e6996u, 0x7cd338u, 0x589647u, 0xc1441u, 0x2e4d25u, 0x80db59u, 0x80db5au, 0x80db5bu, 0x80db5cu, 0x80db5du, 0x80db5eu, 0x80db5fu, 0x7ed748u, 0x121c62u, 0x406da6u, 0x5a9a57u,
    0x80db58u, 0x182893u, 0x2238d4u, 0x5c9e67u, 0x4271b6u, 0x305135u, 0x5ea277u, 0x4475c6u, 0x60a687u, 0x325545u, 0x243ce4u, 0x62aa97u, 0x4679d6u, 0x80df68u, 0x80df69u, 0x80df6au,
    0x80df6bu, 0x80df6cu, 0x80df6du, 0x80df6eu, 0x80df6fu, 0xa1030u, 0x1a2ca3u, 0x64aea7u, 0x142072u, 0x80c04u, 0x345955u, 0x487de6u, 0x66b2b7u, 0x2640f4u, 0x68b6c7u, 0x4a81f6u,
    0xe1851u, 0x365d65u, 0x6abad7u, 0x4c8606u, 0x1c30b3u, 0x6cbee7u, 0x284504u, 0x386175u, 0x4e8a16u, 0x6ec2f7u, 0x80e378u, 0x80e379u, 0x80e37au, 0x80e37bu, 0x80e37cu, 0x80e37du,
    0x80e37eu, 0x80e37fu, 0x70c707u, 0x162482u, 0x508e26u, 0x3a6585u, 0x72cb17u, 0x2a4914u, 0x529236u, 0x1e34c3u, 0x74cf27u, 0x3c6995u, 0x76d337u, 0x549646u, 0x2c4d24u, 0x78d747u,
    0x101c61u, 0x569a56u, 0x3e6da5u, 0xc1440u, 0x7adb57u, 0x182892u, 0x2038d3u, 0x589e66u, 0x7cdf67u, 0x4071b5u, 0x2e5134u, 0x7ee377u, 0x5aa276u, 0x80e788u, 0x80e789u, 0x80e78au,
    0x80e78bu, 0x80e78cu, 0x80e78du, 0x80e78eu, 0x80e78fu, 0x80e787u, 0x4275c5u, 0x5ca686u, 0x305544u, 0x223ce3u, 0x5eaa96u, 0x4479d5u, 0x1a2ca2u, 0x60aea6u, 0x122071u, 0x325954u,
    0x467de5u, 0x62b2b6u, 0x2440f3u, 0x64b6c6u, 0x4881f5u, 0x345d64u, 0x66bad6u, 0xe1850u, 0x4a8605u, 0x1c30b2u, 0x68bee6u, 0x264503u, 0x80eb97u, 0x80eb98u, 0x80eb99u, 0x80eb9au,
    0x80eb9bu, 0x80eb9cu, 0x80eb9du, 0x80eb9eu, 0x80eb9fu, 0x366174u, 0x4c8a15u, 0x6ac2f6u, 0x6cc706u, 0x142481u, 0x4e8e25u, 0x386584u, 0x6ecb16u, 0x284913u, 0x509235u, 0x1e34c2u,
    0x70cf26u, 0x3a6994u, 0x72d336u, 0x529645u, 0x74d746u, 0x2a4d23u, 0x549a55u, 0x3c6da4u, 0x76db56u, 0x101c60u, 0x162891u, 0x2038d2u, 0x569e65u, 0x78df66u, 0x3e71b4u, 0x2c5133u,
    0x7ae376u, 0x58a275u, 0x7ce786u, 0x4075c4u, 0x5aa685u, 0x80efa7u, 0x80efa8u, 0x80efa9u, 0x80efaau, 0x80efabu, 0x80efacu, 0x80efadu, 0x80efaeu, 0x80efafu, 0x7eeb96u, 0x2e5543u,
    0x223ce2u, 0x80efa6u, 0x5caa95u, 0x4279d4u, 0x182ca1u, 0x5eaea5u, 0x305953u, 0x447de4u, 0x60b2b5u, 0x122070u, 0x2440f2u, 0x62b6c5u, 0x4681f4u, 0x325d63u, 0x64bad5u, 0x488604u,
    0x1a30b1u, 0x66bee5u, 0x264502u, 0x346173u, 0x4a8a14u, 0x68c2f5u, 0x6ac705u, 0x4c8e24u, 0x366583u, 0x142480u, 0x6ccb15u, 0x284912u, 0x4e9234u, 0x1c34c1u, 0x6ecf25u, 0x386993u,
    0x70d335u, 0x80f3b6u, 0x80f3b7u, 0x80f3b8u, 0x80f3b9u, 0x80f3bau, 0x80f3bbu, 0x80f3bcu, 0x80f3bdu, 0x80f3beu, 0x80f3bfu, 0x509644u, 0x72d745u, 0x2a4d22u, 0x529a54u, 0x3a6da3u,
    0x74db55u, 0x1e38d1u, 0x549e64u, 0x76df65u, 0x162890u, 0x3c71b3u, 0x2c5132u, 0x78e375u, 0x56a274u, 0x7ae785u, 0x3e75c3u, 0x58a684u, 0x7ceb95u, 0x2e5542u, 0x203ce1u, 0x7eefa5u,
    0x5aaa94u, 0x4079d3u, 0x80f3b5u, 0x5caea4u, 0x182ca0u, 0x305952u, 0x427de3u, 0x5eb2b4u, 0x2240f1u, 0x60b6c4u, 0x4481f3u, 0x325d62u, 0x62bad4u, 0x468603u, 0x64bee4u, 0x1a30b0u,
    0x244501u, 0x346172u, 0x488a13u, 0x66c2f4u, 0x68c704u, 0x4a8e23u, 0x366582u, 0x80f7c5u, 0x80f7c6u, 0x80f7c7u, 0x80f7c8u, 0x80f7c9u, 0x80f7cau, 0x80f7cbu, 0x80f7ccu, 0x80f7cdu,
    0x80f7ceu, 0x80f7cfu, 0x6acb14u, 0x264911u, 0x4c9233u, 0x6ccf24u, 0x1c34c0u, 0x386992u, 0x6ed334u, 0x4e9643u, 0x70d744u, 0x284d21u, 0x509a53u, 0x3a6da2u, 0x72db54u, 0x74df64u,
    0x529e63u, 0x1e38d0u, 0x3c71b2u, 0x2a5131u, 0x76e374u, 0x54a273u, 0x78e784u, 0x3e75c2u, 0x56a683u, 0x7aeb94u, 0x2c5541u, 0x7cefa4u, 0x58aa93u, 0x203ce0u, 0x4079d2u, 0x7ef3b4u,
    0x5aaea3u, 0x80f7c4u, 0x2e5951u, 0x427de2u, 0x5cb2b3u, 0x5eb6c3u, 0x2240f0u, 0x4481f2u, 0x305d61u, 0x60bad3u, 0x468602u, 0x62bee3u, 0x326171u, 0x244500u, 0x488a12u, 0x64c2f3u,
    0x66c703u, 0x4a8e22u, 0x346581u, 0x68cb13u, 0x264910u, 0x4c9232u, 0x6acf23u, 0x366991u, 0x6cd333u, 0x4e9642u, 0x6ed743u, 0x284d20u, 0x509a52u, 0x80fbd4u, 0x80fbd5u, 0x80fbd6u,
    0x80fbd7u, 0x80fbd8u, 0x80fbd9u, 0x80fbdau, 0x80fbdbu, 0x80fbdcu, 0x80fbddu, 0x80fbdeu, 0x80fbdfu, 0x386da1u, 0x70db53u, 0x72df63u, 0x529e62u, 0x3a71b1u, 0x74e373u, 0x2a5130u,
    0x54a272u, 0x76e783u, 0x3c75c1u, 0x56a682u, 0x78eb93u, 0x7aefa3u, 0x2c5540u, 0x58aa92u, 0x3e79d1u, 0x7cf3b3u, 0x5aaea2u, 0x7ef7c3u, 0x407de1u, 0x80fbd3u, 0x2e5950u, 0x5cb2b2u,
    0x5eb6c2u, 0x4281f1u, 0x305d60u, 0x60bad2u, 0x448601u, 0x62bee2u, 0x326170u, 0x468a11u, 0x64c2f2u, 0x66c702u, 0x488e21u, 0x346580u, 0x68cb12u, 0x4a9231u, 0x6acf22u, 0x366990u,
    0x6cd332u, 0x4c9641u, 0x6ed742u, 0x4e9a51u, 0x386da0u, 0x70db52u, 0x72df62u, 0x509e61u, 0x74e372u, 0x3a71b0u, 0x52a271u, 0x76e782u, 0x54a681u, 0x78eb92u, 0x3c75c0u, 0x7aefa2u,
    0x56aa91u, 0x7cf3b2u, 0x3e79d0u, 0x58aea1u, 0x7ef7c2u, 0x80fbd2u, 0x407de0u, 0x5ab2b1u, 0x5cb6c1u, 0x4281f0u, 0x5ebad1u, 0x448600u, 0x60bee1u, 0x62c2f1u, 0x468a10u, 0x64c701u,
    0x488e20u, 0x66cb11u, 0x4a9230u, 0x68cf21u, 0x6ad331u, 0x4c9640u, 0x6cd741u, 0x4e9a50u, 0x6edb51u, 0x80ffe2u, 0x80ffe3u, 0x80ffe4u, 0x80ffe5u, 0x80ffe6u, 0x80ffe7u, 0x80ffe8u,
    0x80ffe9u, 0x80ffeau, 0x80ffebu, 0x80ffecu, 0x80ffedu, 0x80ffeeu, 0x80ffefu, 0x70df61u, 0x509e60u, 0x72e371u, 0x52a270u, 0x74e781u, 0x76eb91u, 0x54a680u, 0x78efa1u, 0x56aa90u,
    0x7af3b1u, 0x58aea0u, 0x7cf7c1u, 0x7efbd1u, 0x5ab2b0u, 0x80ffe1u, 0x5cb6c0u, 0x5ebad0u, 0x60bee0u, 0x62c2f0u, 0x64c700u, 0x66cb10u, 0x68cf20u, 0x6ad330u, 0x6cd740u, 0x6edb50u,
    0x70df60u, 0x72e370u, 0x74e780u, 0x76eb90u, 0x78efa0u, 0x7af3b0u, 0x7cf7c0u, 0x7efbd0u, 0x80ffe0u,
};
__device__ __forceinline__ void phase_attn_sel(const bf16* Q, const bf16* K, const bf16* V, const unsigned* sel, const float* qn2, bf16* part0, bf16* part12, float* lse, gu32* qctr, LAS unsigned char* lds, const int wave0, bool nostore = false) {
    int tid = wave0 * 64 + mk_lane(); asm volatile("" : "+v"(tid)); const int lane = tid & 63, wave = __builtin_amdgcn_readfirstlane(tid >> 6);
    const int fr = lane & 15, fq = lane >> 4;
    LAS unsigned* cw = (LAS unsigned*)(lds + A_CNT);
    LAS unsigned short* list = (LAS unsigned short*)(lds + A_LIST);
    constexpr int NU = SEL_NU;
    if (tid == 0) { cw[4] = __hip_atomic_fetch_add(qctr, 1u, RLX_AGENT); cw[0] = 0u; cw[1] = 0u; cw[2] = 0u; cw[3] = 0u; }
    __syncthreads();
    int unit = (int)cw[4];
    for (int par = 0; unit < NU; par ^= 1) {
        const unsigned te = sel_unit_tab[unit];
        const int h = (int)(te & 15u), n = (int)((te >> 4) & 63u), jlo = (int)((te >> 10) & 127u), jhi = (int)((te >> 17) & 127u);
        const float slope2 = head_slope2(h);
        LAS unsigned* lcnt = cw + par;
        u32x4 kv[4], vv[4];
        kv_load(K, V, n, h, kv, vv, tid, wave, lane);
        const int tbase = jlo * BS, tlim = min(min(S_, jhi * BS), n * BS + BS + (int)(160.0f / slope2) + 1);
        unsigned sv[32];
#pragma unroll
        for (int i = 0; i < 32; ++i) { const int t = tbase + i * 512 + tid; sv[i] = 0xffffffffu; if (tbase + i * 512 < tlim) { if (t < tlim) sv[i] = sel[(size_t)h * S_ + t]; } }
        kv_write(kv, vv, lds, cw + 2 + par, tid, wave, lane);
        if (tid == 0) { cw[4 + (par ^ 1)] = __hip_atomic_fetch_add(qctr, 1u, RLX_AGENT); cw[par ^ 1] = 0u; cw[2 + (par ^ 1)] = 0u; }
        unsigned long long code = 0ull; int total = 0;
#pragma unroll
        for (int i = 0; i < 32; ++i) {
            if (tbase + i * 512 < tlim) {
                const unsigned s = sv[i];
                unsigned k1 = (s & 0xffu) == (unsigned)n ? 1u : ((s >> 8) & 0xffu) == (unsigned)n ? 2u : ((s >> 16) & 0xffu) == (unsigned)n ? 3u : 0u;
                if (alibi_dead(slope2, tbase + i * 512 + tid, n)) k1 = 0u;
                code |= (unsigned long long)k1 << (2 * i);
                total += __popcll(__ballot(k1 != 0u));
            }
        }
        unsigned wbase = 0u; if (lane == 0 && total) wbase = __hip_atomic_fetch_add(lcnt, (unsigned)total, __ATOMIC_RELAXED, __HIP_MEMORY_SCOPE_WORKGROUP);
        wbase = (unsigned)__builtin_amdgcn_readfirstlane((int)wbase);
#pragma unroll
        for (int i = 0; i < 32; ++i) {
            if (tbase + i * 512 < tlim) {
                const unsigned k1 = (unsigned)(code >> (2 * i)) & 3u;
                const unsigned long long bal = __ballot(k1 != 0u);
                if (bal) {
                    const unsigned pre = __builtin_amdgcn_mbcnt_hi((unsigned)(bal >> 32), __builtin_amdgcn_mbcnt_lo((unsigned)bal, 0u));
                    if (k1) list[wbase + pre] = (unsigned short)((tbase + i * 512 + tid) | ((k1 - 1u) << 14));
                    wbase += (unsigned)__popcll(bal);
                }
            }
        }
        __syncthreads();
        const int N = (int)*lcnt, ntiles = (N + 15) >> 4;
        const float kmax2 = __uint_as_float(cw[2 + par]);
        const int nunit = (int)cw[4 + (par ^ 1)];
        int tile = wave; bool valid = false; int t = 0, k = 0; bf16x8 q0 = {}, q1 = {}; float qn = 0.f;
        if (tile < ntiles) { int idx = tile * 16 + fr; valid = idx < N; if (!valid) idx = N - 1; const unsigned e = list[idx]; t = (int)(e & 0x3fffu); k = (int)(e >> 14);
            const bf16* qrow = Q + (size_t)t * D_ + h * 64; q0 = *(const bf16x8*)(qrow + 8 * fq); q1 = *(const bf16x8*)(qrow + 32 + 8 * fq); qn = qn2[(size_t)h * S_ + t]; }
        while (tile < ntiles) {
            const int ntile = tile + NWAVES; bool nvalid = false; int nt = 0, nk = 0; bf16x8 nq0 = {}, nq1 = {}; float nqn = 0.f;
            if (ntile < ntiles) { int idx = ntile * 16 + fr; nvalid = idx < N; if (!nvalid) idx = N - 1; const unsigned e = list[idx]; nt = (int)(e & 0x3fffu); nk = (int)(e >> 14);
                const bf16* qrow = Q + (size_t)nt * D_ + h * 64; nq0 = *(const bf16x8*)(qrow + 8 * fq); nq1 = *(const bf16x8*)(qrow + 32 + 8 * fq); nqn = qn2[(size_t)h * S_ + nt]; }
            const float m = __builtin_amdgcn_sqrtf(qn * kmax2) * 1.0005f + 0.01f;
            const float lcm = slope2 * (float)(n * BS + 8 * fq - t) - m;
            f32x4 o[4]; float l;
            attn_tile<false>(lds + A_KS, lds + A_VT, q0, q1, lcm, slope2, 0, 8, fr, fq, o, l);
            const float il = l > 0.f ? 1.0f / l : 0.f;
            {
                LAS unsigned char* ost = lds + A_OST + wave * (16 * A_OPITCH);
#pragma unroll
                for (int dt = 0; dt < 4; ++dt) { u32x2 w; w.x = cvt_pk_bf16(o[dt][0] * il, o[dt][1] * il); w.y = cvt_pk_bf16(o[dt][2] * il, o[dt][3] * il); *(LAS u32x2*)(ost + fr * A_OPITCH + (16 * dt + 4 * fq) * 2) = w; }
                LDS_WAIT(); asm volatile("" ::: "memory");
#pragma unroll
                for (int i = 0; i < 2; ++i) {
                    const int q = (lane >> 3) + 8 * i, p = lane & 7;
                    const u32x4 v = *(LAS const u32x4*)(ost + q * A_OPITCH + p * 16);
                    const int tq = shi(t, q), kq = shi(k, q), vq = shi((int)valid, q);
                    if (vq && !nostore) *(u32x4*)((kq == 0 ? part0 : part12 + (size_t)(kq - 1) * S_ * D_) + (size_t)tq * D_ + h * 64 + p * 8) = v;
                }
                if (valid && fq == 0) lse[((size_t)k * S_ + t) * NH + h] = m + __builtin_amdgcn_logf(l);
                LDS_WAIT(); asm volatile("" ::: "memory");
            }
            tile = ntile; valid = nvalid; t = nt; k = nk; q0 = nq0; q1 = nq1; qn = nqn;
        }
        __syncthreads();
        unit = nunit;
    }
}
__device__ __forceinline__ void phase_attn_own(bf16* Q, const bf16* K, const bf16* V, const unsigned* sel, const float* qn2, const bf16* part0, const bf16* part12, const float* lse, LAS unsigned char* lds, const int wave0, bool nostore = false) {
    int tid = wave0 * 64 + mk_lane(); asm volatile("" : "+v"(tid)); const int lane = tid & 63, wave = __builtin_amdgcn_readfirstlane(tid >> 6);
    const int fr = lane & 15, fq = lane >> 4;
    LAS unsigned* cw = (LAS unsigned*)(lds + A_CNT);
    if (tid == 0) { cw[2] = 0u; cw[3] = 0u; }
    __syncthreads();
    int par = 0;
    for (int unit = blockIdx.x; unit < NBLK * NH; unit += gridDim.x, par ^= 1) {
        const int j = unit >> 4, h = ((unit & 15) + 4 * (unit >> 8)) & 15;
        u32x4 kv[4], vv[4];
        kv_load(K, V, j, h, kv, vv, tid, wave, lane);
        kv_write(kv, vv, lds, cw + 2 + par, tid, wave, lane);
        if (tid == 0) cw[2 + (par ^ 1)] = 0u;
        __syncthreads();
        const float kmax2 = __uint_as_float(cw[2 + par]);
        const float slope2 = head_slope2(h);
        const int nv = j < 3 ? j : 3;
        for (int half = 0; half < 2; ++half) {
            const int tile = half ? 15 - wave : wave;
            const int tq = tile * 16 + fr, t = j * BS + tq;
            const bf16* qrow = Q + (size_t)t * D_ + h * 64;
            const bf16x8 q0 = *(const bf16x8*)(qrow + 8 * fq), q1 = *(const bf16x8*)(qrow + 32 + 8 * fq);
            float lk[3]; u32x2 pv[3][4];
            const unsigned selw = nv > 0 ? sel[(size_t)h * S_ + t] : 0xffffffffu;
#pragma unroll
            for (int k = 0; k < 3; ++k) {
                lk[k] = -INFINITY;
#pragma unroll
                for (int dt = 0; dt < 4; ++dt) pv[k][dt] = (u32x2){0u, 0u};
                if (k < nv && !alibi_dead(slope2, t, (int)((selw >> (8 * k)) & 0xffu))) {
                    lk[k] = lse[((size_t)k * S_ + t) * NH + h];
                    const bf16* pp = (k == 0 ? part0 : part12 + (size_t)(k - 1) * S_ * D_) + (size_t)t * D_ + h * 64 + 4 * fq;
#pragma unroll
                    for (int dt = 0; dt < 4; ++dt) pv[k][dt] = *(const u32x2*)(pp + dt * 16);
                }
            }
            const float m = __builtin_amdgcn_sqrtf(qn2[(size_t)h * S_ + t] * kmax2) * 1.0005f + 0.01f;
            const float lcm = slope2 * (float)(8 * fq - tq) - m;
            f32x4 o[4]; float l;
            attn_tile<true>(lds + A_KS, lds + A_VT, q0, q1, lcm, slope2, tq, (tile >> 1) + 1, fr, fq, o, l);
            const float lown = m + __builtin_amdgcn_logf(l), il = 1.0f / l;
            const float M = fmaxf(fmaxf(lown, lk[0]), fmaxf(lk[1], lk[2]));
            const float e0 = __builtin_amdgcn_exp2f(lown - M), w0 = e0 * il;
            float wsum = e0;
#pragma unroll
            for (int dt = 0; dt < 4; ++dt) o[dt] = o[dt] * w0;
#pragma unroll
            for (int k = 0; k < 3; ++k) {
                const float wk = __builtin_amdgcn_exp2f(lk[k] - M);
                wsum += wk;
#pragma unroll
                for (int dt = 0; dt < 4; ++dt) { o[dt][0] += wk * bf_lo(pv[k][dt].x); o[dt][1] += wk * bf_hi(pv[k][dt].x); o[dt][2] += wk * bf_lo(pv[k][dt].y); o[dt][3] += wk * bf_hi(pv[k][dt].y); }
            }
            const float inv = 1.0f / wsum;
            {
                LAS unsigned char* ost = lds + A_OST + wave * (16 * A_OPITCH);
#pragma unroll
                for (int dt = 0; dt < 4; ++dt) { u32x2 w; w.x = cvt_pk_bf16(o[dt][0] * inv, o[dt][1] * inv); w.y = cvt_pk_bf16(o[dt][2] * inv, o[dt][3] * inv); *(LAS u32x2*)(ost + fr * A_OPITCH + (16 * dt + 4 * fq) * 2) = w; }
                LDS_WAIT(); asm volatile("" ::: "memory");
#pragma unroll
                for (int i = 0; i < 2; ++i) {
                    const int q = (lane >> 3) + 8 * i, p = lane & 7;
                    const u32x4 v = *(LAS const u32x4*)(ost + q * A_OPITCH + p * 16);
                    if (!nostore) *(u32x4*)(Q + (size_t)(j * BS + tile * 16 + q) * D_ + h * 64 + p * 8) = v;
                }
                LDS_WAIT(); asm volatile("" ::: "memory");
            }
        }
        __syncthreads();
    }
}
struct Args { const float* in[10]; float* out; unsigned char* ws; };
typedef const __attribute__((address_space(4))) Args* CArgsP;
__device__ __forceinline__ CArgsP KA() { unsigned long long p = (unsigned long long)__builtin_amdgcn_kernarg_segment_ptr(); asm volatile("" : "+s"(p)); return (CArgsP)p; }
__device__ __forceinline__ Ptrs make_ptrs(CArgsP a) { Ptrs P; P.x = a->in[0]; P.ln = a->in[1]; P.wg = a->in[2]; P.wu = a->in[3]; P.wd = a->in[4]; P.wqkv = a->in[5]; P.wo = a->in[6]; P.pw = a->in[7]; P.ps = a->in[8]; P.fg = a->in[9]; P.out = a->out; P.ws = a->ws; return P; }
__device__ __forceinline__ void phase_tailconv(LAS unsigned char* lds, int f, const int wave0) {
    int tid = wave0 * 64 + mk_lane(); asm volatile("" : "+v"(tid)); const int lane = tid & 63, wave = __builtin_amdgcn_readfirstlane(tid >> 6);
    const Ptrs P = make_ptrs(KA());
    const int ww = ((int)blockIdx.x - 128) * NWAVES + wave, n_ww = 128 * NWAVES;
    convert_items(P, lds, (f + 1) * IT_FFN, (f + 2) * IT_FFN, ww, n_ww, wave, lane);
    if (f == 0) { convert_items(P, lds, 8 * IT_FFN, 8 * IT_FFN + IT_ATT, ww, n_ww, wave, lane); convert_items(P, lds, 8 * IT_FFN + 2 * IT_ATT, IT_TOTAL, ww, n_ww, wave, lane); }
    if (f == 2) convert_items(P, lds, 8 * IT_FFN + IT_ATT, 8 * IT_FFN + IT_ATT + IT_ATT / 2, ww, n_ww, wave, lane);
    if (f == 3) convert_items(P, lds, 8 * IT_FFN + IT_ATT + IT_ATT / 2, 8 * IT_FFN + 2 * IT_ATT, ww, n_ww, wave, lane);
}
__global__ void __launch_bounds__(NWAVES * 64, 2) mk_fwd(Args args) {
    extern __shared__ __attribute__((aligned(16))) unsigned char lds_raw[];
    LAS unsigned char* lds = (LAS unsigned char*)lds_raw;
    volatile LAS unsigned* MISC = (volatile LAS unsigned*)(lds + MISC_OFF);
    const int G = gridDim.x;
    gu32* ctl = (gu32*)(KA()->ws + WS_CTL);
    for (int u = threadIdx.x; u < (LDS_BYTES - LDSCTL_OFF) / 4; u += NWAVES * 64) ((LAS unsigned*)(lds + LDSCTL_OFF))[u] = 0u;
    __syncthreads();
    const int wave0 = __builtin_amdgcn_readfirstlane((int)threadIdx.x >> 6);
    XcdBarrier bar = xcd_barrier_post((unsigned*)(ctl + CW_BAR), MISC + 8, wave0 == 0 && mk_lane() == 0);
    (void)bar;
#define GRID_BAR() do { unsigned long long wsl_ = (unsigned long long)KA()->ws; XcdBarrier b_; b_.bar = (unsigned*)(wsl_ + WS_CTL) + CW_BAR; b_.x = xb_xcc_id(); \
        b_.st = (volatile LAS unsigned*)(lds + MISC_OFF) + 8; xcd_barrier(b_, wave0 == 0 && mk_lane() == 0); } while (0)
#define NREP(p) ((PROBE == (p)) ? 2 : 1)
    for (int rep = 0; rep < NREP(5); ++rep) { Ptrs P2 = make_ptrs(KA()); phase_prologue(P2, lds, wave0); GRID_BAR(); }
#define WSL() (KA()->ws)
#pragma clang loop unroll(full)
    for (int f = 0; f < 8; ++f) {
        for (int rep = 0; rep < NREP(3) * NREP(13); ++rep) {
            unsigned char* w = WSL();
            pg8::Gemm g{(const bf16*)(w + WS_XB), ws_wgu(w, f), S_, NGU, D_}; pg8::StaticOrder S; S.init(S_, NGU, G, (int)blockIdx.x);
            rstd_table(lds, (const float*)(w + ((f & 3) == 3 ? WS_SSQB : WS_SSQ)), S, wave0);
            EpiSwiGLU E{(bf16*)(w + ((PROBE == 13 && rep == 0) ? WS_END : WS_BIG)), (LAS const float*)(lds + RSTD_OFF), PROBE == 13 && rep == 0};
            pg8::gemm_phase<EpiSwiGLU, pg8::StaticOrder, PG8_ALIGN, PG8_SP2>(lds, g, S, E, wave0);
            if (TAILCONV && G == 256 && rep == 0 && f < 7 && blockIdx.x >= 128) phase_tailconv(lds, f, wave0);
            GRID_BAR();
        }
        for (int rep = 0; rep < NREP(4) * NREP(14) * NREP(24) * NREP(25); ++rep) {
            unsigned char* w = WSL();
            pg8::Gemm g{(const bf16*)(w + WS_BIG), ws_wd(w, f), S_, D_, FF_}; pg8::StaticOrder S; S.init(S_, D_, G, (int)blockIdx.x);
            EpiResid<false, 1> E{(bf16*)(w + WS_XB), (float*)(w + WS_SSQ), nullptr, (f & 3) == 2 ? (bf16*)(w + WS_HALO) : nullptr};
            pg8::gemm_phase<EpiResid<false, 1>, pg8::StaticOrder, false, PG8_SP2>(lds, g, S, E, wave0);
            GRID_BAR();
        }
        if ((f & 1) == 0) {
            const int L = f >> 1, mi = L >> 1;
            if ((L & 1) == 0) {
                for (int rep = 0; rep < NREP(6); ++rep) {
                    unsigned char* w = WSL();
                    pg8::Gemm g{(const bf16*)(w + WS_XB), ws_wqkv(w, mi), S_, 3 * D_, D_}; pg8::StaticOrder S; S.init(S_, 3 * D_, G, (int)blockIdx.x);
                    rstd_table(lds, (const float*)(w + WS_SSQ), S, wave0);
                    EpiQKV E{(bf16*)(w + WS_BIG), (LAS const float*)(lds + RSTD_OFF), (float*)(w + WS_KPART)};
                    pg8::gemm_phase<EpiQKV, pg8::StaticOrder, PG8_ALIGN, PG8_SP2>(lds, g, S, E, wave0);
                    GRID_BAR();
                }
                for (int rep = 0; rep < NREP(1); ++rep) {
                    for (int r2 = 0; r2 < NREP(7); ++r2) { unsigned char* w = WSL(); phase_gate((const bf16*)(w + WS_BIG), (const float*)(w + WS_KPART), (unsigned*)(w + WS_SEL), (float*)(w + WS_QN2), lds, wave0); GRID_BAR(); }
                    for (int r2 = 0; r2 < NREP(8) * NREP(18) * NREP(28) * NREP(29); ++r2) { unsigned char* w = WSL(); bf16* B = (bf16*)(w + WS_BIG);
                      phase_attn_sel(B, B + (size_t)S_ * D_, B + (size_t)2 * S_ * D_, (const unsigned*)(w + WS_SEL), (const float*)(w + WS_QN2), (bf16*)(w + WS_WFFN + (size_t)(mi == 0 ? 2 : 0) * WFFN_STRIDE), (bf16*)(w + WS_XB + 32 * MiB), (float*)(w + WS_LSE), (gu32*)(w + WS_CTL) + CW_QA + 64 * (mi + 2 * (rep + r2)), lds, wave0, (PROBE == 18 || PROBE == 28 || PROBE == 29) && r2 == 0 && ((const unsigned*)(w + WS_CTL))[2] == 0u);
                      GRID_BAR(); }
                    for (int r2 = 0; r2 < NREP(9); ++r2) { unsigned char* w = WSL(); bf16* B = (bf16*)(w + WS_BIG);
                      phase_attn_own(B, B + (size_t)S_ * D_, B + (size_t)2 * S_ * D_, (const unsigned*)(w + WS_SEL), (const float*)(w + WS_QN2), (const bf16*)(w + WS_WFFN + (size_t)(mi == 0 ? 2 : 0) * WFFN_STRIDE), (const bf16*)(w + WS_XB + 32 * MiB), (const float*)(w + WS_LSE), lds, wave0, (rep + r2 + 1) < NREP(1) * NREP(9));
                      GRID_BAR(); }
                }
                for (int rep = 0; rep < NREP(6); ++rep) {
                    unsigned char* w = WSL();
                    pg8::Gemm g{(const bf16*)(w + WS_BIG), ws_wo(w, mi), S_, D_, D_}; pg8::StaticOrder S; S.init(S_, D_, G, (int)blockIdx.x);
                    EpiResid<false, 2> E{(bf16*)(w + WS_XB), (float*)(w + WS_SSQ), nullptr, nullptr};
                    pg8::gemm_phase<EpiResid<false, 2>, pg8::StaticOrder, false, PG8_SP2>(lds, g, S, E, wave0);
                    GRID_BAR();
                }
            } else {
                for (int rep = 0; rep < NREP(2); ++rep) {
                    { unsigned char* w = WSL(); phase_pool_elem((const bf16*)(w + WS_XB), (const float*)(w + WS_SSQ), KA()->in[1] + (L * 3 + 1) * D_, (bf16*)(w + WS_BIG), (const bf16*)(w + WS_HALO), lds, wave0); }
                    {
                        unsigned char* w = WSL();
                        pg8::Gemm g{(const bf16*)(w + WS_BIG), ws_wp(w, mi), 4 * S_, 256, 256}; PoolOrder S{G, (int)blockIdx.x};
                        EpiResid<true, 2> E{(bf16*)(w + WS_XB), (float*)(w + WS_SSQB), KA()->in[8] + mi * D_, nullptr};
                        pg8::gemm_phase<EpiResid<true, 2>, PoolOrder, false, PG8_SP2>(lds, g, S, E, wave0);
                    }
                    GRID_BAR();
                }
            }
        }
    }
    { Ptrs P2 = make_ptrs(KA()); const bool poison = (__hip_atomic_load((gu32*)(P2.ws + WS_CTL) + CW_BAR + XB_TMO, RLX_AGENT) != 0u) || (G != 256);
      phase_final(P2, poison, wave0); }
}

extern "C" void kernel_launch(void* const* d_in, const int* in_sizes, int n_in, void* d_out, int out_size, void* d_ws, size_t ws_size, hipStream_t stream) {
    static int grid = 0;
    if (grid == 0) {
        if (n_in != 10 || in_sizes[0] != S_ * D_ || out_size != S_ * D_ || ws_size < WS_END) { fprintf(stderr, "kernel_launch: unexpected shapes / workspace (%zu < %zu)\n", ws_size, (size_t)WS_END); grid = -1; return; }
        int dev = 0, cus = 0, per_cu = 0;
        if (hipGetDevice(&dev) != hipSuccess || hipDeviceGetAttribute(&cus, hipDeviceAttributeMultiprocessorCount, dev) != hipSuccess) { grid = -1; return; }
        if (hipFuncSetAttribute((const void*)mk_fwd, hipFuncAttributeMaxDynamicSharedMemorySize, LDS_BYTES) != hipSuccess) { fprintf(stderr, "kernel_launch: hipFuncSetAttribute failed\n"); grid = -1; return; }
        if (hipOccupancyMaxActiveBlocksPerMultiprocessor(&per_cu, (const void*)mk_fwd, NWAVES * 64, LDS_BYTES) != hipSuccess || per_cu < 1) { fprintf(stderr, "kernel_launch: occupancy query says %d\n", per_cu); }
        (void)hipGetLastError();
        grid = cus;
    }
    if (grid < 0) return;
    if (hipMemsetAsync((char*)d_ws + WS_CTL, 0, CTL_ZERO_BYTES, stream) != hipSuccess) return;
    Args a{};
    for (int i = 0; i < 10; ++i) a.in[i] = (const float*)d_in[i];
    a.out = (float*)d_out; a.ws = (unsigned char*)d_ws;
    hipLaunchKernelGGL(mk_fwd, dim3(grid), dim3(NWAVES * 64), LDS_BYTES, stream, a);
}
```

```cpp
#include <hip/hip_runtime.h>
#include <cstdio>
#include <cstdint>
#include <type_traits>
__device__ __forceinline__ float shx(float v, int mask, int lane) { return __builtin_bit_cast(float, __builtin_amdgcn_ds_bpermute((lane ^ mask) << 2, __builtin_bit_cast(int, v))); }
__device__ __forceinline__ unsigned shxu(unsigned v, int mask, int lane) { return (unsigned)__builtin_amdgcn_ds_bpermute((lane ^ mask) << 2, (int)v); }
__device__ __forceinline__ int shi(int v, int src) { return __builtin_amdgcn_ds_bpermute(src << 2, v); }
__device__ __forceinline__ int mk_lane() { int l; asm volatile("v_mbcnt_lo_u32_b32 %0, -1, 0\n\tv_mbcnt_hi_u32_b32 %0, -1, %0" : "=v"(l)); return l; }
namespace pg8 {
#define PG8_LAS __attribute__((address_space(3)))
typedef unsigned short bf16_t;
typedef short bf16x8 __attribute__((ext_vector_type(8)));
typedef float f32x4 __attribute__((ext_vector_type(4)));
typedef unsigned u32x4 __attribute__((ext_vector_type(4)));
constexpr int BM = 256, BK = 64, HALF = 128, HTB = HALF * BK * 2  , STAGE_BYTES = 8 * HTB, NXCD = 8, WGM = 8;

__host__ __device__ __forceinline__ int lds_byte(int r, int c) { const int st = (r >> 4) * 2 + (c >> 5), rr = r & 15, cc = c & 31, ob = rr * 64 + cc * 2; return st * 1024 + (ob ^ (((ob >> 9) & 1) << 5)); }
__host__ __device__ __forceinline__ void stage_rc(int b, int& R, int& C) { const int st = b / 1024, sb = b % 1024, swz = sb ^ (((sb >> 9) & 1) << 5); R = (st >> 1) * 16 + swz / 64; C = (st & 1) * 32 + (swz % 64) / 2; }
__host__ __device__ __forceinline__ int perm32(int rho) { const int n = rho >> 4, i = rho & 15; return 8 * (i >> 2) + 4 * n + (i & 3); }

struct Unit { int pm, pn, idx; };
struct Gemm { const bf16_t* A; const bf16_t* Bt; int M, N, K; };

struct StaticOrder {
    int nM, nN, nwg, G, c;
    __host__ __device__ void init(int M, int N, int G_, int c_) { nM = M / BM; nN = N / BM; nwg = nM * nN; G = G_; c = c_; }
    __host__ __device__ bool next(int i, Unit& u) const {
        const long L = (long)i * G + c; if (L >= nwg) return false;
        int wgid = (int)L; { const int q = nwg / NXCD, r = nwg % NXCD, xcd = wgid % NXCD, off = wgid / NXCD; wgid = (xcd < r ? xcd * (q + 1) : r * (q + 1) + (xcd - r) * q) + off; }
        const int nig = WGM * nN, gid = wgid / nig, fm = gid * WGM, gsz = (nM - fm) < WGM ? (nM - fm) : WGM;
        u.pm = fm + ((wgid % nig) % gsz); u.pn = (wgid % nig) / gsz; u.idx = i; return true;
    }
    __device__ __forceinline__ void a_ready(const Unit&) const {}
    __device__ __forceinline__ void done(const Unit&) const {}
};

__device__ __forceinline__ unsigned cvt_pk_bf16(float lo, float hi) { unsigned r; asm volatile("v_cvt_pk_bf16_f32 %0, %1, %2" : "=v"(r) : "v"(lo), "v"(hi)); return r; }
typedef float f32x2 __attribute__((ext_vector_type(2)));
template <class Epi, class Sched, bool ALIGN_EPI = false, bool SP2 = false>
__device__ __forceinline__ void gemm_phase(PG8_LAS unsigned char* lds, const Gemm g, const Sched& S, const Epi& E, const int wave0) {
    int tid_ = wave0 * 64 + mk_lane(); asm volatile("" : "+v"(tid_));
    const int tid = tid_, wid = __builtin_amdgcn_readfirstlane(tid >> 6), lane = tid & 63, wr = wid >> 2, wc = wid & 3, fr = lane & 15, fq = lane >> 4;
    const int K = g.K, nt = K / BK;
    unsigned voffA[2], voffB[2];
#pragma unroll
    for (int i = 0; i < 2; ++i) { int R, C; stage_rc(tid * 16 + i * 8192, R, C); const int Rb = Epi::PERM ? ((R & ~31) + perm32(R & 31)) : R;
        voffA[i] = (unsigned)(R * K + C) * 2u; voffB[i] = (unsigned)(Rb * K + C) * 2u; }
    const size_t kstep = (size_t)(BK * 2);
    const size_t hstep = (size_t)HALF * K * 2;
    const size_t tstep = 2 * hstep;
    const unsigned ldsw = (unsigned)wid * 1024u;
    const int aoff = lds_byte(wr * 64 + fr, fq * 8), boff = lds_byte(wc * 32 + fr, fq * 8);
#define PG8_SA(b, h) (((b) * 2 + (h)) * HTB)
#define PG8_SB(b, h) ((4 + (b) * 2 + (h)) * HTB)
#define PG8_STAGE(bufoff, gbase, voff) do { _Pragma("unroll") for (int _i = 0; _i < 2; ++_i) \
        __builtin_amdgcn_global_load_lds((const unsigned*)((const char*)(gbase) + (voff)[_i]), (PG8_LAS unsigned*)(lds + (bufoff) + ldsw + _i * 8192), 16, 0, 0); } while (0)
#define PG8_LDA(dst, b, h) do { _Pragma("unroll") for (int m = 0; m < 4; ++m) _Pragma("unroll") for (int k = 0; k < 2; ++k) dst[m][k] = *(const PG8_LAS bf16x8*)(lds + PG8_SA(b, h) + aoff + m * 2048 + k * 1024); } while (0)
#define PG8_LDB(dst, b, h) do { _Pragma("unroll") for (int n = 0; n < 2; ++n) _Pragma("unroll") for (int k = 0; k < 2; ++k) dst[n][k] = *(const PG8_LAS bf16x8*)(lds + PG8_SB(b, h) + boff + n * 2048 + k * 1024); } while (0)
#define PG8_MMA(ai, bj, At, Bt) do { __builtin_amdgcn_s_setprio(1); _Pragma("unroll") for (int m = 0; m < 4; ++m) _Pragma("unroll") for (int n = 0; n < 2; ++n) _Pragma("unroll") for (int k = 0; k < 2; ++k) \
        acc[ai][bj][m][n] = __builtin_amdgcn_mfma_f32_16x16x32_bf16(Bt[n][k], At[m][k], acc[ai][bj][m][n], 0, 0, 0); __builtin_amdgcn_s_setprio(0); } while (0)
#define PG8_WAIT_V(n) asm volatile("s_waitcnt vmcnt(" #n ")" ::: "memory")
#define PG8_WAIT_L(n) asm volatile("s_waitcnt lgkmcnt(" #n ")" ::: "memory")
#define PG8_BAR __builtin_amdgcn_s_barrier()
#define PG8_SCHED __builtin_amdgcn_sched_barrier(0)
    Unit cur, nxt; int ui = 0;
    if (!S.next(0, cur)) return;
    f32x4 acc[2][2][4][2];
    typename Epi::Pre pre;
    if constexpr (Epi::PRELOAD) E.pre_issue(pre, cur, wr, wc, fr, fq);
    else {
#pragma unroll
    for (int a = 0; a < 2; ++a)
#pragma unroll
        for (int b = 0; b < 2; ++b)
#pragma unroll
            for (int m = 0; m < 4; ++m)
#pragma unroll
                for (int n = 0; n < 2; ++n) acc[a][b][m][n] = (f32x4){0.f, 0.f, 0.f, 0.f};
    }
    bf16x8 At[4][2], B0[2][2], B1[2][2];
    const char* cA = (const char*)g.A + (size_t)cur.pm * tstep; const char* cB = (const char*)g.Bt + (size_t)cur.pn * tstep;
    S.a_ready(cur);
    if constexpr (SP2) {
        PG8_STAGE(PG8_SB(0, 0), cB, voffB); PG8_STAGE(PG8_SB(0, 1), cB + hstep, voffB); PG8_STAGE(PG8_SA(0, 0), cA, voffA); PG8_STAGE(PG8_SA(0, 1), cA + hstep, voffA);
        if constexpr (Epi::PRELOAD) E.pre_finish(acc, pre);
        if (wr == 1) PG8_BAR;
        PG8_WAIT_V(2); PG8_BAR;
        PG8_STAGE(PG8_SB(1, 0), cB + kstep, voffB); PG8_STAGE(PG8_SA(1, 0), cA + kstep, voffA); PG8_STAGE(PG8_SB(1, 1), cB + hstep + kstep, voffB);
        PG8_WAIT_V(6); PG8_BAR;
    } else {
        PG8_STAGE(PG8_SB(0, 0), cB, voffB); PG8_STAGE(PG8_SA(0, 0), cA, voffA); PG8_STAGE(PG8_SB(0, 1), cB + hstep, voffB); PG8_STAGE(PG8_SA(0, 1), cA + hstep, voffA);
        if constexpr (Epi::PRELOAD) E.pre_finish(acc, pre);
        if (wr == 1) PG8_BAR;
        PG8_WAIT_V(4); PG8_BAR;
        PG8_STAGE(PG8_SB(1, 0), cB + kstep, voffB); PG8_STAGE(PG8_SA(1, 0), cA + kstep, voffA); PG8_STAGE(PG8_SB(1, 1), cB + hstep + kstep, voffB);
        PG8_WAIT_V(6); PG8_BAR;
    }
    for (;;) {
        const bool has_next = S.next(ui + 1, nxt);
        const char* nA = has_next ? (const char*)g.A + (size_t)nxt.pm * tstep : cA; const char* nB = has_next ? (const char*)g.Bt + (size_t)nxt.pn * tstep : cB;
        for (int t = 0; t < nt; t += 2) {
            const bool last = (t == nt - 2);
            const char* a1 = cA + (size_t)(t + 1) * kstep;
            const char* a2 = last ? nA : cA + (size_t)(t + 2) * kstep; const char* b2 = last ? nB : cB + (size_t)(t + 2) * kstep;
            const char* a3 = a2 + kstep; const char* b3 = b2 + kstep;
            if (last && has_next) S.a_ready(nxt);
            if constexpr (SP2) {
            PG8_LDB(B0, 0, 0); PG8_LDB(B1, 0, 1); PG8_SCHED; PG8_LDA(At, 0, 0); PG8_STAGE(PG8_SA(1, 1), a1 + hstep, voffA);
            PG8_WAIT_V(8); PG8_WAIT_L(0); PG8_BAR; PG8_MMA(0, 0, At, B0); PG8_MMA(0, 1, At, B1); PG8_BAR; PG8_SCHED;
            PG8_LDA(At, 0, 1); PG8_STAGE(PG8_SB(0, 0), b2, voffB); PG8_STAGE(PG8_SB(0, 1), b2 + hstep, voffB); PG8_STAGE(PG8_SA(0, 0), a2, voffA);
            PG8_WAIT_V(8); PG8_WAIT_L(0); PG8_BAR; PG8_MMA(1, 0, At, B0); PG8_MMA(1, 1, At, B1); PG8_BAR; PG8_SCHED;
            PG8_LDB(B0, 1, 0); PG8_LDB(B1, 1, 1); PG8_SCHED; PG8_LDA(At, 1, 0); PG8_STAGE(PG8_SA(0, 1), a2 + hstep, voffA);
            PG8_WAIT_V(8); PG8_WAIT_L(0); PG8_BAR; PG8_MMA(0, 0, At, B0); PG8_MMA(0, 1, At, B1); PG8_BAR; PG8_SCHED;
            PG8_LDA(At, 1, 1); PG8_STAGE(PG8_SB(1, 0), b3, voffB); PG8_STAGE(PG8_SB(1, 1), b3 + hstep, voffB); PG8_STAGE(PG8_SA(1, 0), a3, voffA);
            PG8_WAIT_V(8); PG8_WAIT_L(0); PG8_BAR; PG8_MMA(1, 0, At, B0); PG8_MMA(1, 1, At, B1); PG8_BAR; PG8_SCHED;
            } else {
            PG8_LDB(B0, 0, 0); PG8_SCHED; PG8_LDA(At, 0, 0); PG8_STAGE(PG8_SA(1, 1), a1 + hstep, voffA);
            PG8_WAIT_L(8); PG8_BAR; PG8_WAIT_L(0); PG8_MMA(0, 0, At, B0); PG8_BAR; PG8_SCHED;
            PG8_LDB(B1, 0, 1); PG8_STAGE(PG8_SB(0, 0), b2, voffB);
            PG8_BAR; PG8_WAIT_L(0); PG8_MMA(0, 1, At, B1); PG8_BAR;
            PG8_LDA(At, 0, 1); PG8_STAGE(PG8_SA(0, 0), a2, voffA);
            PG8_BAR; PG8_WAIT_L(0); PG8_MMA(1, 0, At, B0); PG8_BAR; PG8_SCHED;
            PG8_STAGE(PG8_SB(0, 1), b2 + hstep, voffB);
            PG8_WAIT_V(6); PG8_BAR; PG8_MMA(1, 1, At, B1); PG8_BAR;
            PG8_LDB(B0, 1, 0); PG8_SCHED; PG8_LDA(At, 1, 0); PG8_STAGE(PG8_SA(0, 1), a2 + hstep, voffA);
            PG8_WAIT_L(8); PG8_BAR; PG8_WAIT_L(0); PG8_MMA(0, 0, At, B0); PG8_BAR; PG8_SCHED;
            PG8_LDB(B1, 1, 1); PG8_STAGE(PG8_SB(1, 0), b3, voffB);
            PG8_BAR; PG8_WAIT_L(0); PG8_MMA(0, 1, At, B1); PG8_BAR;
            PG8_LDA(At, 1, 1); PG8_STAGE(PG8_SA(1, 0), a3, voffA);
            PG8_BAR; PG8_WAIT_L(0); PG8_MMA(1, 0, At, B0); PG8_BAR; PG8_SCHED;
            PG8_STAGE(PG8_SB(1, 1), b3 + hstep, voffB);
            PG8_WAIT_V(6); PG8_BAR; PG8_MMA(1, 1, At, B1); PG8_BAR;
            }
        }
        if constexpr (ALIGN_EPI) { if (wr == 0) PG8_BAR; }
        if constexpr (!Epi::AFTER_DRAIN) { E(acc, cur, wr, wc, fr, fq); S.done(cur); }
        if (!has_next) break;
        if constexpr (Epi::PRELOAD) { typename Epi::Pre pre2; E.pre_issue(pre2, nxt, wr, wc, fr, fq); E.pre_finish(acc, pre2); }
        else {
#pragma unroll
        for (int a = 0; a < 2; ++a)
#pragma unroll
            for (int b = 0; b < 2; ++b)
#pragma unroll
                for (int m = 0; m < 4; ++m)
#pragma unroll
                    for (int n = 0; n < 2; ++n) acc[a][b][m][n] = (f32x4){0.f, 0.f, 0.f, 0.f};
        }
        cur = nxt; cA = nA; cB = nB; ++ui;
        if constexpr (ALIGN_EPI) { if (wr == 1) PG8_BAR; }
    }
    PG8_WAIT_V(0);
    if constexpr (!ALIGN_EPI) { if (wr == 0) PG8_BAR; }
    PG8_BAR;
    if constexpr (Epi::AFTER_DRAIN) { E.fused(acc, cur, wr, wc, fr, fq, lds, wid, lane); S.done(cur); }
#undef PG8_SA
#undef PG8_SB
#undef PG8_STAGE
#undef PG8_LDA
#undef PG8_LDB
#undef PG8_MMA
#undef PG8_WAIT_V
#undef PG8_WAIT_L
#undef PG8_BAR
#undef PG8_SCHED
}
}

#ifndef PROBE
#define PROBE 0
#endif
#ifndef PG8_SP2
#define PG8_SP2 true
#endif
#ifndef PG8_ALIGN
#define PG8_ALIGN true
#endif

#define GAS __attribute__((address_space(1)))
#define LAS __attribute__((address_space(3)))
typedef unsigned short bf16;
typedef pg8::f32x4 f32x4;
typedef pg8::f32x2 f32x2;
typedef pg8::u32x4 u32x4;
typedef pg8::bf16x8 bf16x8;
typedef unsigned u32x2 __attribute__((ext_vector_type(2)));
typedef GAS unsigned gu32;
#define RLX_AGENT __ATOMIC_RELAXED, __HIP_MEMORY_SCOPE_AGENT
#define LDS_WAIT() asm volatile("s_waitcnt lgkmcnt(0)" ::: "memory")
#define VM_WAIT() asm volatile("s_waitcnt vmcnt(0)" ::: "memory")
using pg8::cvt_pk_bf16;

constexpr int S_ = 16384, D_ = 1024, FF_ = 2816, NGU = 2 * FF_, NH = 16, HD = 64, NBLK = 64, BS = 256;
constexpr int NWAVES = 8;
constexpr float EPS = 1e-6f, LOG2E = 1.4426950408889634f;

constexpr size_t MiB = 1u << 20;
constexpr size_t WS_CTL = 0, CTL_ZERO_BYTES = 64 * 1024;
constexpr size_t WS_SSQ = 1 * MiB;
constexpr size_t WS_KPART = 2 * MiB;
constexpr size_t WS_SEL = 3 * MiB;
constexpr size_t WS_LSE = 4 * MiB;
constexpr size_t WS_QN2 = 348 * MiB;
constexpr size_t WS_WP = 7 * MiB;
constexpr size_t WS_WATT = 8 * MiB, WATT_STRIDE = 8 * MiB, WATT_WO = 6 * MiB;
constexpr size_t WS_WFFN = 24 * MiB, WFFN_STRIDE = 17301504, WFFN_WD = 11 * MiB;
constexpr size_t WS_XB = 156 * MiB;
constexpr size_t WS_BIG = 252 * MiB;
constexpr size_t WS_HALO = 349 * MiB;
constexpr size_t WS_SSQB = 351 * MiB;
constexpr size_t WS_END = 352 * MiB;
static_assert(WS_WFFN + 8 * WFFN_STRIDE == WS_XB, "ws map");
constexpr int CW_BAR = 4096, CW_QA = 8192;
static_assert((CW_QA + 64 * 16) * 4 <= (int)CTL_ZERO_BYTES && (CW_BAR + 3456) <= CW_QA, "control words inside the memset region");

constexpr int RING_BYTES = 131072, LDSCTL_OFF = RING_BYTES, MISC_OFF = LDSCTL_OFF + 320, RSTD_OFF = MISC_OFF + 128, LDS_BYTES = 147456;
static_assert(RSTD_OFF + 6 * 1024 <= LDS_BYTES, "LDS map");
constexpr int A_KS = 0, A_VT = 32768, A_LIST = 65536, A_CNT = A_LIST + 32768, A_OST = A_CNT + 256, A_OPITCH = 144;
static_assert(A_OST + 8 * 16 * A_OPITCH <= RING_BYTES, "attention LDS");

#define XB_TMO      128
#define XB_XCNT(j)  (256  + 64 * (j))
#define XB_XSUB(j)  (1280 + 64 * (j))
#define XB_XGEN(j)  (2304 + 64 * (j))
#define XB_TOP      3328
#define XB_TOPGEN   3392
#define XCD_BAR_WORDS 3456
#define XB_SPIN_CAP (1u << 18)

__device__ __forceinline__ unsigned xb_ld(unsigned* p)              { return __hip_atomic_load(p, __ATOMIC_RELAXED, __HIP_MEMORY_SCOPE_AGENT); }
__device__ __forceinline__ unsigned xb_add(unsigned* p, unsigned v) { return __hip_atomic_fetch_add(p, v, __ATOMIC_RELAXED, __HIP_MEMORY_SCOPE_AGENT); }
__device__ __forceinline__ unsigned xb_xcc_id() { return (unsigned)__builtin_amdgcn_s_getreg((3 << 11) | 20) & 0xFu; }
#define XB_SPIN(cond, bar) do { unsigned _sp = 0; while (cond) { __builtin_amdgcn_s_sleep(1); \
    if ((++_sp & 255u) == 0u) { if (xb_ld(&(bar)[XB_TMO])) break; if (_sp > XB_SPIN_CAP) { atomicAdd(&(bar)[XB_TMO], 1u); break; } } } } while (0)

struct XcdBarrier {
    unsigned* bar; unsigned x;
    volatile LAS unsigned* st;
};

__device__ __forceinline__ XcdBarrier xcd_barrier_post(unsigned* bar, volatile LAS unsigned* st, const bool thread0) {
    XcdBarrier b; b.bar = bar; b.x = xb_xcc_id(); b.st = st;
    if (thread0) (void)xb_add(&bar[XB_XCNT(b.x)], 1u);
    return b;
}
__device__ __forceinline__ void xcd_barrier_complete(unsigned* bar, unsigned x, unsigned& nloc, unsigned& nx) {
    const unsigned G = gridDim.x * gridDim.y * gridDim.z;
    unsigned sum, cnt, mine, sp = 0u;
    for (;;) {
        sum = 0u; cnt = 0u; mine = 0u;
#pragma unroll
        for (unsigned j = 0; j < 16; ++j) { const unsigned c = xb_ld(&bar[XB_XCNT(j)]); sum += c; cnt += (c > 0u) ? 1u : 0u; mine = (j == x) ? c : mine; }
        if (sum == G) break;
        __builtin_amdgcn_s_sleep(1);
        if ((++sp & 255u) == 0u) { if (xb_ld(&bar[XB_TMO])) break; if (sp > XB_SPIN_CAP) { atomicAdd(&bar[XB_TMO], 1u); break; } }
    }
    nloc = mine > 0u ? mine : 1u; nx = cnt > 0u ? cnt : 1u;
}

__device__ __forceinline__ void xcd_barrier(const XcdBarrier& b, const bool thread0) {
    asm volatile("s_waitcnt vmcnt(0)" ::: "memory");
    __syncthreads();
    if (thread0) {
        unsigned* bar = b.bar;
        __builtin_amdgcn_s_waitcnt(0);
        unsigned nloc = b.st[0], nx = b.st[1];
        if (nloc == 0u) { xcd_barrier_complete(bar, b.x, nloc, nx); b.st[0] = nloc; b.st[1] = nx; }
        const unsigned old = xb_add(&bar[XB_XSUB(b.x)], 1u);
        const unsigned gen = old / nloc;
        if (old + 1u == (gen + 1u) * nloc) {
            __builtin_amdgcn_fence(__ATOMIC_RELEASE, "agent");
            asm volatile("s_waitcnt vmcnt(0)" ::: "memory");
            const unsigned og = xb_add(&bar[XB_TOP], 1u);
            const unsigned tg = og / nx;
            if (og + 1u == (tg + 1u) * nx) xb_add(&bar[XB_TOPGEN], 1u);
            else XB_SPIN(xb_ld(&bar[XB_TOPGEN]) == tg, bar);
            __builtin_amdgcn_fence(__ATOMIC_ACQUIRE, "agent");
            xb_add(&bar[XB_XGEN(b.x)], 1u);
            asm volatile("s_waitcnt vmcnt(0)" ::: "memory");
        } else {
            XB_SPIN(xb_ld(&bar[XB_XGEN(b.x)]) == gen, bar);
            __builtin_amdgcn_fence(__ATOMIC_ACQUIRE, "agent");
            asm volatile("s_waitcnt vmcnt(0)" ::: "memory");
        }
    }
    __syncthreads();
}
__device__ __forceinline__ float row_rstd(const float* ssq, int row) {
    const f32x4* p = (const f32x4*)(ssq + (size_t)row * 16);
    const f32x4 a = p[0], b = p[1], c = p[2], d = p[3];
    const float s = (((a.x + a.y) + (a.z + a.w)) + ((b.x + b.y) + (b.z + b.w))) + (((c.x + c.y) + (c.z + c.w)) + ((d.x + d.y) + (d.z + d.w)));
    return __builtin_amdgcn_rsqf(s * (1.0f / 1024.0f) + EPS);
}
template <class Sched> __device__ __forceinline__ void rstd_table(LAS unsigned char* lds, const float* ssq, const Sched& S, const int wave0) {
    int tid = wave0 * 64 + mk_lane(); asm volatile("" : "+v"(tid));
    LAS float* T = (LAS float*)(lds + RSTD_OFF);
#pragma unroll
    for (int i2 = 0; i2 < 3; ++i2) { pg8::Unit u; const int i = 2 * i2 + (tid >> 8); if (S.next(i, u)) T[i * 256 + (tid & 255)] = row_rstd(ssq, u.pm * 256 + (tid & 255)); }
    __syncthreads();
}
__device__ __forceinline__ float bf_lo(unsigned w) { return __uint_as_float(w << 16); }
__device__ __forceinline__ float bf_hi(unsigned w) { return __uint_as_float(w & 0xffff0000u); }

struct EpiNull {
    static constexpr bool PERM = false, AFTER_DRAIN = false;
    float* dummy;
    __device__ __forceinline__ void operator()(const f32x4 (&acc)[2][2][4][2], const pg8::Unit& u, int wr, int wc, int fr, int fq) const {
        f32x4 s = {0.f, 0.f, 0.f, 0.f};
#pragma unroll
        for (int ai = 0; ai < 2; ++ai)
#pragma unroll
            for (int bj = 0; bj < 2; ++bj)
#pragma unroll
                for (int m = 0; m < 4; ++m)
#pragma unroll
                    for (int n = 0; n < 2; ++n) s += acc[ai][bj][m][n];
        dummy[(size_t)blockIdx.x * 512 + (wr * 4 + wc) * 64 + fq * 16 + fr] = (s.x + s.y) + (s.z + s.w);
    }
};
struct NoPre {};
struct EpiSwiGLU {
    static constexpr bool PERM = true, AFTER_DRAIN = false, PRELOAD = false; typedef NoPre Pre;
    bf16* H; LAS const float* rt; int nullmode;
    __device__ __forceinline__ void operator()(const f32x4 (&acc)[2][2][4][2], const pg8::Unit& u, int wr, int wc, int fr, int fq) const {
#if PROBE == 13
        if (nullmode) { EpiNull en{(float*)H}; en(acc, u, wr, wc, fr, fq); return; }
#endif
        const int row0 = u.pm * 256 + wr * 64 + fr, col0 = u.pn * 128 + wc * 32 + 8 * fq;
#pragma unroll
        for (int ai = 0; ai < 2; ++ai)
#pragma unroll
            for (int m = 0; m < 4; ++m) {
                const int row = row0 + ai * 128 + m * 16;
                const float rs = rt[u.idx * 256 + (row & 255)], rsl = rs * (-LOG2E), rs2 = rs * rs;
                float hv[8];
#pragma unroll
                for (int n = 0; n < 2; ++n)
#pragma unroll
                    for (int e = 0; e < 4; ++e) {
                        const float ga = acc[ai][0][m][n][e], ua = acc[ai][1][m][n][e];
                        const float ex = __builtin_amdgcn_exp2f(ga * rsl);
                        hv[n * 4 + e] = ((ga * ua) * rs2) * __builtin_amdgcn_rcpf(1.0f + ex);
                    }
                u32x4 w; w.x = cvt_pk_bf16(hv[0], hv[1]); w.y = cvt_pk_bf16(hv[2], hv[3]); w.z = cvt_pk_bf16(hv[4], hv[5]); w.w = cvt_pk_bf16(hv[6], hv[7]);
                *(u32x4*)(H + (size_t)row * FF_ + col0) = w;
            }
    }
};

template <bool POOL, int ALPHA2> struct EpiResid {
    static constexpr bool PERM = true, AFTER_DRAIN = false;
    static constexpr bool PRELOAD = !POOL;
    struct PreTile { u32x4 r[16]; };
    typedef typename std::conditional<POOL, NoPre, PreTile>::type Pre;
    static constexpr float alpha = 0.5f * (float)ALPHA2;
    bf16* xb; float* ssq; const float* cscale; bf16* halo;
    __device__ __forceinline__ void pre_issue(PreTile& pre, const pg8::Unit& u, int wr, int wc, int fr, int fq) const {
        const int row0 = u.pm * 256 + wr * 64 + fr, col0 = u.pn * 256 + wc * 32 + 8 * fq;
#pragma unroll
        for (int ai = 0; ai < 2; ++ai)
#pragma unroll
            for (int m = 0; m < 4; ++m)
#pragma unroll
                for (int bj = 0; bj < 2; ++bj) pre.r[(ai * 4 + m) * 2 + bj] = *(const u32x4*)(xb + (size_t)(row0 + ai * 128 + m * 16) * D_ + col0 + bj * 128);
    }
    __device__ __forceinline__ void pre_finish(f32x4 (&acc)[2][2][4][2], const PreTile& pre) const {
        const float ia = 1.0f / alpha;
#pragma unroll
        for (int ai = 0; ai < 2; ++ai)
#pragma unroll
            for (int m = 0; m < 4; ++m)
#pragma unroll
                for (int bj = 0; bj < 2; ++bj) { const u32x4 b = pre.r[(ai * 4 + m) * 2 + bj];
                    acc[ai][bj][m][0] = (f32x4){bf_lo(b.x), bf_hi(b.x), bf_lo(b.y), bf_hi(b.y)} * ia; acc[ai][bj][m][1] = (f32x4){bf_lo(b.z), bf_hi(b.z), bf_lo(b.w), bf_hi(b.w)} * ia; }
    }
    __device__ __forceinline__ void operator()(const f32x4 (&acc)[2][2][4][2], const pg8::Unit& u, int wr, int wc, int fr, int fq) const {
        const int pmr = POOL ? (u.pm & 63) : u.pm;
        const int row0 = pmr * 256 + wr * 64 + fr, col0 = u.pn * 256 + wc * 32 + 8 * fq;
        f32x4 cs[2][2];
#pragma unroll
        for (int bj = 0; bj < 2; ++bj)
#pragma unroll
            for (int n = 0; n < 2; ++n) { if (POOL) cs[bj][n] = *(const f32x4*)(cscale + col0 + bj * 128 + 4 * n) * alpha; }
#pragma unroll
        for (int ai = 0; ai < 2; ++ai) {
            u32x4 bx[4][2];
            if (POOL) {
#pragma unroll
            for (int m = 0; m < 4; ++m)
#pragma unroll
                for (int bj = 0; bj < 2; ++bj) bx[m][bj] = *(const u32x4*)(xb + (size_t)(row0 + ai * 128 + m * 16) * D_ + col0 + bj * 128);
            }
#pragma unroll
            for (int m = 0; m < 4; ++m) {
                const int row = row0 + ai * 128 + m * 16; float s = 0.f;
#pragma unroll
                for (int bj = 0; bj < 2; ++bj) {
                    f32x4 v0, v1;
                    if (POOL) { v0 = acc[ai][bj][m][0] * cs[bj][0]; v1 = acc[ai][bj][m][1] * cs[bj][1]; } else { v0 = acc[ai][bj][m][0] * alpha; v1 = acc[ai][bj][m][1] * alpha; }
                    if (POOL) { const u32x4 b = bx[m][bj]; v0 += (f32x4){bf_lo(b.x), bf_hi(b.x), bf_lo(b.y), bf_hi(b.y)}; v1 += (f32x4){bf_lo(b.z), bf_hi(b.z), bf_lo(b.w), bf_hi(b.w)}; }
                    s += ((v0.x * v0.x + v0.y * v0.y) + (v0.z * v0.z + v0.w * v0.w)) + ((v1.x * v1.x + v1.y * v1.y) + (v1.z * v1.z + v1.w * v1.w));
                    u32x4 w; w.x = cvt_pk_bf16(v0.x, v0.y); w.y = cvt_pk_bf16(v0.z, v0.w); w.z = cvt_pk_bf16(v1.x, v1.y); w.w = cvt_pk_bf16(v1.z, v1.w);
                    *(u32x4*)(xb + (size_t)row * D_ + col0 + bj * 128) = w;
                    if (!POOL && ai == 1 && m == 3) { if (halo && wr == 1) *(u32x4*)(halo + ((size_t)u.pm * 16 + fr) * D_ + col0 + bj * 128) = w; }
                }
                s += shx(s, 16, fq * 16 + fr); s += shx(s, 32, fq * 16 + fr);
                if (fq == 0) ssq[(size_t)row * 16 + u.pn * 4 + wc] = s;
            }
        }
    }
};

struct EpiQKV {
    static constexpr bool PERM = true, AFTER_DRAIN = false, PRELOAD = false; typedef NoPre Pre;
    bf16* QKV; LAS const float* rt; float* kpart;
    __device__ __forceinline__ void operator()(const f32x4 (&acc)[2][2][4][2], const pg8::Unit& u, int wr, int wc, int fr, int fq) const {
        const int t = u.pn >> 2, colt = (u.pn & 3) * 256;
        bf16* dst = QKV + (size_t)t * S_ * D_;
        const int row0 = u.pm * 256 + wr * 64 + fr, col0 = colt + wc * 32 + 8 * fq;
        f32x4 csum[2][2];
#pragma unroll
        for (int bj = 0; bj < 2; ++bj)
#pragma unroll
            for (int n = 0; n < 2; ++n) csum[bj][n] = (f32x4){0.f, 0.f, 0.f, 0.f};
#pragma unroll
        for (int ai = 0; ai < 2; ++ai)
#pragma unroll
            for (int m = 0; m < 4; ++m) {
                const int row = row0 + ai * 128 + m * 16;
                const float rs = rt[u.idx * 256 + (row & 255)];
#pragma unroll
                for (int bj = 0; bj < 2; ++bj) {
                    const f32x4 v0 = acc[ai][bj][m][0] * rs, v1 = acc[ai][bj][m][1] * rs;
                    u32x4 w; w.x = cvt_pk_bf16(v0.x, v0.y); w.y = cvt_pk_bf16(v0.z, v0.w); w.z = cvt_pk_bf16(v1.x, v1.y); w.w = cvt_pk_bf16(v1.z, v1.w);
                    *(u32x4*)(dst + (size_t)row * D_ + col0 + bj * 128) = w;
                    csum[bj][0] += v0; csum[bj][1] += v1;
                }
            }
        if (t == 1) {
#pragma unroll
            for (int bj = 0; bj < 2; ++bj)
#pragma unroll
                for (int n = 0; n < 2; ++n) {
                    f32x4 c = csum[bj][n];
#pragma unroll
                    for (int e = 0; e < 4; ++e) { float x = c[e]; x += shx(x, 1, fq * 16 + fr); x += shx(x, 2, fq * 16 + fr); x += shx(x, 4, fq * 16 + fr); x += shx(x, 8, fq * 16 + fr); c[e] = x; }
                    if (fr == 0) *(f32x4*)(kpart + ((size_t)wr * NBLK + u.pm) * D_ + col0 + bj * 128 + 4 * n) = c;
                }
        }
    }
};


struct PoolOrder {
    int G, c;
    __device__ __forceinline__ bool next(int i, pg8::Unit& u) const { const int L = i * G + c; if (L >= 256) return false; u.pm = L; u.pn = L >> 6; u.idx = i; return true; }
    __device__ __forceinline__ void a_ready(const pg8::Unit&) const {}
    __device__ __forceinline__ void done(const pg8::Unit&) const {}
};
__device__ __forceinline__ float wave_sum(float v, int lane) {
#pragma unroll
    for (int o = 1; o < 64; o <<= 1) v += shx(v, o, lane);
    return v;
}
__device__ __forceinline__ void tr_item(const float* src, int N, int k0, int n0, bf16* dst, int dpitch, int drow0, const float* gain, float cs, LAS float* scr, int lane) {
    f32x4 v[8];
#pragma unroll
    for (int i = 0; i < 8; ++i) v[i] = *(const f32x4*)(src + (size_t)(k0 + 8 * i + (lane >> 3)) * N + n0 + 4 * (lane & 7));
#pragma unroll
    for (int i = 0; i < 8; ++i) {
        const int kk = 8 * i + (lane >> 3);
        const float g = gain ? gain[k0 + kk] * cs : cs;
        LAS float* d = scr + kk * 33 + 4 * (lane & 7);
        d[0] = v[i].x * g; d[1] = v[i].y * g; d[2] = v[i].z * g; d[3] = v[i].w * g;
    }
    LDS_WAIT(); asm volatile("" ::: "memory");
    const int c = lane & 7;
#pragma unroll
    for (int j = 0; j < 4; ++j) {
        const int n = (lane >> 3) + 8 * j; const LAS float* s = scr + (8 * c) * 33 + n;
        u32x4 o; o.x = cvt_pk_bf16(s[0 * 33], s[1 * 33]); o.y = cvt_pk_bf16(s[2 * 33], s[3 * 33]); o.z = cvt_pk_bf16(s[4 * 33], s[5 * 33]); o.w = cvt_pk_bf16(s[6 * 33], s[7 * 33]);
        *(u32x4*)(dst + (size_t)(drow0 + n) * dpitch + k0 + 8 * c) = o;
    }
    LDS_WAIT(); asm volatile("" ::: "memory");
}
__device__ __forceinline__ unsigned char* launder_s(unsigned char* p) { unsigned long long v = (unsigned long long)p; asm volatile("" : "+s"(v)); return (unsigned char*)v; }
struct Ptrs {
    const float *x, *ln, *wg, *wu, *wd, *wqkv, *wo, *pw, *ps, *fg;
    float* out; unsigned char* ws;
};
__device__ __forceinline__ bf16* ws_wgu(unsigned char* ws, int f) { return (bf16*)(ws + WS_WFFN + (size_t)f * WFFN_STRIDE); }
__device__ __forceinline__ bf16* ws_wd(unsigned char* ws, int f) { return (bf16*)(ws + WS_WFFN + (size_t)f * WFFN_STRIDE + WFFN_WD); }
__device__ __forceinline__ bf16* ws_wqkv(unsigned char* ws, int a) { return (bf16*)(ws + WS_WATT + (size_t)a * WATT_STRIDE); }
__device__ __forceinline__ bf16* ws_wo(unsigned char* ws, int a) { return (bf16*)(ws + WS_WATT + (size_t)a * WATT_STRIDE + WATT_WO); }
__device__ __forceinline__ bf16* ws_wp(unsigned char* ws, int p) { return (bf16*)(ws + WS_WP + (size_t)p * 524288); }

constexpr int IT_F = 1408, IT_FFN = 3 * IT_F, IT_ATT = 2048, IT_QKV = 1536, IT_POOL = 128;
constexpr int IT_TOTAL = 8 * IT_FFN + 2 * IT_ATT + 2 * IT_POOL;
__device__ __forceinline__ void convert_items(const Ptrs& P, LAS unsigned char* lds, int it_lo, int it_hi, int ww, int n_ww, int wave, int lane) {
    LAS float* scr = (LAS float*)(lds + wave * 16384);
    for (int it = it_lo + ww; it < it_hi; it += n_ww) {
        if (it < 8 * IT_FFN) {
            const int f = it / IT_FFN, r = it % IT_FFN, m = r / IT_F, q = r % IT_F;
            if (m < 2) {
                const int kb = q / 88, nb = q % 88, n0 = 32 * nb;
                const float* src = (m == 0 ? P.wg : P.wu) + (size_t)f * D_ * FF_;
                const float* gain = P.ln + ((f >> 1) * 3 + ((f & 1) ? 2 : 0)) * D_;
                tr_item(src, FF_, 64 * kb, n0, ws_wgu(P.ws, f), D_, (n0 >> 7) * 256 + m * 128 + (n0 & 127), gain, 1.0f, scr, lane);
            } else {
                const int kb = q / 32, nb = q % 32;
                tr_item(P.wd + (size_t)f * D_ * FF_, D_, 64 * kb, 32 * nb, ws_wd(P.ws, f), FF_, 32 * nb, nullptr, 1.0f, scr, lane);
            }
        } else if (it < 8 * IT_FFN + 2 * IT_ATT) {
            const int r = it - 8 * IT_FFN, a = r / IT_ATT; int q = r % IT_ATT;
            if (q < IT_QKV) {
                const int kb = q / 96, nb = q % 96, n0 = 32 * nb;
                tr_item(P.wqkv + (size_t)a * D_ * 3 * D_, 3 * D_, 64 * kb, n0, ws_wqkv(P.ws, a), D_, n0, P.ln + ((2 * a) * 3 + 1) * D_, n0 < D_ ? 0.125f * LOG2E : 1.0f, scr, lane);
            } else {
                q -= IT_QKV; const int kb = q / 32, nb = q % 32;
                tr_item(P.wo + (size_t)a * D_ * D_, D_, 64 * kb, 32 * nb, ws_wo(P.ws, a), D_, 32 * nb, nullptr, 1.0f, scr, lane);
            }
        } else {
            const int r = it - 8 * IT_FFN - 2 * IT_ATT, p = r / IT_POOL, g = (r % IT_POOL) / 32, q = r % 32, kb = q / 8, nb = q % 8;
            tr_item(P.pw + (size_t)(p * 4 + g) * 65536, 256, 64 * kb, 32 * nb, ws_wp(P.ws, p), 256, g * 256 + 32 * nb, nullptr, 1.0f, scr, lane);
        }
    }
}
#ifndef TAILCONV
#define TAILCONV 1
#endif
__device__ __forceinline__ void phase_prologue(const Ptrs& P, LAS unsigned char* lds, const int wave0) {
    int tid = wave0 * 64 + mk_lane(); asm volatile("" : "+v"(tid)); const int lane = tid & 63, wave = __builtin_amdgcn_readfirstlane(tid >> 6); (void)lane; (void)wave;
    const int gw = blockIdx.x * NWAVES + wave, NGW = gridDim.x * NWAVES;
    if (TAILCONV && gridDim.x == 256) {
        convert_items(P, lds, 0, IT_FFN, gw, NGW, wave, lane);
    } else convert_items(P, lds, 0, IT_TOTAL, gw, NGW, wave, lane);
    bf16* XB = (bf16*)(P.ws + WS_XB); float* ssq = (float*)(P.ws + WS_SSQ);
    for (int row = gw; row < S_; row += NGW) {
        const f32x4* xr = (const f32x4*)(P.x + (size_t)row * D_) + lane;
        f32x4 v[4]; float s = 0.f;
#pragma unroll
        for (int j = 0; j < 4; ++j) { v[j] = xr[64 * j]; s += (v[j].x * v[j].x + v[j].y * v[j].y) + (v[j].z * v[j].z + v[j].w * v[j].w); }
        s = wave_sum(s, lane);
        u32x2* o8 = (u32x2*)(XB + (size_t)row * D_) + lane;
#pragma unroll
        for (int j = 0; j < 4; ++j) { u32x2 w; w.x = cvt_pk_bf16(v[j].x, v[j].y); w.y = cvt_pk_bf16(v[j].z, v[j].w); o8[64 * j] = w; }
        if (lane < 16) ssq[(size_t)row * 16 + lane] = lane == 0 ? s : 0.f;
    }
}

__device__ __forceinline__ void phase_final(const Ptrs& P, bool poison, const int wave0) {
    int tid = wave0 * 64 + mk_lane(); asm volatile("" : "+v"(tid)); const int lane = tid & 63, wave = __builtin_amdgcn_readfirstlane(tid >> 6); (void)lane; (void)wave;
    const int gw = blockIdx.x * NWAVES + wave, NGW = gridDim.x * NWAVES;
    const float* ssq = (const float*)(P.ws + WS_SSQ);
    const float qnan = __builtin_nanf("");
    for (int row = gw; row < S_; row += NGW) {
        const float rs = row_rstd(ssq, row);
        f32x4* xr = (f32x4*)(P.out + (size_t)row * D_) + lane; const f32x4* gr = (const f32x4*)P.fg + lane;
        const u32x2* h8 = (const u32x2*)((const bf16*)(P.ws + WS_XB) + (size_t)row * D_) + lane;
#pragma unroll
        for (int j = 0; j < 4; ++j) { const u32x2 hv = h8[64 * j]; f32x4 x4 = {bf_lo(hv.x), bf_hi(hv.x), bf_lo(hv.y), bf_hi(hv.y)};
            f32x4 v = x4 * gr[64 * j] * rs; if (poison) v = (f32x4){qnan, qnan, qnan, qnan}; xr[64 * j] = v; }
    }
}

__device__ __forceinline__ void phase_pool_elem(const bf16* xhi, const float* ssq, const float* gain, bf16* Y, const bf16* halo, LAS unsigned char* lds, const int wave0) {
    int tid = wave0 * 64 + mk_lane(); asm volatile("" : "+v"(tid)); const int lane = tid & 63, wave = __builtin_amdgcn_readfirstlane(tid >> 6); (void)lane; (void)wave;
    LAS float* rs = (LAS float*)lds;
    const int L = blockIdx.x, g = L >> 6, strip = wave >> 1;
    const int t0 = (L & 63) * 256 + strip * 64;
    if (tid < 320) { const int st = tid / 80, r = (L & 63) * 256 + st * 64 - 16 + tid % 80; rs[tid] = r >= 0 ? row_rstd(ssq, r) : 0.f; }
    __syncthreads();
    const int cg = 2 * (tid & 127), c = g * 256 + cg;
    const f32x2 gn = *(const f32x2*)(gain + c);
    f32x2 hist[16], S2 = {0.f, 0.f}, S4 = {0.f, 0.f}, S8 = {0.f, 0.f}, S16 = {0.f, 0.f};
#pragma unroll
    for (int i = 0; i < 16; ++i) hist[i] = (f32x2){0.f, 0.f};
    const int w = 2 << g;
    bf16* Yg = Y + (size_t)g * S_ * 256 + cg;
    LAS const float* rss = rs + strip * 80;
    unsigned hwv[80];
#pragma unroll
    for (int r = 0; r < 80; ++r) {
        const int row = t0 - 16 + r; hwv[r] = 0u;
        if (row >= 0) { const bf16* src = (r < 16 && strip == 0) ? halo + ((size_t)((L & 63) - 1) * 16 + r) * D_ + c : xhi + (size_t)row * D_ + c; hwv[r] = *(const unsigned*)src; }
    }
#pragma unroll
    for (int b = 0; b < 5; ++b) {
#pragma unroll
        for (int i = 0; i < 16; ++i) {
            const int r = 16 * b + i, row = t0 - 16 + r;
            const unsigned hw = hwv[r];
            const f32x2 hv = (f32x2){bf_lo(hw), bf_hi(hw)} * gn * rss[r];
            S16 += hv - hist[i]; S8 += hv - hist[(i + 8) & 15]; S4 += hv - hist[(i + 12) & 15]; S2 += hv - hist[(i + 14) & 15]; hist[i] = hv;
            if (b > 0) {
                const f32x2 sw = g == 0 ? S2 : g == 1 ? S4 : g == 2 ? S8 : S16;
                const int cnt = row + 1 < w ? row + 1 : w;
                const f32x2 y = sw * (1.0f / (float)cnt) - hv;
                *(unsigned*)(Yg + (size_t)row * 256) = cvt_pk_bf16(y.x, y.y);
            }
        }
    }
    asm volatile("s_waitcnt vmcnt(0)" ::: "memory");
    __builtin_amdgcn_fence(__ATOMIC_ACQUIRE, "agent");
    asm volatile("s_waitcnt vmcnt(0)" ::: "memory");
    __syncthreads();
}

__device__ __forceinline__ void top3_insert(float gt, unsigned n, float& v0, float& v1, float& v2, unsigned& i0, unsigned& i1, unsigned& i2) {
    const bool g0 = gt > v0, g1 = gt > v1, g2 = gt > v2;
    v2 = g1 ? v1 : (g2 ? gt : v2); i2 = g1 ? i1 : (g2 ? n : i2);
    v1 = g0 ? v0 : (g1 ? gt : v1); i1 = g0 ? i0 : (g1 ? n : i1);
    v0 = g0 ? gt : v0;             i0 = g0 ? n : i0;
}
__device__ __forceinline__ void phase_gate(const bf16* Q, const float* kpart, unsigned* sel, float* qn2, LAS unsigned char* lds, const int wave0) {
    int tid = wave0 * 64 + mk_lane(); asm volatile("" : "+v"(tid)); const int lane = tid & 63, wave = __builtin_amdgcn_readfirstlane(tid >> 6);
    const int fr = lane & 15, fq = lane >> 4;
    constexpr int KP = 144, LO = 64 * KP;
    for (int wgt = blockIdx.x; wgt < 256; wgt += gridDim.x) {
        const int h = wgt & 15, part = wgt >> 4;
        bf16x8 qa[8][2];
#pragma unroll
        for (int i = 0; i < 8; ++i) { const bf16* qrow = Q + (size_t)(part * 1024 + (wave + 8 * i) * 16 + fr) * D_ + h * 64; qa[i][0] = *(const bf16x8*)(qrow + 8 * fq); qa[i][1] = *(const bf16x8*)(qrow + 32 + 8 * fq); }
        {
            const int n = tid >> 3, d0 = (tid & 7) * 8;
            const float* pa = kpart + (size_t)n * D_ + h * 64 + d0; const float* pb = pa + (size_t)NBLK * D_;
            const f32x4 a0 = *(const f32x4*)pa, a1 = *(const f32x4*)(pa + 4), b0 = *(const f32x4*)pb, b1 = *(const f32x4*)(pb + 4);
            const f32x4 s0 = a0 + b0, s1 = a1 + b1;
            u32x4 hi; hi.x = cvt_pk_bf16(s0.x, s0.y); hi.y = cvt_pk_bf16(s0.z, s0.w); hi.z = cvt_pk_bf16(s1.x, s1.y); hi.w = cvt_pk_bf16(s1.z, s1.w);
            u32x4 lo; lo.x = cvt_pk_bf16(s0.x - bf_lo(hi.x), s0.y - bf_hi(hi.x)); lo.y = cvt_pk_bf16(s0.z - bf_lo(hi.y), s0.w - bf_hi(hi.y));
            lo.z = cvt_pk_bf16(s1.x - bf_lo(hi.z), s1.y - bf_hi(hi.z)); lo.w = cvt_pk_bf16(s1.z - bf_lo(hi.w), s1.w - bf_hi(hi.w));
            *(LAS u32x4*)(lds + n * KP + d0 * 2) = hi; *(LAS u32x4*)(lds + LO + n * KP + d0 * 2) = lo;
        }
        __syncthreads();
#pragma unroll
        for (int ti = 0; ti < 8; ++ti) {
            const int tile = wave + 8 * ti;
            const int t0 = part * 1024 + tile * 16, j = t0 >> 8, t = t0 + fr;
            const bf16x8 q0 = qa[ti][0], q1 = qa[ti][1];
            float v0 = -INFINITY, v1 = -INFINITY, v2 = -INFINITY; unsigned i0 = 255u, i1 = 255u, i2 = 255u;
            LAS const unsigned char* kp = lds + fr * KP + fq * 16;
#pragma unroll
            for (int bt = 0; bt < 4; ++bt) {
                if (16 * bt < j) {
                    const bf16x8 h0 = *(LAS const bf16x8*)(kp + bt * 16 * KP), h1 = *(LAS const bf16x8*)(kp + bt * 16 * KP + 64);
                    const bf16x8 l0 = *(LAS const bf16x8*)(kp + LO + bt * 16 * KP), l1 = *(LAS const bf16x8*)(kp + LO + bt * 16 * KP + 64);
                    f32x4 z = {0.f, 0.f, 0.f, 0.f};
                    z = __builtin_amdgcn_mfma_f32_16x16x32_bf16(l0, q0, z, 0, 0, 0); z = __builtin_amdgcn_mfma_f32_16x16x32_bf16(l1, q1, z, 0, 0, 0);
                    z = __builtin_amdgcn_mfma_f32_16x16x32_bf16(h0, q0, z, 0, 0, 0); z = __builtin_amdgcn_mfma_f32_16x16x32_bf16(h1, q1, z, 0, 0, 0);
#pragma unroll
                    for (int e = 0; e < 4; ++e) { const int n = 16 * bt + 4 * fq + e; if (n < j) top3_insert(z[e], (unsigned)n, v0, v1, v2, i0, i1, i2); }
                }
            }
#pragma unroll
            for (int sh = 16; sh <= 32; sh <<= 1) {
                const float p0 = shx(v0, sh, lane), p1 = shx(v1, sh, lane), p2 = shx(v2, sh, lane);
                const unsigned q0i = shxu(i0, sh, lane), q1i = shxu(i1, sh, lane), q2i = shxu(i2, sh, lane);
                if (q0i != 255u) top3_insert(p0, q0i, v0, v1, v2, i0, i1, i2);
                if (q1i != 255u) top3_insert(p1, q1i, v0, v1, v2, i0, i1, i2);
                if (q2i != 255u) top3_insert(p2, q2i, v0, v1, v2, i0, i1, i2);
            }
            float qq = 0.f;
#pragma unroll
            for (int i = 0; i < 8; ++i) { const float a = __uint_as_float((unsigned)(unsigned short)q0[i] << 16), b = __uint_as_float((unsigned)(unsigned short)q1[i] << 16); qq = __builtin_fmaf(a, a, qq); qq = __builtin_fmaf(b, b, qq); }
            qq += shx(qq, 16, lane); qq += shx(qq, 32, lane);
            if (fq == 0) { sel[(size_t)h * S_ + t] = i0 | (i1 << 8) | (i2 << 16) | 0xff000000u; qn2[(size_t)h * S_ + t] = qq; }
        }
        __syncthreads();
    }
}

template <bool CAUSAL>
__device__ __forceinline__ void attn_tile(LAS const unsigned char* Ks, LAS const unsigned char* Vt, bf16x8 q0, bf16x8 q1, float lcm, float slope2, int tq_rel, int nch, int fr, int fq,
                                          f32x4 (&o)[4], float& l_out) {
    const int rowbase = 8 * (fr >> 2) + (fr & 3), sw = (((fr >> 1) & 1) << 1) | (((fr >> 3) & 1) << 2);
    LAS const unsigned char* kp0 = Ks + rowbase * 128 + ((fq ^ sw) * 16);
    LAS const unsigned char* kp1 = Ks + rowbase * 128 + (((4 | fq) ^ sw) * 16);
    const float thr_f = (float)(tq_rel - 8 * fq);
    f32x4 s[16];
    bf16x8 kf[2][4];
#define AT_LOADK(buf, c) do { _Pragma("unroll") for (int u = 0; u < 2; ++u) { const int ro = (32 * (c) + 4 * u) * 128; \
        kf[buf][2 * u] = *(LAS const bf16x8*)(kp0 + ro); kf[buf][2 * u + 1] = *(LAS const bf16x8*)(kp1 + ro); } } while (0)
    AT_LOADK(0, 0);
#pragma unroll
    for (int c = 0; c < 8; ++c) {
        if (!CAUSAL || c < nch) {
            if (c < 7) { if (!CAUSAL || c + 1 < nch) AT_LOADK((c + 1) & 1, c + 1); }
            __builtin_amdgcn_sched_barrier(0);
            f32x4 c0, c1;
            float lcc = lcm, thc = thr_f; asm volatile("" : "+v"(lcc), "+v"(thc));
#pragma unroll
            for (int e = 0; e < 4; ++e) {
                c0[e] = __builtin_fmaf(slope2, (float)(32 * c + e), lcc); c1[e] = __builtin_fmaf(slope2, (float)(32 * c + 4 + e), lcc);
                if (CAUSAL) { c0[e] = __builtin_fmaf(fminf(thc - (float)(32 * c + e), 0.f), 1e9f, c0[e]); c1[e] = __builtin_fmaf(fminf(thc - (float)(32 * c + 4 + e), 0.f), 1e9f, c1[e]); }
            }
            const f32x4 z0 = __builtin_amdgcn_mfma_f32_16x16x32_bf16(kf[c & 1][0], q0, c0, 0, 0, 0);
            const f32x4 z1 = __builtin_amdgcn_mfma_f32_16x16x32_bf16(kf[c & 1][2], q0, c1, 0, 0, 0);
            s[2 * c] = __builtin_amdgcn_mfma_f32_16x16x32_bf16(kf[c & 1][1], q1, z0, 0, 0, 0);
            s[2 * c + 1] = __builtin_amdgcn_mfma_f32_16x16x32_bf16(kf[c & 1][3], q1, z1, 0, 0, 0);
        }
    }
#undef AT_LOADK
    const int lanev16 = (fq ^ (2 * (fr & 7))) * 16;
    LAS const unsigned char* vp = Vt + fr * 512;
    bf16x8 vf[2][4];
#define AT_LOADV(buf, c) do { const int co = (64 * (c)) ^ lanev16; \
        _Pragma("unroll") for (int dt = 0; dt < 4; ++dt) vf[buf][dt] = *(LAS const bf16x8*)(vp + dt * 8192 + co); } while (0)
    AT_LOADV(0, 0);
    float l0 = 0.f, l1 = 0.f, l2 = 0.f, l3 = 0.f;
#pragma unroll
    for (int kt = 0; kt < 16; ++kt) {
        if (!CAUSAL || (kt >> 1) < nch) {
#pragma unroll
            for (int e = 0; e < 4; ++e) s[kt][e] = __builtin_amdgcn_exp2f(s[kt][e]);
            l0 += s[kt][0]; l1 += s[kt][1]; l2 += s[kt][2]; l3 += s[kt][3];
        }
    }
    float l = (l0 + l1) + (l2 + l3);
    l += shx(l, 16, fq * 16 + fr); l += shx(l, 32, fq * 16 + fr);
#pragma unroll
    for (int dt = 0; dt < 4; ++dt) o[dt] = (f32x4){0.f, 0.f, 0.f, 0.f};
#pragma unroll
    for (int c = 0; c < 8; ++c) {
        if (!CAUSAL || c < nch) {
            if (c < 7) { if (!CAUSAL || c + 1 < nch) AT_LOADV((c + 1) & 1, c + 1); }
            u32x4 pw; pw.x = cvt_pk_bf16(s[2 * c][0], s[2 * c][1]); pw.y = cvt_pk_bf16(s[2 * c][2], s[2 * c][3]); pw.z = cvt_pk_bf16(s[2 * c + 1][0], s[2 * c + 1][1]); pw.w = cvt_pk_bf16(s[2 * c + 1][2], s[2 * c + 1][3]);
            const bf16x8 pf = __builtin_bit_cast(bf16x8, pw);
#pragma unroll
            for (int dt = 0; dt < 4; ++dt) o[dt] = __builtin_amdgcn_mfma_f32_16x16x32_bf16(vf[c & 1][dt], pf, o[dt], 0, 0, 0);
        }
    }
#undef AT_LOADV
    l_out = l;
}
__device__ __forceinline__ void kv_load(const bf16* K, const bf16* V, int n, int h, u32x4 (&kv)[4], u32x4 (&vv)[4], int tid, int wave, int lane) {
#pragma unroll
    for (int it = 0; it < 4; ++it) kv[it] = *(const u32x4*)(K + (size_t)(n * BS + it * 64 + (tid >> 3)) * D_ + h * 64 + (tid & 7) * 8);
#pragma unroll
    for (int it = 0; it < 4; ++it) vv[it] = *(const u32x4*)(V + (size_t)(n * BS + wave * 32 + (lane & 31)) * D_ + h * 64 + ((lane >> 5) * 4 + it) * 8);
}
__device__ __forceinline__ void kv_write(const u32x4 (&kv)[4], const u32x4 (&vv)[4], LAS unsigned char* lds, LAS unsigned* kmaxw, int tid, int wave, int lane) {
    float kn = 0.f;
#pragma unroll
    for (int it = 0; it < 4; ++it) { const int r = it * 64 + (tid >> 3), c16 = tid & 7, swz = (((r >> 1) & 1) << 1) | (((r >> 4) & 1) << 2);
        *(LAS u32x4*)(lds + A_KS + r * 128 + ((c16 ^ swz) * 16)) = kv[it];
        float sq = 0.f;
#pragma unroll
        for (int w = 0; w < 4; ++w) { const float a = bf_lo(kv[it][w]), b = bf_hi(kv[it][w]); sq = __builtin_fmaf(a, a, sq); sq = __builtin_fmaf(b, b, sq); }
        sq += shx(sq, 1, lane); sq += shx(sq, 2, lane); sq += shx(sq, 4, lane); kn = fmaxf(kn, sq); }
    kn = fmaxf(kn, shx(kn, 8, lane)); kn = fmaxf(kn, shx(kn, 16, lane)); kn = fmaxf(kn, shx(kn, 32, lane));
    if (lane == 0) __hip_atomic_fetch_max(kmaxw, __float_as_uint(kn), __ATOMIC_RELAXED, __HIP_MEMORY_SCOPE_WORKGROUP);
#pragma unroll
    for (int it = 0; it < 4; ++it) {
        const int key = wave * 32 + (lane & 31), pc = (lane >> 5) * 4 + it;
        const u32x4 v = vv[it];
        LAS unsigned char* vb = lds + A_VT + (pc * 8) * 512 + (key & 7) * 2; const int kc = key >> 3;
#define ST_VT(e, val) *(LAS unsigned short*)(vb + (e) * 512 + ((kc ^ (2 * (e))) * 16)) = (unsigned short)(val)
        ST_VT(0, v.x & 0xffffu); ST_VT(1, v.x >> 16); ST_VT(2, v.y & 0xffffu); ST_VT(3, v.y >> 16);
        ST_VT(4, v.z & 0xffffu); ST_VT(5, v.z >> 16); ST_VT(6, v.w & 0xffffu); ST_VT(7, v.w >> 16);
#undef ST_VT
    }
}
__device__ __forceinline__ bool alibi_dead(float slope2, int t, int n) { return slope2 * (float)(t - n * BS - (BS - 1)) >= 160.0f; }
__device__ __forceinline__ float head_slope2(int h) { return exp2f(-0.5f * (float)(h + 1)) * LOG2E; }

constexpr int SEL_NU = 1305;
__device__ const unsigned sel_unit_tab[SEL_NU] = {
    0x80406u, 0x80408u, 0x8040au, 0x8040bu, 0x8040cu, 0x8040du, 0x8040eu, 0x8040fu, 0xa0817u, 0xa0819u, 0xa081bu, 0xa081cu, 0xa081du, 0xa081eu, 0xa081fu, 0x12100bu,
    0x12100eu, 0x12100fu, 0x16141cu, 0x16144cu, 0x28240eu, 0x28240fu, 0x1a185au, 0x302c1cu, 0x302cacu, 0x1e1c6du, 0x1e1c6eu, 0x1e1c6fu, 0x22203bu, 0x22207bu, 0x22200du, 0xc0c27u,
    0xc0c09u, 0xc0c29u, 0xc0c2au, 0xc0c2bu, 0xc0c2cu, 0xc0c2du, 0xc0c2eu, 0xc0c2fu, 0x3c38ddu, 0x3c38deu, 0x3c38dfu, 0x68617bu, 0x56500eu, 0x56500fu, 0xa0814u, 0x26240bu,
    0x26248bu, 0x403c6du, 0x403c6eu, 0x403c6fu, 0x8079dcu, 0x8078ddu, 0x8079ddu, 0x8078deu, 0x8079deu, 0x8078dfu, 0x8079dfu, 0x262488u, 0x48440du, 0x2e2c4cu, 0x101008u, 0x101038u,
    0x10100au, 0x10103au, 0x10103bu, 0x10100cu, 0x10103cu, 0x10100du, 0x10103du, 0x10103eu, 0x10103fu, 0x48447bu, 0x6a658bu, 0x3230bcu, 0x4c491au, 0x6660acu, 0x3634c9u, 0x141419u,
    0x141449u, 0x14141bu, 0x14144bu, 0x14141du, 0x14144du, 0x14141eu, 0x14144eu, 0x14141fu, 0x14144fu, 0x3e3cedu, 0x3e3ceeu, 0x3e3cefu, 0x42403eu, 0x42407eu, 0x42403fu, 0x42407fu,
    0x18182au, 0x18182cu, 0x18185cu, 0x18182eu, 0x18182fu, 0x6c699bu, 0x141446u, 0x807decu, 0x807cedu, 0x807dedu, 0x807ceeu, 0x807deeu, 0x807cefu, 0x807defu, 0x52501eu, 0x52501fu,
    0x1c1c6au, 0x6864bcu, 0x20200au, 0x20200cu, 0x20203du, 0x20207du, 0x20203eu, 0x20207eu, 0x20203fu, 0x20207fu, 0x1c1c67u, 0x4e4d2au, 0x24248du, 0x24248eu, 0x24248fu, 0x28281bu,
    0x28289bu, 0x28281du, 0x28281eu, 0x28281fu, 0x6e6dabu, 0x30302cu, 0x30305cu, 0x3434ccu, 0x3838dcu, 0x40400cu, 0x40403du, 0x40407du, 0x4040fdu, 0x4040feu, 0x4040ffu, 0x282898u,
    0x6a68ccu, 0x3838d9u, 0x50501du, 0x8081fcu, 0x8080fdu, 0x8081fdu, 0x80806eu, 0x8080feu, 0x8081feu, 0x80806fu, 0x8080ffu, 0x8081ffu, 0x7071bbu, 0x34345au, 0x50513au, 0x80807du,
    0x101035u, 0x4a4c4eu, 0x4a4c4fu, 0x7275cbu, 0x46488du, 0x46488eu, 0x46488fu, 0x42450du, 0x42450eu, 0x42450fu, 0x7e806du, 0x3a3cecu, 0xc0c24u, 0x32346cu, 0x4a4c8bu, 0x2e302eu,
    0x2e302fu, 0x52554au, 0x3a3ce9u, 0x80860cu, 0x80850du, 0x80860du, 0x80843eu, 0x80847eu, 0x80850eu, 0x80860eu, 0x80843fu, 0x80847fu, 0x80850fu, 0x80860fu, 0x2a2c2bu, 0x2a2cabu,
    0x2a2c2du, 0x60404u, 0x60405u, 0x80815u, 0x80816u, 0x60407u, 0x80818u, 0x60409u, 0x8081au, 0x26284bu, 0x26284du, 0x26289du, 0x26284eu, 0x26289eu, 0x26284fu, 0x26289fu,
    0x5a5c4cu, 0x7479dbu, 0x585c2eu, 0x585c2fu, 0x36386au, 0x2a2ca8u, 0x1e203au, 0x1e207au, 0x1e203cu, 0x1e207cu, 0x262849u, 0x1e2077u, 0x1a1c69u, 0x1a1c1au, 0x1a1c6cu, 0x2e302au,
    0x484c4du, 0x484c9du, 0x484c9eu, 0x484c9fu, 0x6c70dcu, 0x44491du, 0x44491eu, 0x44491fu, 0x54595au, 0x767debu, 0x4c509bu, 0x161809u, 0x161829u, 0x161859u, 0x16182bu, 0x16185bu,
    0x16182du, 0x16185du, 0x16185eu, 0x16185fu, 0x3c40fcu, 0x5c605cu, 0x383c3cu, 0x383c7cu, 0x808a1cu, 0x80891du, 0x808a1du, 0x80891eu, 0x808a1eu, 0x80891fu, 0x808a1fu, 0x3c40f9u,
    0x40443bu, 0x161856u, 0x121428u, 0x121448u, 0x12144au, 0x6e74ecu, 0x7881fbu, 0x4e542du, 0x4a505du, 0x4a50adu, 0x4a505eu, 0x4a50aeu, 0x4a505fu, 0x4a50afu, 0x78803du, 0x565d6au,
    0x121417u, 0x2c30bbu, 0x383c7au, 0x5e646cu, 0x464d2du, 0x464d2eu, 0x464d2fu, 0x4e54abu, 0x42491cu, 0x282c5bu, 0x282c5du, 0x282cadu, 0x282c5eu, 0x282caeu, 0x282c5fu, 0x282cafu,
    0x7078fcu, 0x7a860bu, 0xe1037u, 0xe1018u, 0xe1039u, 0xe101au, 0x2c30b8u, 0x3e450cu, 0x282c59u, 0x24289au, 0x808e2cu, 0x808c8du, 0x808d2du, 0x808e2du, 0x808c8eu, 0x808d2eu,
    0x808e2eu, 0x808c8fu, 0x808d2fu, 0x808e2fu, 0x3e4509u, 0x3a408cu, 0x58617au, 0x7c8a1bu, 0x727d0cu, 0x5058bbu, 0x20244au, 0x20248au, 0x20248cu, 0xe1016u, 0x48513du, 0x48513eu,
    0x48513fu, 0x3238dbu, 0x202487u, 0x3a408au, 0x444d2cu, 0x7e8e2bu, 0x5a658au, 0x2e34cbu, 0x1c2079u, 0xa0c25u, 0xa0c26u, 0xa0c07u, 0xa0c28u, 0x404919u, 0x80923cu, 0x80909du,
    0x80913du, 0x80923du, 0x80909eu, 0x80913eu, 0x80923eu, 0x80909fu, 0x80913fu, 0x80923fu, 0x525ccbu, 0x2e34c8u, 0x2a306bu, 0x2a30bdu, 0x2a30beu, 0x2a30bfu, 0x80923bu, 0x60403u,
    0x80813u, 0x4a54bdu, 0x4a554du, 0x4a54beu, 0x4a554eu, 0x4a54bfu, 0x4a554fu, 0x56602cu, 0x1c2038u, 0x46513cu, 0x5c699au, 0x181c39u, 0x181c6bu, 0x121445u, 0x262caau, 0x343cebu,
    0x181c66u, 0x424d29u, 0x74851cu, 0x4c58cdu, 0x4c595du, 0x4c58ceu, 0x4c595eu, 0x4c58cfu, 0x4c595fu, 0x424c4bu, 0x80964bu, 0x80964cu, 0x8094adu, 0x8094bdu, 0x80954du, 0x80964du,
    0x80944eu, 0x80945eu, 0x8094aeu, 0x8094beu, 0x80954eu, 0x80964eu, 0x80944fu, 0x80945fu, 0x8094afu, 0x8094bfu, 0x80954fu, 0x80964fu, 0x5e6daau, 0x181c18u, 0x22289cu, 0x54601cu,
    0x48554cu, 0x222897u, 0x3a449cu, 0x141858u, 0x3038d8u, 0x76892cu, 0x2c34cdu, 0x2c34ceu, 0x2c34cfu, 0x6071bau, 0x141827u, 0x4e5d6du, 0x4e5d6eu, 0x4e5d6fu, 0x445139u, 0x3640fbu,
    0x64749cu, 0x1e2489u, 0x44505bu, 0x788d3cu, 0x60707cu, 0x4a595cu, 0x2830bau, 0x809a5bu, 0x809a5cu, 0x8098cdu, 0x80995du, 0x809a5du, 0x8098ceu, 0x80995eu, 0x809a5eu, 0x8098cfu,
    0x80995fu, 0x809a5fu, 0xe1034u, 0x7a904du, 0x6275cau, 0x2c341au, 0x5464dbu, 0x7a914cu, 0x1e2448u, 0x50617du, 0x50617eu, 0x50617fu, 0x465549u, 0x323ce8u, 0xa0c23u, 0x62748cu,
    0x7c945du, 0x46546bu, 0x4c5d6cu, 0x38450bu, 0x101447u, 0x6479dau, 0x7c955cu, 0x3c489au, 0x242ca7u, 0x5668ebu, 0x1a2076u, 0x809e6bu, 0x809e6cu, 0x809d6du, 0x809e6du, 0x809d6eu,
    0x809e6eu, 0x809d6fu, 0x809e6fu, 0x101407u, 0x7e996cu, 0x485959u, 0x667deau, 0x101426u, 0x2a34cau, 0x4e617cu, 0x3440f8u, 0x202899u, 0x586cfbu, 0x809d7cu, 0x3a491bu, 0x2a3469u,
    0x3e4caau, 0x141855u, 0x6881fau, 0x202819u, 0x4a5d69u, 0x161c68u, 0x50658cu, 0x50658du, 0x50658eu, 0x50658fu, 0x202858u, 0x5a710bu, 0x80a27bu, 0x80a18cu, 0x80a27cu, 0x80a17du,
    0x80a18du, 0x80a27du, 0x80a17eu, 0x80a18eu, 0x80a27eu, 0x80a17fu, 0x80a18fu, 0x80a27fu, 0x161c37u, 0x6a860au, 0x2630b7u, 0x4050bau, 0x3c4d2bu, 0x364508u, 0x303c3au, 0x2c38dau,
    0x4c6179u, 0x52699cu, 0x52699du, 0x52699eu, 0x52699fu, 0x5c751bu, 0x6c8a1au, 0x2c3879u, 0x72900du, 0x1c2486u, 0x222ca9u, 0xc1036u, 0x6e8e2au, 0x80a68bu, 0x80a59cu, 0x80a68cu,
    0x80a59du, 0x80a68du, 0x80a41eu, 0x80a59eu, 0x80a68eu, 0x80a41fu, 0x80a59fu, 0x80a68fu, 0xa0c05u, 0x5e792bu, 0x546dacu, 0x546dadu, 0x546daeu, 0x546dafu, 0x4254cau, 0x4e6589u,
    0x3e513bu, 0x384918u, 0x44595bu, 0x222c29u, 0x32404au, 0x2834c7u, 0x58703cu, 0x70923au, 0x222c68u, 0x2e3ceau, 0x607d3bu, 0x5671bcu, 0x5671bdu, 0x5671beu, 0x5671bfu, 0x121857u,
    0x506999u, 0x2e3c89u, 0x4458dau, 0x101444u, 0x72964au, 0xc1006u, 0x40554bu, 0x465d6bu, 0x182078u, 0x62814bu, 0x161c65u, 0x80aa9bu, 0x80a9acu, 0x80aa9cu, 0x80a9adu, 0x80aa9du,
    0x80a9aeu, 0x80aa9eu, 0x80a9afu, 0x80aa9fu, 0x3a4d28u, 0x5875ccu, 0x5875cdu, 0x5875ceu, 0x5875cfu, 0x3a4c0bu, 0x121836u, 0x182047u, 0x526da9u, 0x749a5au, 0x2430b9u, 0x3040fau,
    0x465ceau, 0x1e2896u, 0x2a38d7u, 0x769e6au, 0x243039u, 0x304099u, 0x769c2du, 0x5471b9u, 0x243078u, 0x60402u, 0x80812u, 0x3c5138u, 0x3c501bu, 0x78a27au, 0x80aeabu, 0x80adbcu,
    0x80aeacu, 0x80adbdu, 0x80aeadu, 0x80ac0eu, 0x80adbeu, 0x80aeaeu, 0x80ac0fu, 0x80adbfu, 0x80aeafu, 0x4860fau, 0x5675c9u, 0xc1033u, 0x32450au, 0x7aa68au, 0x3e5548u, 0x2c3ce7u,
    0x3244a9u, 0xa0c22u, 0x3e542bu, 0x4a650au, 0x7caa9au, 0x5879d9u, 0x64895bu, 0x202ca6u, 0x1a2457u, 0x7eaeaau, 0x182075u, 0x80b2bbu, 0x80b1ccu, 0x80b2bcu, 0x80b1cdu, 0x80b2bdu,
    0x80b02eu, 0x80b1ceu, 0x80b2beu, 0x80b02fu, 0x80b1cfu, 0x80b2bfu, 0x405958u, 0x668d6bu, 0x5a7de9u, 0x80b2bau, 0x3448b9u, 0x2e40f7u, 0x1a2428u, 0x74a01du, 0x121854u, 0x5c81f9u,
    0x425d68u, 0x80b6cau, 0x80b6cbu, 0x80b6ccu, 0x80b6cdu, 0x80b6ceu, 0x80b6cfu, 0x5e8609u, 0x2230b6u, 0x304507u, 0x446178u, 0x608a19u, 0xc1015u, 0x1a2485u, 0x628e29u, 0x466588u,
    0x324917u, 0x80badau, 0x80badbu, 0x80badcu, 0x80baddu, 0x80badeu, 0x80badfu, 0x2434c6u, 0x649239u, 0x486998u, 0x669649u, 0xe1443u, 0x344d27u, 0x141c64u, 0x162008u, 0x4a6da8u,
    0x689a59u, 0x1e2c09u, 0x80beeau, 0x80beebu, 0x80beecu, 0x80beedu, 0x80beeeu, 0x80beefu, 0x1c2895u, 0x2638d6u, 0x6a9e69u, 0x4c71b8u, 0x365137u, 0x6ca279u, 0x4e75c8u, 0xc1032u,
    0x6ea689u, 0x385547u, 0x283ce6u, 0x80c2fau, 0x80c2fbu, 0x80c2fcu, 0x80c2fdu, 0x80c2feu, 0x80c2ffu, 0x70aa99u, 0x40401u, 0x60811u, 0x80c21u, 0x5079d8u, 0x1e2ca5u, 0x72aea9u,
    0x162074u, 0x3a5957u, 0x527de8u, 0xe1425u, 0x74b2b9u, 0x2a40f6u, 0x76b6c9u, 0x101853u, 0x5481f8u, 0x80c70au, 0x80c70bu, 0x80c70cu, 0x80c70du, 0x80c70eu, 0x80c70fu, 0x3c5d67u,
    0x78bad9u, 0x568608u, 0x2030b5u, 0x7abee9u, 0x2c4506u, 0x2a400au, 0x3e6177u, 0x588a18u, 0x7cc2f9u, 0x182484u, 0x7ec709u, 0x5a8e28u, 0x80cb1au, 0x80cb1bu, 0x80cb1cu, 0x80cb1du,
    0x80cb1eu, 0x80cb1fu, 0x406587u, 0x80cb19u, 0x2e4916u, 0x2234c5u, 0x5c9238u, 0x426997u, 0x5e9648u, 0xe1442u, 0x304d26u, 0x121c63u, 0x446da7u, 0x609a58u, 0x52800cu, 0x80cf29u,
    0x80cf2au, 0x80cf2bu, 0x80cf2cu, 0x80cf2du, 0x80cf2eu, 0x80cf2fu, 0x1a2894u, 0x2438d5u, 0x629e68u, 0x4671b7u, 0x325136u, 0x64a278u, 0x4875c7u, 0x66a688u, 0xa1031u, 0x345546u,
    0x263ce5u, 0x68aa98u, 0x4a79d7u, 0x80d339u, 0x80d33au, 0x80d33bu, 0x80d33cu, 0x80d33du, 0x80d33eu, 0x80d33fu, 0x1c2ca4u, 0x6aaea8u, 0x142073u, 0x365956u, 0x4c7de7u, 0x6cb2b8u,
    0x40400u, 0x60810u, 0x80c20u, 0x2840f5u, 0x6eb6c8u, 0x4e81f7u, 0x101852u, 0x385d66u, 0x70bad8u, 0x508607u, 0x1e30b4u, 0x72bee8u, 0x2a4505u, 0x80d749u, 0x80d74au, 0x80d74bu,
    0x80d74cu, 0x80d74du, 0x80d74eu, 0x80d74fu, 0x3a6176u, 0x528a17u, 0x74c2f8u, 0x162483u, 0x76c708u, 0x548e27u, 0x3c6586u, 0x78cb18u, 0x2c4915u, 0x2034c4u, 0x569237u, 0x7acf28u,
    0x3e6996u, 0x7cd338u, 0x589647u, 0xc1441u, 0x2e4d25u, 0x80db59u, 0x80db5au, 0x80db5bu, 0x80db5cu, 0x80db5du, 0x80db5eu, 0x80db5fu, 0x7ed748u, 0x121c62u, 0x406da6u, 0x5a9a57u,
    0x80db58u, 0x182893u, 0x2238d4u, 0x5c9e67u, 0x4271b6u, 0x305135u, 0x5ea277u, 0x4475c6u, 0x60a687u, 0x325545u, 0x243ce4u, 0x62aa97u, 0x4679d6u, 0x80df68u, 0x80df69u, 0x80df6au,
    0x80df6bu, 0x80df6cu, 0x80df6du, 0x80df6eu, 0x80df6fu, 0xa1030u, 0x1a2ca3u, 0x64aea7u, 0x142072u, 0x80c04u, 0x345955u, 0x487de6u, 0x66b2b7u, 0x2640f4u, 0x68b6c7u, 0x4a81f6u,
    0xe1851u, 0x365d65u, 0x6abad7u, 0x4c8606u, 0x1c30b3u, 0x6cbee7u, 0x284504u, 0x386175u, 0x4e8a16u, 0x6ec2f7u, 0x80e378u, 0x80e379u, 0x80e37au, 0x80e37bu, 0x80e37cu, 0x80e37du,
    0x80e37eu, 0x80e37fu, 0x70c707u, 0x162482u, 0x508e26u, 0x3a6585u, 0x72cb17u, 0x2a4914u, 0x529236u, 0x1e34c3u, 0x74cf27u, 0x3c6995u, 0x76d337u, 0x549646u, 0x2c4d24u, 0x78d747u,
    0x101c61u, 0x569a56u, 0x3e6da5u, 0xc1440u, 0x7adb57u, 0x182892u, 0x2038d3u, 0x589e66u, 0x7cdf67u, 0x4071b5u, 0x2e5134u, 0x7ee377u, 0x5aa276u, 0x80e788u, 0x80e789u, 0x80e78au,
    0x80e78bu, 0x80e78cu, 0x80e78du, 0x80e78eu, 0x80e78fu, 0x80e787u, 0x4275c5u, 0x5ca686u, 0x305544u, 0x223ce3u, 0x5eaa96u, 0x4479d5u, 0x1a2ca2u, 0x60aea6u, 0x122071u, 0x325954u,
    0x467de5u, 0x62b2b6u, 0x2440f3u, 0x64b6c6u, 0x4881f5u, 0x345d64u, 0x66bad6u, 0xe1850u, 0x4a8605u, 0x1c30b2u, 0x68bee6u, 0x264503u, 0x80eb97u, 0x80eb98u, 0x80eb99u, 0x80eb9au,
    0x80eb9bu, 0x80eb9cu, 0x80eb9du, 0x80eb9eu, 0x80eb9fu, 0x366174u, 0x4c8a15u, 0x6ac2f6u, 0x6cc706u, 0x142481u, 0x4e8e25u, 0x386584u, 0x6ecb16u, 0x284913u, 0x509235u, 0x1e34c2u,
    0x70cf26u, 0x3a6994u, 0x72d336u, 0x529645u, 0x74d746u, 0x2a4d23u, 0x549a55u, 0x3c6da4u, 0x76db56u, 0x101c60u, 0x162891u, 0x2038d2u, 0x569e65u, 0x78df66u, 0x3e71b4u, 0x2c5133u,
    0x7ae376u, 0x58a275u, 0x7ce786u, 0x4075c4u, 0x5aa685u, 0x80efa7u, 0x80efa8u, 0x80efa9u, 0x80efaau, 0x80efabu, 0x80efacu, 0x80efadu, 0x80efaeu, 0x80efafu, 0x7eeb96u, 0x2e5543u,
    0x223ce2u, 0x80efa6u, 0x5caa95u, 0x4279d4u, 0x182ca1u, 0x5eaea5u, 0x305953u, 0x447de4u, 0x60b2b5u, 0x122070u, 0x2440f2u, 0x62b6c5u, 0x4681f4u, 0x325d63u, 0x64bad5u, 0x488604u,
    0x1a30b1u, 0x66bee5u, 0x264502u, 0x346173u, 0x4a8a14u, 0x68c2f5u, 0x6ac705u, 0x4c8e24u, 0x366583u, 0x142480u, 0x6ccb15u, 0x284912u, 0x4e9234u, 0x1c34c1u, 0x6ecf25u, 0x386993u,
    0x70d335u, 0x80f3b6u, 0x80f3b7u, 0x80f3b8u, 0x80f3b9u, 0x80f3bau, 0x80f3bbu, 0x80f3bcu, 0x80f3bdu, 0x80f3beu, 0x80f3bfu, 0x509644u, 0x72d745u, 0x2a4d22u, 0x529a54u, 0x3a6da3u,
    0x74db55u, 0x1e38d1u, 0x549e64u, 0x76df65u, 0x162890u, 0x3c71b3u, 0x2c5132u, 0x78e375u, 0x56a274u, 0x7ae785u, 0x3e75c3u, 0x58a684u, 0x7ceb95u, 0x2e5542u, 0x203ce1u, 0x7eefa5u,
    0x5aaa94u, 0x4079d3u, 0x80f3b5u, 0x5caea4u, 0x182ca0u, 0x305952u, 0x427de3u, 0x5eb2b4u, 0x2240f1u, 0x60b6c4u, 0x4481f3u, 0x325d62u, 0x62bad4u, 0x468603u, 0x64bee4u, 0x1a30b0u,
    0x244501u, 0x346172u, 0x488a13u, 0x66c2f4u, 0x68c704u, 0x4a8e23u, 0x366582u, 0x80f7c5u, 0x80f7c6u, 0x80f7c7u, 0x80f7c8u, 0x80f7c9u, 0x80f7cau, 0x80f7cbu, 0x80f7ccu, 0x80f7cdu,
    0x80f7ceu, 0x80f7cfu, 0x6acb14u, 0x264911u, 0x4c9233u, 0x6ccf24u, 0x1c34c0u, 0x386992u, 0x6ed334u, 0x4e9643u, 0x70d744u, 0x284d21u, 0x509a53u, 0x3a6da2u, 0x72db54u, 0x74df64u,
    0x529e63u, 0x1e38d0u, 0x3c71b2u, 0x2a5131u, 0x76e374u, 0x54a273u, 0x78e784u, 0x3e75c2u, 0x56a683u, 0x7aeb94u, 0x2c5541u, 0x7cefa4u, 0x58aa93u, 0x203ce0u, 0x4079d2u, 0x7ef3b4u,
    0x5aaea3u, 0x80f7c4u, 0x2e5951u, 0x427de2u, 0x5cb2b3u, 0x5eb6c3u, 0x2240f0u, 0x4481f2u, 0x305d61u, 0x60bad3u, 0x468602u, 0x62bee3u, 0x326171u, 0x244500u, 0x488a12u, 0x64c2f3u,
    0x66c703u, 0x4a8e22u, 0x346581u, 0x68cb13u, 0x264910u, 0x4c9232u, 0x6acf23u, 0x366991u, 0x6cd333u, 0x4e9642u, 0x6ed743u, 0x284d20u, 0x509a52u, 0x80fbd4u, 0x80fbd5u, 0x80fbd6u,
    0x80fbd7u, 0x80fbd8u, 0x80fbd9u, 0x80fbdau, 0x80fbdbu, 0x80fbdcu, 0x80fbddu, 0x80fbdeu, 0x80fbdfu, 0x386da1u, 0x70db53u, 0x72df63u, 0x529e62u, 0x3a71b1u, 0x74e373u, 0x2a5130u,
    0x54a272u, 0x76e783u, 0x3c75c1u, 0x56a682u, 0x78eb93u, 0x7aefa3u, 0x2c5540u, 0x58aa92u, 0x3e79d1u, 0x7cf3b3u, 0x5aaea2u, 0x7ef7c3u, 0x407de1u, 0x80fbd3u, 0x2e5950u, 0x5cb2b2u,
    0x5eb6c2u, 0x4281f1u, 0x305d60u, 0x60bad2u, 0x448601u, 0x62bee2u, 0x326170u, 0x468a11u, 0x64c2f2u, 0x66c702u, 0x488e21u, 0x346580u, 0x68cb12u, 0x4a9231u, 0x6acf22u, 0x366990u,
    0x6cd332u, 0x4c9641u, 0x6ed742u, 0x4e9a51u, 0x386da0u, 0x70db52u, 0x72df62u, 0x509e61u, 0x74e372u, 0x3a71b0u, 0x52a271u, 0x76e782u, 0x54a681u, 0x78eb92u, 0x3c75c0u, 0x7aefa2u,
    0x56aa91u, 0x7cf3b2u, 0x3e79d0u, 0x58aea1u, 0x7ef7c2u, 0x80fbd2u, 0x407de0u, 0x5ab2b1u, 0x5cb6c1u, 0x4281f0u, 0x5ebad1u, 0x448600u, 0x60bee1u, 0x62c2f1u, 0x468a10u, 0x64c701u,
    0x488e20u, 0x66cb11u, 0x4a9230u, 0x68cf21u, 0x6ad331u, 0x4c9640u, 0x6cd741u, 0x4e9a50u, 0x6edb51u, 0x80ffe2u, 0x80ffe3u, 0x80ffe4u, 0x80ffe5u, 0x80ffe6u, 0x80ffe7u, 0x80ffe8u,
    0x80ffe9u, 0x80ffeau, 0x80ffebu, 0x80ffecu, 0x80ffedu, 0x80ffeeu, 0x80ffefu, 0x70df61u, 0x509e60u, 0x72e371u, 0x52a270u, 0x74e781u, 0x76eb91u, 0x54a680u, 0x78efa1u, 0x56aa90u,
    0x7af3b1u, 0x58aea0u, 0x7cf7c1u, 0x7efbd1u, 0x5ab2b0u, 0x80ffe1u, 0x5cb6c0u, 0x5ebad0u, 0x60bee0u, 0x62c2f0u, 0x64c700u, 0x66cb10u, 0x68cf20u, 0x6ad330u, 0x6cd740u, 0x6edb50u,
    0x70df60u, 0x72e370u, 0x74e780u, 0x76eb90u, 0x78efa0u, 0x7af3b0u, 0x7cf7c0u, 0x7efbd0u, 0x80ffe0u,
};
__device__ __forceinline__ void phase_attn_sel(const bf16* Q, const bf16* K, const bf16* V, const unsigned* sel, const float* qn2, bf16* part0, bf16* part12, float* lse, gu32* qctr, LAS unsigned char* lds, const int wave0, bool nostore = false) {
    int tid = wave0 * 64 + mk_lane(); asm volatile("" : "+v"(tid)); const int lane = tid & 63, wave = __builtin_amdgcn_readfirstlane(tid >> 6);
    const int fr = lane & 15, fq = lane >> 4;
    LAS unsigned* cw = (LAS unsigned*)(lds + A_CNT);
    LAS unsigned short* list = (LAS unsigned short*)(lds + A_LIST);
    constexpr int NU = SEL_NU;
    if (tid == 0) { cw[4] = __hip_atomic_fetch_add(qctr, 1u, RLX_AGENT); cw[0] = 0u; cw[1] = 0u; cw[2] = 0u; cw[3] = 0u; }
    __syncthreads();
    int unit = (int)cw[4];
    for (int par = 0; unit < NU; par ^= 1) {
        const unsigned te = sel_unit_tab[unit];
        const int h = (int)(te & 15u), n = (int)((te >> 4) & 63u), jlo = (int)((te >> 10) & 127u), jhi = (int)((te >> 17) & 127u);
        const float slope2 = head_slope2(h);
        LAS unsigned* lcnt = cw + par;
        u32x4 kv[4], vv[4];
        kv_load(K, V, n, h, kv, vv, tid, wave, lane);
        const int tbase = jlo * BS, tlim = min(min(S_, jhi * BS), n * BS + BS + (int)(160.0f / slope2) + 1);
        unsigned sv[32];
#pragma unroll
        for (int i = 0; i < 32; ++i) { const int t = tbase + i * 512 + tid; sv[i] = 0xffffffffu; if (tbase + i * 512 < tlim) { if (t < tlim) sv[i] = sel[(size_t)h * S_ + t]; } }
        kv_write(kv, vv, lds, cw + 2 + par, tid, wave, lane);
        if (tid == 0) { cw[4 + (par ^ 1)] = __hip_atomic_fetch_add(qctr, 1u, RLX_AGENT); cw[par ^ 1] = 0u; cw[2 + (par ^ 1)] = 0u; }
        unsigned long long code = 0ull; int total = 0;
#pragma unroll
        for (int i = 0; i < 32; ++i) {
            if (tbase + i * 512 < tlim) {
                const unsigned s = sv[i];
                unsigned k1 = (s & 0xffu) == (unsigned)n ? 1u : ((s >> 8) & 0xffu) == (unsigned)n ? 2u : ((s >> 16) & 0xffu) == (unsigned)n ? 3u : 0u;
                if (alibi_dead(slope2, tbase + i * 512 + tid, n)) k1 = 0u;
                code |= (unsigned long long)k1 << (2 * i);
                total += __popcll(__ballot(k1 != 0u));
            }
        }
        unsigned wbase = 0u; if (lane == 0 && total) wbase = __hip_atomic_fetch_add(lcnt, (unsigned)total, __ATOMIC_RELAXED, __HIP_MEMORY_SCOPE_WORKGROUP);
        wbase = (unsigned)__builtin_amdgcn_readfirstlane((int)wbase);
#pragma unroll
        for (int i = 0; i < 32; ++i) {
            if (tbase + i * 512 < tlim) {
                const unsigned k1 = (unsigned)(code >> (2 * i)) & 3u;
                const unsigned long long bal = __ballot(k1 != 0u);
                if (bal) {
                    const unsigned pre = __builtin_amdgcn_mbcnt_hi((unsigned)(bal >> 32), __builtin_amdgcn_mbcnt_lo((unsigned)bal, 0u));
                    if (k1) list[wbase + pre] = (unsigned short)((tbase + i * 512 + tid) | ((k1 - 1u) << 14));
                    wbase += (unsigned)__popcll(bal);
                }
            }
        }
        __syncthreads();
        const int N = (int)*lcnt, ntiles = (N + 15) >> 4;
        const float kmax2 = __uint_as_float(cw[2 + par]);
        const int nunit = (int)cw[4 + (par ^ 1)];
        int tile = wave; bool valid = false; int t = 0, k = 0; bf16x8 q0 = {}, q1 = {}; float qn = 0.f;
        if (tile < ntiles) { int idx = tile * 16 + fr; valid = idx < N; if (!valid) idx = N - 1; const unsigned e = list[idx]; t = (int)(e & 0x3fffu); k = (int)(e >> 14);
            const bf16* qrow = Q + (size_t)t * D_ + h * 64; q0 = *(const bf16x8*)(qrow + 8 * fq); q1 = *(const bf16x8*)(qrow + 32 + 8 * fq); qn = qn2[(size_t)h * S_ + t]; }
        while (tile < ntiles) {
            const int ntile = tile + NWAVES; bool nvalid = false; int nt = 0, nk = 0; bf16x8 nq0 = {}, nq1 = {}; float nqn = 0.f;
            if (ntile < ntiles) { int idx = ntile * 16 + fr; nvalid = idx < N; if (!nvalid) idx = N - 1; const unsigned e = list[idx]; nt = (int)(e & 0x3fffu); nk = (int)(e >> 14);
                const bf16* qrow = Q + (size_t)nt * D_ + h * 64; nq0 = *(const bf16x8*)(qrow + 8 * fq); nq1 = *(const bf16x8*)(qrow + 32 + 8 * fq); nqn = qn2[(size_t)h * S_ + nt]; }
            const float m = __builtin_amdgcn_sqrtf(qn * kmax2) * 1.0005f + 0.01f;
            const float lcm = slope2 * (float)(n * BS + 8 * fq - t) - m;
            f32x4 o[4]; float l;
            attn_tile<false>(lds + A_KS, lds + A_VT, q0, q1, lcm, slope2, 0, 8, fr, fq, o, l);
            const float il = l > 0.f ? 1.0f / l : 0.f;
            {
                LAS unsigned char* ost = lds + A_OST + wave * (16 * A_OPITCH);
#pragma unroll
                for (int dt = 0; dt < 4; ++dt) { u32x2 w; w.x = cvt_pk_bf16(o[dt][0] * il, o[dt][1] * il); w.y = cvt_pk_bf16(o[dt][2] * il, o[dt][3] * il); *(LAS u32x2*)(ost + fr * A_OPITCH + (16 * dt + 4 * fq) * 2) = w; }
                LDS_WAIT(); asm volatile("" ::: "memory");
#pragma unroll
                for (int i = 0; i < 2; ++i) {
                    const int q = (lane >> 3) + 8 * i, p = lane & 7;
                    const u32x4 v = *(LAS const u32x4*)(ost + q * A_OPITCH + p * 16);
                    const int tq = shi(t, q), kq = shi(k, q), vq = shi((int)valid, q);
                    if (vq && !nostore) *(u32x4*)((kq == 0 ? part0 : part12 + (size_t)(kq - 1) * S_ * D_) + (size_t)tq * D_ + h * 64 + p * 8) = v;
                }
                if (valid && fq == 0) lse[((size_t)k * S_ + t) * NH + h] = m + __builtin_amdgcn_logf(l);
                LDS_WAIT(); asm volatile("" ::: "memory");
            }
            tile = ntile; valid = nvalid; t = nt; k = nk; q0 = nq0; q1 = nq1; qn = nqn;
        }
        __syncthreads();
        unit = nunit;
    }
}
__device__ __forceinline__ void phase_attn_own(bf16* Q, const bf16* K, const bf16* V, const unsigned* sel, const float* qn2, const bf16* part0, const bf16* part12, const float* lse, LAS unsigned char* lds, const int wave0, bool nostore = false) {
    int tid = wave0 * 64 + mk_lane(); asm volatile("" : "+v"(tid)); const int lane = tid & 63, wave = __builtin_amdgcn_readfirstlane(tid >> 6);
    const int fr = lane & 15, fq = lane >> 4;
    LAS unsigned* cw = (LAS unsigned*)(lds + A_CNT);
    if (tid == 0) { cw[2] = 0u; cw[3] = 0u; }
    __syncthreads();
    int par = 0;
    u32x4 kv[4], vv[4];
    { const int u0 = (int)blockIdx.x; kv_load(K, V, u0 >> 4, ((u0 & 15) + 4 * (u0 >> 8)) & 15, kv, vv, tid, wave, lane); }
    for (int unit = blockIdx.x; unit < NBLK * NH; unit += gridDim.x, par ^= 1) {
        const int j = unit >> 4, h = ((unit & 15) + 4 * (unit >> 8)) & 15;
        const int nv = j < 3 ? j : 3;
        bf16x8 qf[2][2]; float qnv[2]; unsigned selv[2];
#pragma unroll
        for (int half = 0; half < 2; ++half) {
            const int t = j * BS + (half ? 15 - wave : wave) * 16 + fr;
            const bf16* qrow = Q + (size_t)t * D_ + h * 64;
            qf[half][0] = *(const bf16x8*)(qrow + 8 * fq); qf[half][1] = *(const bf16x8*)(qrow + 32 + 8 * fq);
            qnv[half] = qn2[(size_t)h * S_ + t];
            selv[half] = nv > 0 ? sel[(size_t)h * S_ + t] : 0xffffffffu;
        }
        kv_write(kv, vv, lds, cw + 2 + par, tid, wave, lane);
        if (tid == 0) cw[2 + (par ^ 1)] = 0u;
        __syncthreads();
        const float kmax2 = __uint_as_float(cw[2 + par]);
        const float slope2 = head_slope2(h);
#pragma unroll
        for (int half = 0; half < 2; ++half) {
            const int tile = half ? 15 - wave : wave;
            const int tq = tile * 16 + fr, t = j * BS + tq;
            const bf16x8 q0 = qf[half][0], q1 = qf[half][1];
            float lk[3]; u32x2 pv[3][4];
            const unsigned selw = selv[half];
#pragma unroll
            for (int k = 0; k < 3; ++k) {
                lk[k] = -INFINITY;
#pragma unroll
                for (int dt = 0; dt < 4; ++dt) pv[k][dt] = (u32x2){0u, 0u};
                if (k < nv && !alibi_dead(slope2, t, (int)((selw >> (8 * k)) & 0xffu))) {
                    lk[k] = lse[((size_t)k * S_ + t) * NH + h];
                    const bf16* pp = (k == 0 ? part0 : part12 + (size_t)(k - 1) * S_ * D_) + (size_t)t * D_ + h * 64 + 4 * fq;
#pragma unroll
                    for (int dt = 0; dt < 4; ++dt) pv[k][dt] = *(const u32x2*)(pp + dt * 16);
                }
            }
            if (half == 0) {
                const int nu = unit + (int)gridDim.x;
                if (nu < NBLK * NH) kv_load(K, V, nu >> 4, ((nu & 15) + 4 * (nu >> 8)) & 15, kv, vv, tid, wave, lane);
            }
            const float m = __builtin_amdgcn_sqrtf(qnv[half] * kmax2) * 1.0005f + 0.01f;
            const float lcm = slope2 * (float)(8 * fq - tq) - m;
            f32x4 o[4]; float l;
            attn_tile<true>(lds + A_KS, lds + A_VT, q0, q1, lcm, slope2, tq, (tile >> 1) + 1, fr, fq, o, l);
            const float lown = m + __builtin_amdgcn_logf(l), il = 1.0f / l;
            const float M = fmaxf(fmaxf(lown, lk[0]), fmaxf(lk[1], lk[2]));
            const float e0 = __builtin_amdgcn_exp2f(lown - M), w0 = e0 * il;
            float wsum = e0;
#pragma unroll
            for (int dt = 0; dt < 4; ++dt) o[dt] = o[dt] * w0;
#pragma unroll
            for (int k = 0; k < 3; ++k) {
                const float wk = __builtin_amdgcn_exp2f(lk[k] - M);
                wsum += wk;
#pragma unroll
                for (int dt = 0; dt < 4; ++dt) { o[dt][0] += wk * bf_lo(pv[k][dt].x); o[dt][1] += wk * bf_hi(pv[k][dt].x); o[dt][2] += wk * bf_lo(pv[k][dt].y); o[dt][3] += wk * bf_hi(pv[k][dt].y); }
            }
            const float inv = 1.0f / wsum;
            {
                LAS unsigned char* ost = lds + A_OST + wave * (16 * A_OPITCH);
#pragma unroll
                for (int dt = 0; dt < 4; ++dt) { u32x2 w; w.x = cvt_pk_bf16(o[dt][0] * inv, o[dt][1] * inv); w.y = cvt_pk_bf16(o[dt][2] * inv, o[dt][3] * inv); *(LAS u32x2*)(ost + fr * A_OPITCH + (16 * dt + 4 * fq) * 2) = w; }
                LDS_WAIT(); asm volatile("" ::: "memory");
#pragma unroll
                for (int i = 0; i < 2; ++i) {
                    const int q = (lane >> 3) + 8 * i, p = lane & 7;
                    const u32x4 v = *(LAS const u32x4*)(ost + q * A_OPITCH + p * 16);
                    if (!nostore) *(u32x4*)(Q + (size_t)(j * BS + tile * 16 + q) * D_ + h * 64 + p * 8) = v;
                }
                LDS_WAIT(); asm volatile("" ::: "memory");
            }
        }
        __syncthreads();
    }
}
struct Args { const float* in[10]; float* out; unsigned char* ws; };
typedef const __attribute__((address_space(4))) Args* CArgsP;
__device__ __forceinline__ CArgsP KA() { unsigned long long p = (unsigned long long)__builtin_amdgcn_kernarg_segment_ptr(); asm volatile("" : "+s"(p)); return (CArgsP)p; }
__device__ __forceinline__ Ptrs make_ptrs(CArgsP a) { Ptrs P; P.x = a->in[0]; P.ln = a->in[1]; P.wg = a->in[2]; P.wu = a->in[3]; P.wd = a->in[4]; P.wqkv = a->in[5]; P.wo = a->in[6]; P.pw = a->in[7]; P.ps = a->in[8]; P.fg = a->in[9]; P.out = a->out; P.ws = a->ws; return P; }
__device__ __forceinline__ void phase_tailconv(LAS unsigned char* lds, int f, const int wave0) {
    int tid = wave0 * 64 + mk_lane(); asm volatile("" : "+v"(tid)); const int lane = tid & 63, wave = __builtin_amdgcn_readfirstlane(tid >> 6);
    const Ptrs P = make_ptrs(KA());
    const int ww = ((int)blockIdx.x - 128) * NWAVES + wave, n_ww = 128 * NWAVES;
    convert_items(P, lds, (f + 1) * IT_FFN, (f + 2) * IT_FFN, ww, n_ww, wave, lane);
    if (f == 0) { convert_items(P, lds, 8 * IT_FFN, 8 * IT_FFN + IT_ATT, ww, n_ww, wave, lane); convert_items(P, lds, 8 * IT_FFN + 2 * IT_ATT, IT_TOTAL, ww, n_ww, wave, lane); }
    if (f == 2) convert_items(P, lds, 8 * IT_FFN + IT_ATT, 8 * IT_FFN + IT_ATT + IT_ATT / 2, ww, n_ww, wave, lane);
    if (f == 3) convert_items(P, lds, 8 * IT_FFN + IT_ATT + IT_ATT / 2, 8 * IT_FFN + 2 * IT_ATT, ww, n_ww, wave, lane);
}
__global__ void __launch_bounds__(NWAVES * 64, 2) mk_fwd(Args args) {
    extern __shared__ __attribute__((aligned(16))) unsigned char lds_raw[];
    LAS unsigned char* lds = (LAS unsigned char*)lds_raw;
    volatile LAS unsigned* MISC = (volatile LAS unsigned*)(lds + MISC_OFF);
    const int G = gridDim.x;
    gu32* ctl = (gu32*)(KA()->ws + WS_CTL);
    for (int u = threadIdx.x; u < (LDS_BYTES - LDSCTL_OFF) / 4; u += NWAVES * 64) ((LAS unsigned*)(lds + LDSCTL_OFF))[u] = 0u;
    __syncthreads();
    const int wave0 = __builtin_amdgcn_readfirstlane((int)threadIdx.x >> 6);
    XcdBarrier bar = xcd_barrier_post((unsigned*)(ctl + CW_BAR), MISC + 8, wave0 == 0 && mk_lane() == 0);
    (void)bar;
#define GRID_BAR() do { unsigned long long wsl_ = (unsigned long long)KA()->ws; XcdBarrier b_; b_.bar = (unsigned*)(wsl_ + WS_CTL) + CW_BAR; b_.x = xb_xcc_id(); \
        b_.st = (volatile LAS unsigned*)(lds + MISC_OFF) + 8; xcd_barrier(b_, wave0 == 0 && mk_lane() == 0); } while (0)
#define NREP(p) ((PROBE == (p)) ? 2 : 1)
    for (int rep = 0; rep < NREP(5); ++rep) { Ptrs P2 = make_ptrs(KA()); phase_prologue(P2, lds, wave0); GRID_BAR(); }
#define WSL() (KA()->ws)
#pragma clang loop unroll(full)
    for (int f = 0; f < 8; ++f) {
        for (int rep = 0; rep < NREP(3) * NREP(13); ++rep) {
            unsigned char* w = WSL();
            pg8::Gemm g{(const bf16*)(w + WS_XB), ws_wgu(w, f), S_, NGU, D_}; pg8::StaticOrder S; S.init(S_, NGU, G, (int)blockIdx.x);
            rstd_table(lds, (const float*)(w + ((f & 3) == 3 ? WS_SSQB : WS_SSQ)), S, wave0);
            EpiSwiGLU E{(bf16*)(w + ((PROBE == 13 && rep == 0) ? WS_END : WS_BIG)), (LAS const float*)(lds + RSTD_OFF), PROBE == 13 && rep == 0};
            pg8::gemm_phase<EpiSwiGLU, pg8::StaticOrder, PG8_ALIGN, PG8_SP2>(lds, g, S, E, wave0);
            if (TAILCONV && G == 256 && rep == 0 && f < 7 && blockIdx.x >= 128) phase_tailconv(lds, f, wave0);
            GRID_BAR();
        }
        for (int rep = 0; rep < NREP(4) * NREP(14) * NREP(24) * NREP(25); ++rep) {
            unsigned char* w = WSL();
            pg8::Gemm g{(const bf16*)(w + WS_BIG), ws_wd(w, f), S_, D_, FF_}; pg8::StaticOrder S; S.init(S_, D_, G, (int)blockIdx.x);
            EpiResid<false, 1> E{(bf16*)(w + WS_XB), (float*)(w + WS_SSQ), nullptr, (f & 3) == 2 ? (bf16*)(w + WS_HALO) : nullptr};
            pg8::gemm_phase<EpiResid<false, 1>, pg8::StaticOrder, false, PG8_SP2>(lds, g, S, E, wave0);
            GRID_BAR();
        }
        if ((f & 1) == 0) {
            const int L = f >> 1, mi = L >> 1;
            if ((L & 1) == 0) {
                for (int rep = 0; rep < NREP(6); ++rep) {
                    unsigned char* w = WSL();
                    pg8::Gemm g{(const bf16*)(w + WS_XB), ws_wqkv(w, mi), S_, 3 * D_, D_}; pg8::StaticOrder S; S.init(S_, 3 * D_, G, (int)blockIdx.x);
                    rstd_table(lds, (const float*)(w + WS_SSQ), S, wave0);
                    EpiQKV E{(bf16*)(w + WS_BIG), (LAS const float*)(lds + RSTD_OFF), (float*)(w + WS_KPART)};
                    pg8::gemm_phase<EpiQKV, pg8::StaticOrder, PG8_ALIGN, PG8_SP2>(lds, g, S, E, wave0);
                    GRID_BAR();
                }
                for (int rep = 0; rep < NREP(1); ++rep) {
                    for (int r2 = 0; r2 < NREP(7); ++r2) { unsigned char* w = WSL(); phase_gate((const bf16*)(w + WS_BIG), (const float*)(w + WS_KPART), (unsigned*)(w + WS_SEL), (float*)(w + WS_QN2), lds, wave0); GRID_BAR(); }
                    for (int r2 = 0; r2 < NREP(8) * NREP(18) * NREP(28) * NREP(29); ++r2) { unsigned char* w = WSL(); bf16* B = (bf16*)(w + WS_BIG);
                      phase_attn_sel(B, B + (size_t)S_ * D_, B + (size_t)2 * S_ * D_, (const unsigned*)(w + WS_SEL), (const float*)(w + WS_QN2), (bf16*)(w + WS_WFFN + (size_t)(mi == 0 ? 2 : 0) * WFFN_STRIDE), (bf16*)(w + WS_XB + 32 * MiB), (float*)(w + WS_LSE), (gu32*)(w + WS_CTL) + CW_QA + 64 * (mi + 2 * (rep + r2)), lds, wave0, (PROBE == 18 || PROBE == 28 || PROBE == 29) && r2 == 0 && ((const unsigned*)(w + WS_CTL))[2] == 0u);
                      GRID_BAR(); }
                    for (int r2 = 0; r2 < NREP(9); ++r2) { unsigned char* w = WSL(); bf16* B = (bf16*)(w + WS_BIG);
                      phase_attn_own(B, B + (size_t)S_ * D_, B + (size_t)2 * S_ * D_, (const unsigned*)(w + WS_SEL), (const float*)(w + WS_QN2), (const bf16*)(w + WS_WFFN + (size_t)(mi == 0 ? 2 : 0) * WFFN_STRIDE), (const bf16*)(w + WS_XB + 32 * MiB), (const float*)(w + WS_LSE), lds, wave0, (rep + r2 + 1) < NREP(1) * NREP(9));
                      GRID_BAR(); }
                }
                for (int rep = 0; rep < NREP(6); ++rep) {
                    unsigned char* w = WSL();
                    pg8::Gemm g{(const bf16*)(w + WS_BIG), ws_wo(w, mi), S_, D_, D_}; pg8::StaticOrder S; S.init(S_, D_, G, (int)blockIdx.x);
                    EpiResid<false, 2> E{(bf16*)(w + WS_XB), (float*)(w + WS_SSQ), nullptr, nullptr};
                    pg8::gemm_phase<EpiResid<false, 2>, pg8::StaticOrder, false, PG8_SP2>(lds, g, S, E, wave0);
                    GRID_BAR();
                }
            } else {
                for (int rep = 0; rep < NREP(2); ++rep) {
                    { unsigned char* w = WSL(); phase_pool_elem((const bf16*)(w + WS_XB), (const float*)(w + WS_SSQ), KA()->in[1] + (L * 3 + 1) * D_, (bf16*)(w + WS_BIG), (const bf16*)(w + WS_HALO), lds, wave0); }
                    {
                        unsigned char* w = WSL();
                        pg8::Gemm g{(const bf16*)(w + WS_BIG), ws_wp(w, mi), 4 * S_, 256, 256}; PoolOrder S{G, (int)blockIdx.x};
                        EpiResid<true, 2> E{(bf16*)(w + WS_XB), (float*)(w + WS_SSQB), KA()->in[8] + mi * D_, nullptr};
                        pg8::gemm_phase<EpiResid<true, 2>, PoolOrder, false, PG8_SP2>(lds, g, S, E, wave0);
                    }
                    GRID_BAR();
                }
            }
        }
    }
    { Ptrs P2 = make_ptrs(KA()); const bool poison = (__hip_atomic_load((gu32*)(P2.ws + WS_CTL) + CW_BAR + XB_TMO, RLX_AGENT) != 0u) || (G != 256);
      phase_final(P2, poison, wave0); }
}

extern "C" void kernel_launch(void* const* d_in, const int* in_sizes, int n_in, void* d_out, int out_size, void* d_ws, size_t ws_size, hipStream_t stream) {
    static int grid = 0;
    if (grid == 0) {
        if (n_in != 10 || in_sizes[0] != S_ * D_ || out_size != S_ * D_ || ws_size < WS_END) { fprintf(stderr, "kernel_launch: unexpected shapes / workspace (%zu < %zu)\n", ws_size, (size_t)WS_END); grid = -1; return; }
        int dev = 0, cus = 0, per_cu = 0;
        if (hipGetDevice(&dev) != hipSuccess || hipDeviceGetAttribute(&cus, hipDeviceAttributeMultiprocessorCount, dev) != hipSuccess) { grid = -1; return; }
        if (hipFuncSetAttribute((const void*)mk_fwd, hipFuncAttributeMaxDynamicSharedMemorySize, LDS_BYTES) != hipSuccess) { fprintf(stderr, "kernel_launch: hipFuncSetAttribute failed\n"); grid = -1; return; }
        if (hipOccupancyMaxActiveBlocksPerMultiprocessor(&per_cu, (const void*)mk_fwd, NWAVES * 64, LDS_BYTES) != hipSuccess || per_cu < 1) { fprintf(stderr, "kernel_launch: occupancy query says %d\n", per_cu); }
        (void)hipGetLastError();
        grid = cus;
    }
    if (grid < 0) return;
    if (hipMemsetAsync((char*)d_ws + WS_CTL, 0, CTL_ZERO_BYTES, stream) != hipSuccess) return;
    Args a{};
    for (int i = 0; i < 10; ++i) a.in[i] = (const float*)d_in[i];
    a.out = (float*)d_out; a.ws = (unsigned char*)d_ws;
    hipLaunchKernelGGL(mk_fwd, dim3(grid), dim3(NWAVES * 64), LDS_BYTES, stream, a);
}
```

```cpp
#include <hip/hip_runtime.h>
#include <cstdio>
#include <cstdint>
#include <type_traits>
__device__ __forceinline__ float shx(float v, int mask, int lane) { return __builtin_bit_cast(float, __builtin_amdgcn_ds_bpermute((lane ^ mask) << 2, __builtin_bit_cast(int, v))); }
__device__ __forceinline__ unsigned shxu(unsigned v, int mask, int lane) { return (unsigned)__builtin_amdgcn_ds_bpermute((lane ^ mask) << 2, (int)v); }
__device__ __forceinline__ int shi(int v, int src) { return __builtin_amdgcn_ds_bpermute(src << 2, v); }
__device__ __forceinline__ int mk_lane() { int l; asm volatile("v_mbcnt_lo_u32_b32 %0, -1, 0\n\tv_mbcnt_hi_u32_b32 %0, -1, %0" : "=v"(l)); return l; }
namespace pg8 {
#define PG8_LAS __attribute__((address_space(3)))
typedef unsigned short bf16_t;
typedef short bf16x8 __attribute__((ext_vector_type(8)));
typedef float f32x4 __attribute__((ext_vector_type(4)));
typedef unsigned u32x4 __attribute__((ext_vector_type(4)));
typedef int i32x4 __attribute__((ext_vector_type(4)));
typedef int i32x8 __attribute__((ext_vector_type(8)));
constexpr int F8_SCALE_H = 0x7c7c7c7c, F8_SCALE_W = 0x76767676;
constexpr int F8_SCALE_X = 0x7c7c7c7c, F8_SCALE_WGU = 0x77777777;
constexpr float I8_WQ = 127.0f * 32.0f / 3.9f, I8_IWQ = 1.0f / I8_WQ;
constexpr int BM = 256, BK = 64, HALF = 128, HTB = HALF * BK * 2  , STAGE_BYTES = 8 * HTB, NXCD = 8, WGM = 8;

__host__ __device__ __forceinline__ int lds_byte(int r, int c) { const int st = (r >> 4) * 2 + (c >> 5), rr = r & 15, cc = c & 31, ob = rr * 64 + cc * 2; return st * 1024 + (ob ^ (((ob >> 9) & 1) << 5)); }
__host__ __device__ __forceinline__ void stage_rc(int b, int& R, int& C) { const int st = b / 1024, sb = b % 1024, swz = sb ^ (((sb >> 9) & 1) << 5); R = (st >> 1) * 16 + swz / 64; C = (st & 1) * 32 + (swz % 64) / 2; }
__host__ __device__ __forceinline__ int perm32(int rho) { const int n = rho >> 4, i = rho & 15; return 8 * (i >> 2) + 4 * n + (i & 3); }

struct Unit { int pm, pn, idx; };
struct Gemm { const bf16_t* A; const bf16_t* Bt; int M, N, K; };

struct StaticOrder {
    int nM, nN, nwg, G, c;
    __host__ __device__ __forceinline__ void init(int M, int N, int G_, int c_) { nM = M / BM; nN = N / BM; nwg = nM * nN; G = G_; c = c_; }
    __host__ __device__ __forceinline__ bool next(int i, Unit& u) const {
        const long L = (long)i * G + c; if (L >= nwg) return false;
        int wgid = (int)L; { const int q = nwg / NXCD, r = nwg % NXCD, xcd = wgid % NXCD, off = wgid / NXCD; wgid = (xcd < r ? xcd * (q + 1) : r * (q + 1) + (xcd - r) * q) + off; }
        const int nig = WGM * nN, gid = wgid / nig, fm = gid * WGM, gsz = (nM - fm) < WGM ? (nM - fm) : WGM;
        u.pm = fm + ((wgid % nig) % gsz); u.pn = (wgid % nig) / gsz; u.idx = i; return true;
    }
    __device__ __forceinline__ void a_ready(const Unit&) const {}
    __device__ __forceinline__ void done(const Unit&) const {}
};

__device__ __forceinline__ unsigned cvt_pk_bf16(float lo, float hi) { unsigned r; asm volatile("v_cvt_pk_bf16_f32 %0, %1, %2" : "=v"(r) : "v"(lo), "v"(hi)); return r; }
typedef float f32x2 __attribute__((ext_vector_type(2)));
template <class Epi, class Sched, bool ALIGN_EPI = false, bool SP2 = false, bool FP8 = false, int SW = F8_SCALE_W, int SH = F8_SCALE_H, bool I8 = false>
__device__ __forceinline__ void gemm_phase(PG8_LAS unsigned char* lds, const Gemm g, const Sched& S, const Epi& E, const int wave0) {
    int tid_ = wave0 * 64 + mk_lane(); asm volatile("" : "+v"(tid_));
    const int tid = tid_, wid = __builtin_amdgcn_readfirstlane(tid >> 6), lane = tid & 63, wr = wid >> 2, wc = wid & 3, fr = lane & 15, fq = lane >> 4;
    const int K = g.K, nt = K / BK;
    unsigned voffA[2], voffB[2];
#pragma unroll
    for (int i = 0; i < 2; ++i) { int R, C; stage_rc(tid * 16 + i * 8192, R, C); const int Rb = Epi::PERM ? ((R & ~31) + perm32(R & 31)) : R;
        voffA[i] = (unsigned)(R * K + C) * 2u; voffB[i] = (unsigned)(Rb * K + C) * 2u; }
    const size_t kstep = (size_t)(BK * 2);
    const size_t hstep = (size_t)HALF * K * 2;
    const size_t tstep = 2 * hstep;
    const unsigned ldsw = (unsigned)wid * 1024u;
    const int aoff = lds_byte(wr * 64 + fr, fq * 8), boff = lds_byte(wc * 32 + fr, fq * 8);
#define PG8_SA(b, h) (((b) * 2 + (h)) * HTB)
#define PG8_SB(b, h) ((4 + (b) * 2 + (h)) * HTB)
#define PG8_STAGE(bufoff, gbase, voff) do { _Pragma("unroll") for (int _i = 0; _i < 2; ++_i) \
        __builtin_amdgcn_global_load_lds((const unsigned*)((const char*)(gbase) + (voff)[_i]), (PG8_LAS unsigned*)(lds + (bufoff) + ldsw + _i * 8192), 16, 0, 0); } while (0)
#define PG8_LDA(dst, b, h) do { _Pragma("unroll") for (int m = 0; m < 4; ++m) { if constexpr (FP8) { dst##8[m].lo = *(const PG8_LAS i32x4*)(lds + PG8_SA(b, h) + aoff + m * 2048); dst##8[m].hi = *(const PG8_LAS i32x4*)(lds + PG8_SA(b, h) + aoff + m * 2048 + 1024); } \
        else { _Pragma("unroll") for (int k = 0; k < 2; ++k) dst[m][k] = *(const PG8_LAS bf16x8*)(lds + PG8_SA(b, h) + aoff + m * 2048 + k * 1024); } } } while (0)
#define PG8_LDB(dst, b, h) do { _Pragma("unroll") for (int n = 0; n < 2; ++n) { if constexpr (FP8) { dst##8[n].lo = *(const PG8_LAS i32x4*)(lds + PG8_SB(b, h) + boff + n * 2048); dst##8[n].hi = *(const PG8_LAS i32x4*)(lds + PG8_SB(b, h) + boff + n * 2048 + 1024); } \
        else { _Pragma("unroll") for (int k = 0; k < 2; ++k) dst[n][k] = *(const PG8_LAS bf16x8*)(lds + PG8_SB(b, h) + boff + n * 2048 + k * 1024); } } } while (0)
#define PG8_MMA(ai, bj, At, Bt) do { __builtin_amdgcn_s_setprio(1); _Pragma("unroll") for (int m = 0; m < 4; ++m) _Pragma("unroll") for (int n = 0; n < 2; ++n) { \
        if constexpr (FP8) asm volatile("v_mfma_scale_f32_16x16x128_f8f6f4 %0, %1, %2, %0, %3, %4 op_sel_hi:[0,0,0]" : "+v"(acc[ai][bj][m][n]) : "v"(Bt##8[n]), "v"(At##8[m]), "v"(f8sw), "v"(f8sh)); \
        else if constexpr (I8) { _Pragma("unroll") for (int k = 0; k < 2; ++k) acc[ai][bj][m][n] = __builtin_bit_cast(f32x4, __builtin_amdgcn_mfma_i32_16x16x64_i8(__builtin_bit_cast(i32x4, Bt[n][k]), __builtin_bit_cast(i32x4, At[m][k]), __builtin_bit_cast(i32x4, acc[ai][bj][m][n]), 0, 0, 0)); } \
        else { _Pragma("unroll") for (int k = 0; k < 2; ++k) acc[ai][bj][m][n] = __builtin_amdgcn_mfma_f32_16x16x32_bf16(Bt[n][k], At[m][k], acc[ai][bj][m][n], 0, 0, 0); } } \
        __builtin_amdgcn_s_setprio(0); } while (0)
#define PG8_WAIT_V(n) asm volatile("s_waitcnt vmcnt(" #n ")" ::: "memory")
#define PG8_WAIT_L(n) asm volatile("s_waitcnt lgkmcnt(" #n ")" ::: "memory")
#define PG8_BAR __builtin_amdgcn_s_barrier()
#define PG8_SCHED __builtin_amdgcn_sched_barrier(0)
    Unit cur, nxt; int ui = 0;
    if (!S.next(0, cur)) return;
    f32x4 acc[2][2][4][2];
    typename Epi::Pre pre;
    if constexpr (Epi::PRELOAD) E.pre_issue(pre, cur, wr, wc, fr, fq);
    else {
#pragma unroll
    for (int a = 0; a < 2; ++a)
#pragma unroll
        for (int b = 0; b < 2; ++b)
#pragma unroll
            for (int m = 0; m < 4; ++m)
#pragma unroll
                for (int n = 0; n < 2; ++n) acc[a][b][m][n] = (f32x4){0.f, 0.f, 0.f, 0.f};
    }
    bf16x8 At[4][2], B0[2][2], B1[2][2]; i32x8 At8[4], B08[2], B18[2];
    int f8sw = SW, f8sh = SH; if constexpr (FP8) asm volatile("" : "+v"(f8sw), "+v"(f8sh));
    const char* cA = (const char*)g.A + (size_t)cur.pm * tstep; const char* cB = (const char*)g.Bt + (size_t)cur.pn * tstep;
    S.a_ready(cur);
    if constexpr (SP2) {
        PG8_STAGE(PG8_SB(0, 0), cB, voffB); PG8_STAGE(PG8_SB(0, 1), cB + hstep, voffB); PG8_STAGE(PG8_SA(0, 0), cA, voffA); PG8_STAGE(PG8_SA(0, 1), cA + hstep, voffA);
        if constexpr (Epi::PRELOAD) E.pre_finish(acc, pre);
        if (wr == 1) PG8_BAR;
        PG8_WAIT_V(2); PG8_BAR;
        PG8_STAGE(PG8_SB(1, 0), cB + kstep, voffB); PG8_STAGE(PG8_SA(1, 0), cA + kstep, voffA); PG8_STAGE(PG8_SB(1, 1), cB + hstep + kstep, voffB);
        PG8_WAIT_V(6); PG8_BAR;
    } else {
        PG8_STAGE(PG8_SB(0, 0), cB, voffB); PG8_STAGE(PG8_SA(0, 0), cA, voffA); PG8_STAGE(PG8_SB(0, 1), cB + hstep, voffB); PG8_STAGE(PG8_SA(0, 1), cA + hstep, voffA);
        if constexpr (Epi::PRELOAD) E.pre_finish(acc, pre);
        if (wr == 1) PG8_BAR;
        PG8_WAIT_V(4); PG8_BAR;
        PG8_STAGE(PG8_SB(1, 0), cB + kstep, voffB); PG8_STAGE(PG8_SA(1, 0), cA + kstep, voffA); PG8_STAGE(PG8_SB(1, 1), cB + hstep + kstep, voffB);
        PG8_WAIT_V(6); PG8_BAR;
    }
    for (;;) {
        const bool has_next = S.next(ui + 1, nxt);
        const char* nA = has_next ? (const char*)g.A + (size_t)nxt.pm * tstep : cA; const char* nB = has_next ? (const char*)g.Bt + (size_t)nxt.pn * tstep : cB;
        for (int t = 0; t < nt; t += 2) {
            const bool last = (t == nt - 2);
            const char* a1 = cA + (size_t)(t + 1) * kstep;
            const char* a2 = last ? nA : cA + (size_t)(t + 2) * kstep; const char* b2 = last ? nB : cB + (size_t)(t + 2) * kstep;
            const char* a3 = a2 + kstep; const char* b3 = b2 + kstep;
            if (last && has_next) S.a_ready(nxt);
            if constexpr (SP2) {
            PG8_LDB(B0, 0, 0); PG8_LDB(B1, 0, 1); PG8_SCHED; PG8_LDA(At, 0, 0); PG8_STAGE(PG8_SA(1, 1), a1 + hstep, voffA);
            PG8_WAIT_V(8); PG8_WAIT_L(0); PG8_BAR; PG8_MMA(0, 0, At, B0); PG8_MMA(0, 1, At, B1); PG8_BAR; PG8_SCHED;
            PG8_LDA(At, 0, 1); PG8_STAGE(PG8_SB(0, 0), b2, voffB); PG8_STAGE(PG8_SB(0, 1), b2 + hstep, voffB); PG8_STAGE(PG8_SA(0, 0), a2, voffA);
            PG8_WAIT_V(8); PG8_WAIT_L(0); PG8_BAR; PG8_MMA(1, 0, At, B0); PG8_MMA(1, 1, At, B1); PG8_BAR; PG8_SCHED;
            PG8_LDB(B0, 1, 0); PG8_LDB(B1, 1, 1); PG8_SCHED; PG8_LDA(At, 1, 0); PG8_STAGE(PG8_SA(0, 1), a2 + hstep, voffA);
            PG8_WAIT_V(8); PG8_WAIT_L(0); PG8_BAR; PG8_MMA(0, 0, At, B0); PG8_MMA(0, 1, At, B1); PG8_BAR; PG8_SCHED;
            PG8_LDA(At, 1, 1); PG8_STAGE(PG8_SB(1, 0), b3, voffB); PG8_STAGE(PG8_SB(1, 1), b3 + hstep, voffB); PG8_STAGE(PG8_SA(1, 0), a3, voffA);
            PG8_WAIT_V(8); PG8_WAIT_L(0); PG8_BAR; PG8_MMA(1, 0, At, B0); PG8_MMA(1, 1, At, B1); PG8_BAR; PG8_SCHED;
            } else {
            PG8_LDB(B0, 0, 0); PG8_SCHED; PG8_LDA(At, 0, 0); PG8_STAGE(PG8_SA(1, 1), a1 + hstep, voffA);
            PG8_WAIT_L(8); PG8_BAR; PG8_WAIT_L(0); PG8_MMA(0, 0, At, B0); PG8_BAR; PG8_SCHED;
            PG8_LDB(B1, 0, 1); PG8_STAGE(PG8_SB(0, 0), b2, voffB);
            PG8_BAR; PG8_WAIT_L(0); PG8_MMA(0, 1, At, B1); PG8_BAR;
            PG8_LDA(At, 0, 1); PG8_STAGE(PG8_SA(0, 0), a2, voffA);
            PG8_BAR; PG8_WAIT_L(0); PG8_MMA(1, 0, At, B0); PG8_BAR; PG8_SCHED;
            PG8_STAGE(PG8_SB(0, 1), b2 + hstep, voffB);
            PG8_WAIT_V(6); PG8_BAR; PG8_MMA(1, 1, At, B1); PG8_BAR;
            PG8_LDB(B0, 1, 0); PG8_SCHED; PG8_LDA(At, 1, 0); PG8_STAGE(PG8_SA(0, 1), a2 + hstep, voffA);
            PG8_WAIT_L(8); PG8_BAR; PG8_WAIT_L(0); PG8_MMA(0, 0, At, B0); PG8_BAR; PG8_SCHED;
            PG8_LDB(B1, 1, 1); PG8_STAGE(PG8_SB(1, 0), b3, voffB);
            PG8_BAR; PG8_WAIT_L(0); PG8_MMA(0, 1, At, B1); PG8_BAR;
            PG8_LDA(At, 1, 1); PG8_STAGE(PG8_SA(1, 0), a3, voffA);
            PG8_BAR; PG8_WAIT_L(0); PG8_MMA(1, 0, At, B0); PG8_BAR; PG8_SCHED;
            PG8_STAGE(PG8_SB(1, 1), b3 + hstep, voffB);
            PG8_WAIT_V(6); PG8_BAR; PG8_MMA(1, 1, At, B1); PG8_BAR;
            }
        }
        if constexpr (FP8) asm volatile("s_nop 15\n\ts_nop 15" ::: "memory");
        if constexpr (ALIGN_EPI) { if (wr == 0) PG8_BAR; }
        if constexpr (!Epi::AFTER_DRAIN) { E(acc, cur, wr, wc, fr, fq); S.done(cur); }
        if (!has_next) break;
        if constexpr (Epi::PRELOAD) { typename Epi::Pre pre2; E.pre_issue(pre2, nxt, wr, wc, fr, fq); E.pre_finish(acc, pre2); }
        else {
#pragma unroll
        for (int a = 0; a < 2; ++a)
#pragma unroll
            for (int b = 0; b < 2; ++b)
#pragma unroll
                for (int m = 0; m < 4; ++m)
#pragma unroll
                    for (int n = 0; n < 2; ++n) acc[a][b][m][n] = (f32x4){0.f, 0.f, 0.f, 0.f};
        }
        cur = nxt; cA = nA; cB = nB; ++ui;
        if constexpr (ALIGN_EPI) { if (wr == 1) PG8_BAR; }
    }
    PG8_WAIT_V(0);
    if constexpr (!ALIGN_EPI) { if (wr == 0) PG8_BAR; }
    PG8_BAR;
    if constexpr (Epi::AFTER_DRAIN) { E.fused(acc, cur, wr, wc, fr, fq, lds, wid, lane); S.done(cur); }
#undef PG8_SA
#undef PG8_SB
#undef PG8_STAGE
#undef PG8_LDA
#undef PG8_LDB
#undef PG8_MMA
#undef PG8_WAIT_V
#undef PG8_WAIT_L
#undef PG8_BAR
#undef PG8_SCHED
}
}

#ifndef PROBE
#define PROBE 0
#endif
#ifndef I8_MASK
#define I8_MASK 0xFF
#endif
#ifndef X8_MASK
#define X8_MASK 0x00
#endif
#ifndef FP8_MASK
#define FP8_MASK 0xF8
#endif
#ifndef PG8_SP2
#define PG8_SP2 true
#endif
#ifndef PG8_ALIGN
#define PG8_ALIGN true
#endif

#define GAS __attribute__((address_space(1)))
#define LAS __attribute__((address_space(3)))
typedef unsigned short bf16;
typedef pg8::f32x4 f32x4;
typedef pg8::f32x2 f32x2;
typedef pg8::u32x4 u32x4;
typedef pg8::bf16x8 bf16x8;
typedef unsigned u32x2 __attribute__((ext_vector_type(2)));
typedef GAS unsigned gu32;
#define RLX_AGENT __ATOMIC_RELAXED, __HIP_MEMORY_SCOPE_AGENT
#define LDS_WAIT() asm volatile("s_waitcnt lgkmcnt(0)" ::: "memory")
#define VM_WAIT() asm volatile("s_waitcnt vmcnt(0)" ::: "memory")
using pg8::cvt_pk_bf16;

constexpr int S_ = 16384, D_ = 1024, FF_ = 2816, NGU = 2 * FF_, NH = 16, HD = 64, NBLK = 64, BS = 256;
constexpr int NWAVES = 8;
constexpr float EPS = 1e-6f, LOG2E = 1.4426950408889634f;

constexpr size_t MiB = 1u << 20;
constexpr size_t WS_CTL = 0, CTL_ZERO_BYTES = 64 * 1024;
constexpr size_t WS_SSQ = 1 * MiB;
constexpr size_t WS_KPART = 2 * MiB;
constexpr size_t WS_SEL = 3 * MiB;
constexpr size_t WS_LSE = 4 * MiB;
constexpr size_t WS_QN2 = 348 * MiB;
constexpr size_t WS_WP = 7 * MiB;
constexpr size_t WS_WATT = 8 * MiB, WATT_STRIDE = 8 * MiB, WATT_WO = 6 * MiB;
constexpr size_t WS_WFFN = 24 * MiB, WFFN_STRIDE = 17301504, WFFN_WD = 11 * MiB;
constexpr size_t WS_XB = 156 * MiB;
constexpr size_t WS_BIG = 252 * MiB;
constexpr size_t WS_HALO = 349 * MiB;
constexpr size_t WS_SSQB = 351 * MiB;
constexpr size_t WS_XS = 352 * MiB;
constexpr size_t WS_END = 352 * MiB + 65536;
static_assert(WS_WFFN + 8 * WFFN_STRIDE == WS_XB, "ws map");
constexpr size_t WS_X8 = WS_WFFN + 4 * WFFN_STRIDE;
static_assert((X8_MASK & 0x1f) == 0 && (X8_MASK & I8_MASK) == 0, "x8 copy region");
constexpr size_t WS_XQ = WS_XB + 32 * MiB;
constexpr int CW_RB = 12288;
constexpr int CW_BAR = 4096, CW_QA = 8192, CW_LC = 10240;
static_assert((CW_RB + 64 * 16) * 4 <= (int)CTL_ZERO_BYTES && CW_LC + 2 * 1024 <= CW_RB && (CW_LC + 2 * 1024) * 4 <= (int)CTL_ZERO_BYTES && CW_QA + 64 * 16 <= CW_LC, "list counters inside the memset region");
constexpr int LIST_HEAD = 256 * 2016;
__host__ __device__ __forceinline__ int list_off(int n) { return 256 * (63 * n - ((n * (n - 1)) >> 1)); }
static_assert((CW_QA + 64 * 16) * 4 <= (int)CTL_ZERO_BYTES && (CW_BAR + 3456) <= CW_QA, "control words inside the memset region");

constexpr int RING_BYTES = 131072, LDSCTL_OFF = RING_BYTES, MISC_OFF = LDSCTL_OFF + 320, RSTD_OFF = MISC_OFF + 128, LDS_BYTES = 147456;
static_assert(RSTD_OFF + 6 * 1024 <= LDS_BYTES, "LDS map");
constexpr int A_KS = 0, A_VT = 32768, A_LIST = 65536, A_CNT = A_LIST + 32768, A_OST = A_CNT + 256, A_OPITCH = 144;
constexpr int A_WROW = A_OST + 8 * 16 * A_OPITCH;
static_assert(A_WROW + 512 <= RING_BYTES, "attention LDS");

#define XB_TMO      128
#define XB_XCNT(j)  (256  + 64 * (j))
#define XB_XSUB(j)  (1280 + 64 * (j))
#define XB_XGEN(j)  (2304 + 64 * (j))
#define XB_TOP      3328
#define XB_TOPGEN   3392
#define XCD_BAR_WORDS 3456
#define XB_SPIN_CAP (1u << 18)

__device__ __forceinline__ unsigned xb_ld(unsigned* p)              { return __hip_atomic_load(p, __ATOMIC_RELAXED, __HIP_MEMORY_SCOPE_AGENT); }
__device__ __forceinline__ unsigned xb_add(unsigned* p, unsigned v) { return __hip_atomic_fetch_add(p, v, __ATOMIC_RELAXED, __HIP_MEMORY_SCOPE_AGENT); }
__device__ __forceinline__ unsigned xb_xcc_id() { return (unsigned)__builtin_amdgcn_s_getreg((3 << 11) | 20) & 0xFu; }
#define XB_SPIN(cond, bar) do { unsigned _sp = 0; while (cond) { __builtin_amdgcn_s_sleep(1); \
    if ((++_sp & 255u) == 0u) { if (xb_ld(&(bar)[XB_TMO])) break; if (_sp > XB_SPIN_CAP) { atomicAdd(&(bar)[XB_TMO], 1u); break; } } } } while (0)

struct XcdBarrier {
    unsigned* bar; unsigned x;
    volatile LAS unsigned* st;
};

__device__ __forceinline__ XcdBarrier xcd_barrier_post(unsigned* bar, volatile LAS unsigned* st, const bool thread0) {
    XcdBarrier b; b.bar = bar; b.x = xb_xcc_id(); b.st = st;
    if (thread0) (void)xb_add(&bar[XB_XCNT(b.x)], 1u);
    return b;
}
__device__ __forceinline__ void xcd_barrier_complete(unsigned* bar, unsigned x, unsigned& nloc, unsigned& nx) {
    const unsigned G = gridDim.x * gridDim.y * gridDim.z;
    unsigned sum, cnt, mine, sp = 0u;
    for (;;) {
        sum = 0u; cnt = 0u; mine = 0u;
#pragma unroll
        for (unsigned j = 0; j < 16; ++j) { const unsigned c = xb_ld(&bar[XB_XCNT(j)]); sum += c; cnt += (c > 0u) ? 1u : 0u; mine = (j == x) ? c : mine; }
        if (sum == G) break;
        __builtin_amdgcn_s_sleep(1);
        if ((++sp & 255u) == 0u) { if (xb_ld(&bar[XB_TMO])) break; if (sp > XB_SPIN_CAP) { atomicAdd(&bar[XB_TMO], 1u); break; } }
    }
    nloc = mine > 0u ? mine : 1u; nx = cnt > 0u ? cnt : 1u;
}

__device__ __forceinline__ void xcd_barrier(const XcdBarrier& b, const bool thread0) {
    asm volatile("s_waitcnt vmcnt(0)" ::: "memory");
    __syncthreads();
    if (thread0) {
        unsigned* bar = b.bar;
        __builtin_amdgcn_s_waitcnt(0);
        unsigned nloc = b.st[0], nx = b.st[1];
        if (nloc == 0u) { xcd_barrier_complete(bar, b.x, nloc, nx); b.st[0] = nloc; b.st[1] = nx; }
        const unsigned old = xb_add(&bar[XB_XSUB(b.x)], 1u);
        const unsigned gen = old / nloc;
        if (old + 1u == (gen + 1u) * nloc) {
            __builtin_amdgcn_fence(__ATOMIC_RELEASE, "agent");
            asm volatile("s_waitcnt vmcnt(0)" ::: "memory");
            const unsigned og = xb_add(&bar[XB_TOP], 1u);
            const unsigned tg = og / nx;
            if (og + 1u == (tg + 1u) * nx) xb_add(&bar[XB_TOPGEN], 1u);
            else XB_SPIN(xb_ld(&bar[XB_TOPGEN]) == tg, bar);
            __builtin_amdgcn_fence(__ATOMIC_ACQUIRE, "agent");
            asm volatile("s_waitcnt vmcnt(0)" ::: "memory");
        } else {
            XB_SPIN(xb_ld(&bar[XB_TOPGEN]) == gen, bar);
            __builtin_amdgcn_fence(__ATOMIC_ACQUIRE, "agent");
            asm volatile("s_waitcnt vmcnt(0)" ::: "memory");
        }
    }
    __syncthreads();
}
__device__ __forceinline__ float row_rstd(const float* ssq, int row) {
    const f32x4* p = (const f32x4*)(ssq + (size_t)row * 16);
    const f32x4 a = p[0], b = p[1], c = p[2], d = p[3];
    const float s = (((a.x + a.y) + (a.z + a.w)) + ((b.x + b.y) + (b.z + b.w))) + (((c.x + c.y) + (c.z + c.w)) + ((d.x + d.y) + (d.z + d.w)));
    return __builtin_amdgcn_rsqf(s * (1.0f / 1024.0f) + EPS);
}
template <class Sched, bool XS = false> __device__ __forceinline__ void rstd_table(LAS unsigned char* lds, const float* ssq, const Sched& S, const int wave0) {
    int tid = wave0 * 64 + mk_lane(); asm volatile("" : "+v"(tid));
    LAS float* T = (LAS float*)(lds + RSTD_OFF);
#pragma unroll
    for (int i2 = 0; i2 < 3; ++i2) { pg8::Unit u; const int i = 2 * i2 + (tid >> 8); if (S.next(i, u)) T[i * 256 + (tid & 255)] = XS ? ssq[u.pm * 256 + (tid & 255)] : row_rstd(ssq, u.pm * 256 + (tid & 255)); }
    __syncthreads();
}
__device__ __forceinline__ float bf_lo(unsigned w) { return __uint_as_float(w << 16); }
__device__ __forceinline__ float bf_hi(unsigned w) { return __uint_as_float(w & 0xffff0000u); }

struct EpiNull {
    static constexpr bool PERM = false, AFTER_DRAIN = false;
    float* dummy;
    __device__ __forceinline__ void operator()(const f32x4 (&acc)[2][2][4][2], const pg8::Unit& u, int wr, int wc, int fr, int fq) const {
        f32x4 s = {0.f, 0.f, 0.f, 0.f};
#pragma unroll
        for (int ai = 0; ai < 2; ++ai)
#pragma unroll
            for (int bj = 0; bj < 2; ++bj)
#pragma unroll
                for (int m = 0; m < 4; ++m)
#pragma unroll
                    for (int n = 0; n < 2; ++n) s += acc[ai][bj][m][n];
        dummy[(size_t)blockIdx.x * 512 + (wr * 4 + wc) * 64 + fq * 16 + fr] = (s.x + s.y) + (s.z + s.w);
    }
};
struct NoPre {};
template <bool F8, bool I8 = false> struct EpiSwiGLUT {
    static constexpr bool PERM = true, AFTER_DRAIN = false, PRELOAD = false; typedef NoPre Pre;
    bf16* H; LAS const float* rt; int nullmode;
    __device__ __forceinline__ void operator()(const f32x4 (&acc)[2][2][4][2], const pg8::Unit& u, int wr, int wc, int fr, int fq) const {
#if PROBE == 13
        if (nullmode) { EpiNull en{(float*)H}; en(acc, u, wr, wc, fr, fq); return; }
#endif
        const int row0 = u.pm * 256 + wr * 64 + fr, col0 = u.pn * 128 + wc * 32 + 8 * fq;
#pragma unroll
        for (int ai = 0; ai < 2; ++ai)
#pragma unroll
            for (int m = 0; m < 4; ++m) {
                const int row = row0 + ai * 128 + m * 16;
                const float rs = rt[u.idx * 256 + (row & 255)], rsl = rs * (-LOG2E), irs2 = __builtin_amdgcn_rcpf(rs * rs * (F8 ? 8.0f : 1.0f));
                float hv[8];
#pragma unroll
                for (int n = 0; n < 2; ++n)
#pragma unroll
                    for (int e = 0; e < 4; ++e) {
                        const float ga = I8 ? (float)__float_as_int(acc[ai][0][m][n][e]) : acc[ai][0][m][n][e], ua = I8 ? (float)__float_as_int(acc[ai][1][m][n][e]) : acc[ai][1][m][n][e];
                        const float ex = __builtin_amdgcn_exp2f(ga * rsl);
                        hv[n * 4 + e] = (ga * ua) * __builtin_amdgcn_rcpf(__builtin_fmaf(ex, irs2, irs2));
                    }
                if constexpr (F8) {
                    int w0 = 0, w1 = 0;
                    w0 = __builtin_amdgcn_cvt_pk_fp8_f32(hv[0], hv[1], w0, false); w0 = __builtin_amdgcn_cvt_pk_fp8_f32(hv[2], hv[3], w0, true);
                    w1 = __builtin_amdgcn_cvt_pk_fp8_f32(hv[4], hv[5], w1, false); w1 = __builtin_amdgcn_cvt_pk_fp8_f32(hv[6], hv[7], w1, true);
                    u32x2 w8; w8.x = (unsigned)w0; w8.y = (unsigned)w1;
                    *(u32x2*)((unsigned char*)H + (size_t)row * FF_ + col0) = w8;
                } else {
                u32x4 w; w.x = cvt_pk_bf16(hv[0], hv[1]); w.y = cvt_pk_bf16(hv[2], hv[3]); w.z = cvt_pk_bf16(hv[4], hv[5]); w.w = cvt_pk_bf16(hv[6], hv[7]);
                *(u32x4*)(H + (size_t)row * FF_ + col0) = w;
                }
            }
    }
};
typedef EpiSwiGLUT<false> EpiSwiGLU;
typedef EpiSwiGLUT<true, true> EpiSwiGLU_F8I8;
typedef EpiSwiGLUT<false, true> EpiSwiGLU_I8;

template <bool POOL, int ALPHA2, bool X8OUT = !POOL> struct EpiResid {
    static constexpr bool PERM = true, AFTER_DRAIN = false;
    static constexpr bool PRELOAD = !POOL;
    struct PreTile { u32x4 r[16]; };
    typedef typename std::conditional<POOL, NoPre, PreTile>::type Pre;
    static constexpr float alpha = 0.5f * (float)ALPHA2;
    bf16* xb; float* ssq; const float* cscale; bf16* halo; unsigned char* x8;
    __device__ __forceinline__ void pre_issue(PreTile& pre, const pg8::Unit& u, int wr, int wc, int fr, int fq) const {
        const int row0 = u.pm * 256 + wr * 64 + fr, col0 = u.pn * 256 + wc * 32 + 8 * fq;
#pragma unroll
        for (int ai = 0; ai < 2; ++ai)
#pragma unroll
            for (int m = 0; m < 4; ++m)
#pragma unroll
                for (int bj = 0; bj < 2; ++bj) pre.r[(ai * 4 + m) * 2 + bj] = *(const u32x4*)(xb + (size_t)(row0 + ai * 128 + m * 16) * D_ + col0 + bj * 128);
    }
    __device__ __forceinline__ void pre_finish(f32x4 (&acc)[2][2][4][2], const PreTile& pre) const {
        const float ia = 1.0f / alpha;
#pragma unroll
        for (int ai = 0; ai < 2; ++ai)
#pragma unroll
            for (int m = 0; m < 4; ++m)
#pragma unroll
                for (int bj = 0; bj < 2; ++bj) { const u32x4 b = pre.r[(ai * 4 + m) * 2 + bj];
                    acc[ai][bj][m][0] = (f32x4){bf_lo(b.x), bf_hi(b.x), bf_lo(b.y), bf_hi(b.y)} * ia; acc[ai][bj][m][1] = (f32x4){bf_lo(b.z), bf_hi(b.z), bf_lo(b.w), bf_hi(b.w)} * ia; }
    }
    __device__ __forceinline__ void operator()(const f32x4 (&acc)[2][2][4][2], const pg8::Unit& u, int wr, int wc, int fr, int fq) const {
        if (POOL) { const int l2 = mk_lane(); fr = l2 & 15; fq = l2 >> 4; }
        const int pmr = POOL ? (u.pm & 63) : u.pm;
        const int row0 = pmr * 256 + wr * 64 + fr, col0 = u.pn * 256 + wc * 32 + 8 * fq;
        f32x4 cs[2][2];
#pragma unroll
        for (int bj = 0; bj < 2; ++bj)
#pragma unroll
            for (int n = 0; n < 2; ++n) { if (POOL) cs[bj][n] = *(const f32x4*)(cscale + col0 + bj * 128 + 4 * n) * alpha; }
#pragma unroll
        for (int ai = 0; ai < 2; ++ai) {
            u32x4 bx[4][2];
            constexpr int MB = POOL ? 2 : 4;
#pragma unroll
            for (int m = 0; m < 4; ++m) {
                if (POOL && (m % MB) == 0) {
#pragma unroll
                    for (int m2 = m; m2 < m + MB; ++m2)
#pragma unroll
                        for (int bj = 0; bj < 2; ++bj) bx[m2][bj] = *(const u32x4*)(xb + (size_t)(row0 + ai * 128 + m2 * 16) * D_ + col0 + bj * 128);
                }
                const int row = row0 + ai * 128 + m * 16; float s = 0.f;
#pragma unroll
                for (int bj = 0; bj < 2; ++bj) {
                    f32x4 v0, v1;
                    if (POOL) { v0 = acc[ai][bj][m][0] * cs[bj][0]; v1 = acc[ai][bj][m][1] * cs[bj][1]; } else { v0 = acc[ai][bj][m][0] * alpha; v1 = acc[ai][bj][m][1] * alpha; }
                    if (POOL) { const u32x4 b = bx[m][bj]; v0 += (f32x4){bf_lo(b.x), bf_hi(b.x), bf_lo(b.y), bf_hi(b.y)}; v1 += (f32x4){bf_lo(b.z), bf_hi(b.z), bf_lo(b.w), bf_hi(b.w)}; }
                    s += ((v0.x * v0.x + v0.y * v0.y) + (v0.z * v0.z + v0.w * v0.w)) + ((v1.x * v1.x + v1.y * v1.y) + (v1.z * v1.z + v1.w * v1.w));
                    u32x4 w; w.x = cvt_pk_bf16(v0.x, v0.y); w.y = cvt_pk_bf16(v0.z, v0.w); w.z = cvt_pk_bf16(v1.x, v1.y); w.w = cvt_pk_bf16(v1.z, v1.w);
                    *(u32x4*)(xb + (size_t)row * D_ + col0 + bj * 128) = w;
                    if (X8OUT && x8) { int p0 = 0, p1 = 0;
                        p0 = __builtin_amdgcn_cvt_pk_fp8_f32(v0.x * 8.0f, v0.y * 8.0f, p0, false); p0 = __builtin_amdgcn_cvt_pk_fp8_f32(v0.z * 8.0f, v0.w * 8.0f, p0, true);
                        p1 = __builtin_amdgcn_cvt_pk_fp8_f32(v1.x * 8.0f, v1.y * 8.0f, p1, false); p1 = __builtin_amdgcn_cvt_pk_fp8_f32(v1.z * 8.0f, v1.w * 8.0f, p1, true);
                        u32x2 w8; w8.x = (unsigned)p0; w8.y = (unsigned)p1; *(u32x2*)(x8 + (size_t)row * D_ + col0 + bj * 128) = w8; }
                    if (!POOL && ai == 1 && m == 3) { if (halo && wr == 1) *(u32x4*)(halo + ((size_t)u.pm * 16 + fr) * D_ + col0 + bj * 128) = w; }
                }
                s += shx(s, 16, fq * 16 + fr); s += shx(s, 32, fq * 16 + fr);
                if (fq == 0) ssq[(size_t)row * 16 + u.pn * 4 + wc] = s;
            }
        }
    }
};

struct EpiQKV {
    static constexpr bool PERM = true, AFTER_DRAIN = false, PRELOAD = false; typedef NoPre Pre;
    bf16* QKV; LAS const float* rt; float* kpart;
    __device__ __forceinline__ void operator()(const f32x4 (&acc)[2][2][4][2], const pg8::Unit& u, int wr, int wc, int fr, int fq) const {
        const int t = u.pn >> 2, colt = (u.pn & 3) * 256;
        bf16* dst = QKV + (size_t)t * S_ * D_;
        const int row0 = u.pm * 256 + wr * 64 + fr, col0 = colt + wc * 32 + 8 * fq;
        f32x4 csum[2][2];
#pragma unroll
        for (int bj = 0; bj < 2; ++bj)
#pragma unroll
            for (int n = 0; n < 2; ++n) csum[bj][n] = (f32x4){0.f, 0.f, 0.f, 0.f};
#pragma unroll
        for (int ai = 0; ai < 2; ++ai)
#pragma unroll
            for (int m = 0; m < 4; ++m) {
                const int row = row0 + ai * 128 + m * 16;
                const float rs = rt[u.idx * 256 + (row & 255)];
#pragma unroll
                for (int bj = 0; bj < 2; ++bj) {
                    const f32x4 v0 = acc[ai][bj][m][0] * rs, v1 = acc[ai][bj][m][1] * rs;
                    u32x4 w; w.x = cvt_pk_bf16(v0.x, v0.y); w.y = cvt_pk_bf16(v0.z, v0.w); w.z = cvt_pk_bf16(v1.x, v1.y); w.w = cvt_pk_bf16(v1.z, v1.w);
                    *(u32x4*)(dst + (size_t)row * D_ + col0 + bj * 128) = w;
                    csum[bj][0] += v0; csum[bj][1] += v1;
                }
            }
        if (t == 1) {
#pragma unroll
            for (int bj = 0; bj < 2; ++bj)
#pragma unroll
                for (int n = 0; n < 2; ++n) {
                    f32x4 c = csum[bj][n];
#pragma unroll
                    for (int e = 0; e < 4; ++e) { float x = c[e]; x += shx(x, 1, fq * 16 + fr); x += shx(x, 2, fq * 16 + fr); x += shx(x, 4, fq * 16 + fr); x += shx(x, 8, fq * 16 + fr); c[e] = x; }
                    if (fr == 0) *(f32x4*)(kpart + ((size_t)wr * NBLK + u.pm) * D_ + col0 + bj * 128 + 4 * n) = c;
                }
        }
    }
};


struct PoolOrder {
    int G, c;
    __device__ __forceinline__ bool next(int i, pg8::Unit& u) const { const int L = i * G + c; if (L >= 256) return false; u.pm = L; u.pn = L >> 6; u.idx = i; return true; }
    __device__ __forceinline__ void a_ready(const pg8::Unit&) const {}
    __device__ __forceinline__ void done(const pg8::Unit&) const {}
};
__device__ __forceinline__ float wave_sum(float v, int lane) {
#pragma unroll
    for (int o = 1; o < 64; o <<= 1) v += shx(v, o, lane);
    return v;
}
__device__ __forceinline__ void tr_item(const float* src, int N, int k0, int n0, bf16* dst, int dpitch, int drow0, const float* gain, float cs, LAS float* scr, int lane, int f8 = 0) {
    f32x4 v[8];
#pragma unroll
    for (int i = 0; i < 8; ++i) v[i] = __builtin_nontemporal_load((const f32x4*)(src + (size_t)(k0 + 8 * i + (lane >> 3)) * N + n0 + 4 * (lane & 7)));
#pragma unroll
    for (int i = 0; i < 8; ++i) {
        const int kk = 8 * i + (lane >> 3);
        const float g = gain ? gain[k0 + kk] * cs : cs;
        LAS float* d = scr + kk * 33 + 4 * (lane & 7);
        d[0] = v[i].x * g; d[1] = v[i].y * g; d[2] = v[i].z * g; d[3] = v[i].w * g;
    }
    LDS_WAIT(); asm volatile("" ::: "memory");
    const int c = lane & 7;
#pragma unroll
    for (int j = 0; j < 4; ++j) {
        const int n = (lane >> 3) + 8 * j; const LAS float* s = scr + (8 * c) * 33 + n;
        if (f8 == 2) {
            unsigned o8[2];
#pragma unroll
            for (int hh = 0; hh < 2; ++hh) { unsigned wv = 0u;
#pragma unroll
                for (int b = 0; b < 4; ++b) { const int q = max(-127, min(127, (int)__builtin_rintf(s[(hh * 4 + b) * 33]))); wv |= ((unsigned)q & 255u) << (8 * b); }
                o8[hh] = wv; }
            u32x2 ov; ov.x = o8[0]; ov.y = o8[1];
            *(u32x2*)((unsigned char*)dst + (size_t)(drow0 + n) * dpitch + k0 + 8 * c) = ov;
        } else if (f8) {
            int w0 = 0, w1 = 0;
            w0 = __builtin_amdgcn_cvt_pk_fp8_f32(s[0 * 33], s[1 * 33], w0, false); w0 = __builtin_amdgcn_cvt_pk_fp8_f32(s[2 * 33], s[3 * 33], w0, true);
            w1 = __builtin_amdgcn_cvt_pk_fp8_f32(s[4 * 33], s[5 * 33], w1, false); w1 = __builtin_amdgcn_cvt_pk_fp8_f32(s[6 * 33], s[7 * 33], w1, true);
            u32x2 o8; o8.x = (unsigned)w0; o8.y = (unsigned)w1;
            *(u32x2*)((unsigned char*)dst + (size_t)(drow0 + n) * dpitch + k0 + 8 * c) = o8;
        } else {
        u32x4 o; o.x = cvt_pk_bf16(s[0 * 33], s[1 * 33]); o.y = cvt_pk_bf16(s[2 * 33], s[3 * 33]); o.z = cvt_pk_bf16(s[4 * 33], s[5 * 33]); o.w = cvt_pk_bf16(s[6 * 33], s[7 * 33]);
        *(u32x4*)(dst + (size_t)(drow0 + n) * dpitch + k0 + 8 * c) = o;
        }
    }
    LDS_WAIT(); asm volatile("" ::: "memory");
}
__device__ __forceinline__ unsigned char* launder_s(unsigned char* p) { unsigned long long v = (unsigned long long)p; asm volatile("" : "+s"(v)); return (unsigned char*)v; }
struct Ptrs {
    const float *x, *ln, *wg, *wu, *wd, *wqkv, *wo, *pw, *ps, *fg;
    float* out; unsigned char* ws;
};
__device__ __forceinline__ bf16* ws_wgu(unsigned char* ws, int f) { return (bf16*)(ws + WS_WFFN + (size_t)f * WFFN_STRIDE); }
__device__ __forceinline__ bf16* ws_wd(unsigned char* ws, int f) { return (bf16*)(ws + WS_WFFN + (size_t)f * WFFN_STRIDE + WFFN_WD); }
__device__ __forceinline__ bf16* ws_wqkv(unsigned char* ws, int a) { return (bf16*)(ws + WS_WATT + (size_t)a * WATT_STRIDE); }
__device__ __forceinline__ bf16* ws_wo(unsigned char* ws, int a) { return (bf16*)(ws + WS_WATT + (size_t)a * WATT_STRIDE + WATT_WO); }
__device__ __forceinline__ bf16* ws_wp(unsigned char* ws, int p) { return (bf16*)(ws + WS_WP + (size_t)p * 524288); }

constexpr int IT_F = 1408, IT_FFN = 3 * IT_F, IT_ATT = 2048, IT_QKV = 1536, IT_POOL = 128;
constexpr int IT_TOTAL = 8 * IT_FFN + 2 * IT_ATT + 2 * IT_POOL;
__device__ __forceinline__ void convert_items(const Ptrs& P, LAS unsigned char* lds, int it_lo, int it_hi, int ww, int n_ww, int wave, int lane) {
    LAS float* scr = (LAS float*)(lds + wave * 16384);
    for (int it = it_lo + ww; it < it_hi; it += n_ww) {
        if (it < 8 * IT_FFN) {
            const int f = it / IT_FFN, r = it % IT_FFN, m = r / IT_F, q = r % IT_F;
            if (m < 2) {
                const int kb = q / 88, nb = q % 88, n0 = 32 * nb;
                const float* src = (m == 0 ? P.wg : P.wu) + (size_t)f * D_ * FF_;
                const float* gain = P.ln + ((f >> 1) * 3 + ((f & 1) ? 2 : 0)) * D_;
                const bool x8 = ((X8_MASK >> f) & 1) != 0, i8 = ((I8_MASK >> f) & 1) != 0;
                tr_item(src, FF_, 64 * kb, n0, ws_wgu(P.ws, f), D_, (n0 >> 7) * 256 + m * 128 + (n0 & 127), gain, i8 ? pg8::I8_WQ : x8 ? 256.0f : 1.0f, scr, lane, i8 ? 2 : (x8 ? 1 : 0));
            } else {
                const int kb = q / 32, nb = q % 32;
                const bool f8 = ((FP8_MASK >> f) & 1) != 0;
                tr_item(P.wd + (size_t)f * D_ * FF_, D_, 64 * kb, 32 * nb, ws_wd(P.ws, f), FF_, 32 * nb, nullptr, f8 ? 512.0f : 1.0f, scr, lane, f8 ? 1 : 0);
            }
        } else if (it < 8 * IT_FFN + 2 * IT_ATT) {
            const int r = it - 8 * IT_FFN, a = r / IT_ATT; int q = r % IT_ATT;
            if (q < IT_QKV) {
                const int kb = q / 96, nb = q % 96, n0 = 32 * nb;
                tr_item(P.wqkv + (size_t)a * D_ * 3 * D_, 3 * D_, 64 * kb, n0, ws_wqkv(P.ws, a), D_, n0, P.ln + ((2 * a) * 3 + 1) * D_, n0 < D_ ? 0.125f * LOG2E : 1.0f, scr, lane);
            } else {
                q -= IT_QKV; const int kb = q / 32, nb = q % 32;
                tr_item(P.wo + (size_t)a * D_ * D_, D_, 64 * kb, 32 * nb, ws_wo(P.ws, a), D_, 32 * nb, nullptr, 1.0f, scr, lane);
            }
        } else {
            const int r = it - 8 * IT_FFN - 2 * IT_ATT, p = r / IT_POOL, g = (r % IT_POOL) / 32, q = r % 32, kb = q / 8, nb = q % 8;
            tr_item(P.pw + (size_t)(p * 4 + g) * 65536, 256, 64 * kb, 32 * nb, ws_wp(P.ws, p), 256, g * 256 + 32 * nb, nullptr, 1.0f, scr, lane);
        }
    }
}
#ifndef TAILCONV
#define TAILCONV 1
#endif
__device__ __forceinline__ void phase_prologue(const Ptrs& P, LAS unsigned char* lds, const int wave0) {
    int tid = wave0 * 64 + mk_lane(); asm volatile("" : "+v"(tid)); const int lane = tid & 63, wave = __builtin_amdgcn_readfirstlane(tid >> 6); (void)lane; (void)wave;
    const int gw = blockIdx.x * NWAVES + wave, NGW = gridDim.x * NWAVES;
    if (TAILCONV && gridDim.x == 256) {
        convert_items(P, lds, 0, IT_FFN, gw, NGW, wave, lane);
        convert_items(P, lds, 8 * IT_FFN, 8 * IT_FFN + IT_ATT, gw, NGW, wave, lane);
    } else convert_items(P, lds, 0, IT_TOTAL, gw, NGW, wave, lane);
    bf16* XB = (bf16*)(P.ws + WS_XB); float* ssq = (float*)(P.ws + WS_SSQ);
    for (int row = gw; row < S_; row += NGW) {
        const f32x4* xr = (const f32x4*)(P.x + (size_t)row * D_) + lane;
        f32x4 v[4]; float s = 0.f;
#pragma unroll
        for (int j = 0; j < 4; ++j) { v[j] = __builtin_nontemporal_load(xr + 64 * j); s += (v[j].x * v[j].x + v[j].y * v[j].y) + (v[j].z * v[j].z + v[j].w * v[j].w); }
        s = wave_sum(s, lane);
        if ((I8_MASK & 1) != 0) {
            float am = 0.f;
#pragma unroll
            for (int j = 0; j < 4; ++j) am = fmaxf(fmaxf(am, fmaxf(fabsf(v[j].x), fabsf(v[j].y))), fmaxf(fabsf(v[j].z), fabsf(v[j].w)));
            am = fmaxf(am, shx(am, 1, lane)); am = fmaxf(am, shx(am, 2, lane)); am = fmaxf(am, shx(am, 4, lane)); am = fmaxf(am, shx(am, 8, lane)); am = fmaxf(am, shx(am, 16, lane)); am = fmaxf(am, shx(am, 32, lane));
            am = fmaxf(am, 1e-20f); const float qs = 127.0f / am;
            unsigned* oq = (unsigned*)(P.ws + WS_XQ + (size_t)row * D_) + lane;
#pragma unroll
            for (int j = 0; j < 4; ++j) { const int q0 = (int)__builtin_rintf(v[j].x * qs), q1 = (int)__builtin_rintf(v[j].y * qs), q2 = (int)__builtin_rintf(v[j].z * qs), q3 = (int)__builtin_rintf(v[j].w * qs);
                oq[64 * j] = ((unsigned)q0 & 255u) | (((unsigned)q1 & 255u) << 8) | (((unsigned)q2 & 255u) << 16) | (((unsigned)q3 & 255u) << 24); }
            if (lane == 0) ((float*)(P.ws + WS_XS))[row] = am * __builtin_amdgcn_rsqf(s * (1.0f / 1024.0f) + EPS) * (pg8::I8_IWQ / 127.0f);
        }
        u32x2* o8 = (u32x2*)(XB + (size_t)row * D_) + lane;
#pragma unroll
        for (int j = 0; j < 4; ++j) { u32x2 w; w.x = cvt_pk_bf16(v[j].x, v[j].y); w.y = cvt_pk_bf16(v[j].z, v[j].w); o8[64 * j] = w; }
        if (lane < 16) ssq[(size_t)row * 16 + lane] = lane == 0 ? s : 0.f;
    }
}

__device__ __forceinline__ void phase_final(const Ptrs& P, bool poison, const int wave0) {
    int tid = wave0 * 64 + mk_lane(); asm volatile("" : "+v"(tid)); const int lane = tid & 63, wave = __builtin_amdgcn_readfirstlane(tid >> 6); (void)lane; (void)wave;
    const int gw = blockIdx.x * NWAVES + wave, NGW = gridDim.x * NWAVES;
    const float* ssq = (const float*)(P.ws + WS_SSQ);
    const float qnan = __builtin_nanf("");
    for (int row = gw; row < S_; row += NGW) {
        const float rs = row_rstd(ssq, row);
        f32x4* xr = (f32x4*)(P.out + (size_t)row * D_) + lane; const f32x4* gr = (const f32x4*)P.fg + lane;
        const u32x2* h8 = (const u32x2*)((const bf16*)(P.ws + WS_XB) + (size_t)row * D_) + lane;
#pragma unroll
        for (int j = 0; j < 4; ++j) { const u32x2 hv = h8[64 * j]; f32x4 x4 = {bf_lo(hv.x), bf_hi(hv.x), bf_lo(hv.y), bf_hi(hv.y)};
            f32x4 v = x4 * gr[64 * j] * rs; if (poison) v = (f32x4){qnan, qnan, qnan, qnan}; __builtin_nontemporal_store(v, xr + 64 * j); }
    }
}

__device__ __forceinline__ void phase_pool_elem(const bf16* xhi, const float* ssq, const float* gain, bf16* Y, const bf16* halo, LAS unsigned char* lds, const int wave0) {
    int tid = wave0 * 64 + mk_lane(); asm volatile("" : "+v"(tid)); const int lane = tid & 63, wave = __builtin_amdgcn_readfirstlane(tid >> 6); (void)lane; (void)wave;
    LAS float* rs = (LAS float*)lds;
    const int L = blockIdx.x, g = L >> 6, strip = wave >> 1;
    const int t0 = (L & 63) * 256 + strip * 64;
    if (tid < 320) { const int st = tid / 80, r = (L & 63) * 256 + st * 64 - 16 + tid % 80; rs[tid] = r >= 0 ? row_rstd(ssq, r) : 0.f; }
    __syncthreads();
    const int cg = 2 * (tid & 127), c = g * 256 + cg;
    const f32x2 gn = *(const f32x2*)(gain + c);
    f32x2 hist[16], S2 = {0.f, 0.f}, S4 = {0.f, 0.f}, S8 = {0.f, 0.f}, S16 = {0.f, 0.f};
#pragma unroll
    for (int i = 0; i < 16; ++i) hist[i] = (f32x2){0.f, 0.f};
    const int w = 2 << g;
    bf16* Yg = Y + (size_t)g * S_ * 256 + cg;
    LAS const float* rss = rs + strip * 80;
    unsigned hwv[80];
#pragma unroll
    for (int r = 0; r < 80; ++r) {
        const int row = t0 - 16 + r; hwv[r] = 0u;
        if (row >= 0) { const bf16* src = (r < 16 && strip == 0) ? halo + ((size_t)((L & 63) - 1) * 16 + r) * D_ + c : xhi + (size_t)row * D_ + c; hwv[r] = *(const unsigned*)src; }
    }
#pragma unroll
    for (int b = 0; b < 5; ++b) {
#pragma unroll
        for (int i = 0; i < 16; ++i) {
            const int r = 16 * b + i, row = t0 - 16 + r;
            const unsigned hw = hwv[r];
            const f32x2 hv = (f32x2){bf_lo(hw), bf_hi(hw)} * gn * rss[r];
            S16 += hv - hist[i]; S8 += hv - hist[(i + 8) & 15]; S4 += hv - hist[(i + 12) & 15]; S2 += hv - hist[(i + 14) & 15]; hist[i] = hv;
            if (b > 0) {
                const f32x2 sw = g == 0 ? S2 : g == 1 ? S4 : g == 2 ? S8 : S16;
                const int cnt = row + 1 < w ? row + 1 : w;
                const f32x2 y = sw * (1.0f / (float)cnt) - hv;
                *(unsigned*)(Yg + (size_t)row * 256) = cvt_pk_bf16(y.x, y.y);
            }
        }
    }
    asm volatile("s_waitcnt vmcnt(0)" ::: "memory");
    __builtin_amdgcn_fence(__ATOMIC_ACQUIRE, "agent");
    asm volatile("s_waitcnt vmcnt(0)" ::: "memory");
    __syncthreads();
}

__device__ __forceinline__ bool alibi_dead(float slope2, int t, int n) { return slope2 * (float)(t - n * BS - (BS - 1)) >= 160.0f; }
__device__ __forceinline__ float head_slope2(int h) { return exp2f(-0.5f * (float)(h + 1)) * LOG2E; }
__device__ __forceinline__ void top3_insert(float gt, unsigned n, float& v0, float& v1, float& v2, unsigned& i0, unsigned& i1, unsigned& i2) {
    const bool g0 = gt > v0, g1 = gt > v1, g2 = gt > v2;
    v2 = g1 ? v1 : (g2 ? gt : v2); i2 = g1 ? i1 : (g2 ? n : i2);
    v1 = g0 ? v0 : (g1 ? gt : v1); i1 = g0 ? i0 : (g1 ? n : i1);
    v0 = g0 ? gt : v0;             i0 = g0 ? n : i0;
}
__device__ __forceinline__ void phase_gate(const bf16* Q, const float* kpart, unsigned* sel, float* qn2, unsigned* lists, gu32* lc, LAS unsigned char* lds, const int wave0) {
    int tid = wave0 * 64 + mk_lane(); asm volatile("" : "+v"(tid)); const int lane = tid & 63, wave = __builtin_amdgcn_readfirstlane(tid >> 6);
    const int fr = lane & 15, fq = lane >> 4;
    constexpr int KP = 144, LO = 64 * KP;
    for (int wgt = blockIdx.x; wgt < 256; wgt += gridDim.x) {
        const int h = wgt & 15, part = wgt >> 4;
        const float slope2g = head_slope2(h);
        unsigned apos[8], aent[8];
        bf16x8 qa[8][2];
#pragma unroll
        for (int i = 0; i < 8; ++i) { const bf16* qrow = Q + (size_t)(part * 1024 + (wave + 8 * i) * 16 + fr) * D_ + h * 64; qa[i][0] = *(const bf16x8*)(qrow + 8 * fq); qa[i][1] = *(const bf16x8*)(qrow + 32 + 8 * fq); }
        {
            const int n = tid >> 3, d0 = (tid & 7) * 8;
            const float* pa = kpart + (size_t)n * D_ + h * 64 + d0; const float* pb = pa + (size_t)NBLK * D_;
            const f32x4 a0 = *(const f32x4*)pa, a1 = *(const f32x4*)(pa + 4), b0 = *(const f32x4*)pb, b1 = *(const f32x4*)(pb + 4);
            const f32x4 s0 = a0 + b0, s1 = a1 + b1;
            u32x4 hi; hi.x = cvt_pk_bf16(s0.x, s0.y); hi.y = cvt_pk_bf16(s0.z, s0.w); hi.z = cvt_pk_bf16(s1.x, s1.y); hi.w = cvt_pk_bf16(s1.z, s1.w);
            u32x4 lo; lo.x = cvt_pk_bf16(s0.x - bf_lo(hi.x), s0.y - bf_hi(hi.x)); lo.y = cvt_pk_bf16(s0.z - bf_lo(hi.y), s0.w - bf_hi(hi.y));
            lo.z = cvt_pk_bf16(s1.x - bf_lo(hi.z), s1.y - bf_hi(hi.z)); lo.w = cvt_pk_bf16(s1.z - bf_lo(hi.w), s1.w - bf_hi(hi.w));
            *(LAS u32x4*)(lds + n * KP + d0 * 2) = hi; *(LAS u32x4*)(lds + LO + n * KP + d0 * 2) = lo;
        }
        LAS unsigned* lcn = (LAS unsigned*)(lds + 2 * LO + 2048);
        if (tid < 64) lcn[tid] = 0u;
        __syncthreads();
#pragma unroll
        for (int ti = 0; ti < 8; ++ti) {
            const int tile = wave + 8 * ti;
            const int t0 = part * 1024 + tile * 16, j = t0 >> 8, t = t0 + fr;
            const bf16x8 q0 = qa[ti][0], q1 = qa[ti][1];
            float v0 = -INFINITY, v1 = -INFINITY, v2 = -INFINITY; unsigned i0 = 255u, i1 = 255u, i2 = 255u;
            LAS const unsigned char* kp = lds + fr * KP + fq * 16;
#pragma unroll
            for (int bt = 0; bt < 4; ++bt) {
                if (16 * bt < j) {
                    const bf16x8 h0 = *(LAS const bf16x8*)(kp + bt * 16 * KP), h1 = *(LAS const bf16x8*)(kp + bt * 16 * KP + 64);
                    const bf16x8 l0 = *(LAS const bf16x8*)(kp + LO + bt * 16 * KP), l1 = *(LAS const bf16x8*)(kp + LO + bt * 16 * KP + 64);
                    f32x4 z = {0.f, 0.f, 0.f, 0.f};
                    z = __builtin_amdgcn_mfma_f32_16x16x32_bf16(l0, q0, z, 0, 0, 0); z = __builtin_amdgcn_mfma_f32_16x16x32_bf16(l1, q1, z, 0, 0, 0);
                    z = __builtin_amdgcn_mfma_f32_16x16x32_bf16(h0, q0, z, 0, 0, 0); z = __builtin_amdgcn_mfma_f32_16x16x32_bf16(h1, q1, z, 0, 0, 0);
#pragma unroll
                    for (int e = 0; e < 4; ++e) { const int n = 16 * bt + 4 * fq + e; if (n < j) top3_insert(z[e], (unsigned)n, v0, v1, v2, i0, i1, i2); }
                }
            }
#pragma unroll
            for (int sh = 16; sh <= 32; sh <<= 1) {
                const float p0 = shx(v0, sh, lane), p1 = shx(v1, sh, lane), p2 = shx(v2, sh, lane);
                const unsigned q0i = shxu(i0, sh, lane), q1i = shxu(i1, sh, lane), q2i = shxu(i2, sh, lane);
                if (q0i != 255u) top3_insert(p0, q0i, v0, v1, v2, i0, i1, i2);
                if (q1i != 255u) top3_insert(p1, q1i, v0, v1, v2, i0, i1, i2);
                if (q2i != 255u) top3_insert(p2, q2i, v0, v1, v2, i0, i1, i2);
            }
            float qq = 0.f;
#pragma unroll
            for (int i = 0; i < 8; ++i) { const float a = __uint_as_float((unsigned)(unsigned short)q0[i] << 16), b = __uint_as_float((unsigned)(unsigned short)q1[i] << 16); qq = __builtin_fmaf(a, a, qq); qq = __builtin_fmaf(b, b, qq); }
            qq += shx(qq, 16, lane); qq += shx(qq, 32, lane);
            const unsigned word = i0 | (i1 << 8) | (i2 << 16) | 0xff000000u;
            if (fq == 0) { sel[(size_t)h * S_ + t] = word; qn2[(size_t)h * S_ + t] = qq; }
            const unsigned w0 = (unsigned)shi((int)word, fr);
            const unsigned nk = fq < 3 ? ((w0 >> (8 * fq)) & 255u) : 255u;
            apos[ti] = 0u; aent[ti] = 0xffffffffu;
            if (nk != 255u && !alibi_dead(slope2g, t, (int)nk)) { apos[ti] = __hip_atomic_fetch_add(lcn + nk, 1u, __ATOMIC_RELAXED, __HIP_MEMORY_SCOPE_WORKGROUP); aent[ti] = (nk << 16) | (unsigned)t | ((unsigned)fq << 14); }
        }
        __syncthreads();
        if (tid < 64) { const unsigned c = lcn[tid]; lcn[64 + tid] = c ? __hip_atomic_fetch_add(lc + h * 64 + tid, c, RLX_AGENT) : 0u; }
        __syncthreads();
#pragma unroll
        for (int ti = 0; ti < 8; ++ti) if (aent[ti] != 0xffffffffu) { const int n = (int)(aent[ti] >> 16); lists[(size_t)h * LIST_HEAD + list_off(n) + lcn[64 + n] + apos[ti]] = aent[ti] & 0xffffu; }
        __syncthreads();
    }
}

template <bool CAUSAL, bool FOLD = false>
__device__ __forceinline__ void attn_tile(LAS const unsigned char* Ks, LAS const unsigned char* Vt, bf16x8 q0, bf16x8 q1, float lcm, float slope2, int tq_rel, int nch, int fr, int fq,
                                          f32x4 (&o)[4], float& l_out, LAS const unsigned char* Wr = nullptr) {
    const int rowbase = 8 * (fr >> 2) + (fr & 3), sw = (((fr >> 1) & 1) << 1) | (((fr >> 3) & 1) << 2);
    LAS const unsigned char* kp0 = Ks + rowbase * 128 + ((fq ^ sw) * 16);
    LAS const unsigned char* kp1 = Ks + rowbase * 128 + (((4 | fq) ^ sw) * 16);
    const float thr_f = (float)(tq_rel - 8 * fq);
    f32x4 s[16];
    bf16x8 kf[2][4];
#define AT_LOADK(buf, c) do { _Pragma("unroll") for (int u = 0; u < 2; ++u) { const int ro = (32 * (c) + 4 * u) * 128; \
        kf[buf][2 * u] = *(LAS const bf16x8*)(kp0 + ro); kf[buf][2 * u + 1] = *(LAS const bf16x8*)(kp1 + ro); } } while (0)
    AT_LOADK(0, 0);
#pragma unroll
    for (int c = 0; c < 8; ++c) {
        if (!CAUSAL || c < nch) {
            if (c < 7) { if (!CAUSAL || c + 1 < nch) AT_LOADK((c + 1) & 1, c + 1); }
            __builtin_amdgcn_sched_barrier(0);
            f32x4 c0, c1;
            float lcc = lcm, thc = thr_f; asm volatile("" : "+v"(lcc), "+v"(thc));
            if constexpr (FOLD) { c0 = (f32x4){lcc, lcc, lcc, lcc}; c1 = c0; } else {
#pragma unroll
            for (int e = 0; e < 4; ++e) {
                c0[e] = __builtin_fmaf(slope2, (float)(32 * c + e), lcc); c1[e] = __builtin_fmaf(slope2, (float)(32 * c + 4 + e), lcc);
                if (CAUSAL) { c0[e] = __builtin_fmaf(fminf(thc - (float)(32 * c + e), 0.f), 1e9f, c0[e]); c1[e] = __builtin_fmaf(fminf(thc - (float)(32 * c + 4 + e), 0.f), 1e9f, c1[e]); }
            }
            }
            const f32x4 z0 = __builtin_amdgcn_mfma_f32_16x16x32_bf16(kf[c & 1][0], q0, c0, 0, 0, 0);
            const f32x4 z1 = __builtin_amdgcn_mfma_f32_16x16x32_bf16(kf[c & 1][2], q0, c1, 0, 0, 0);
            s[2 * c] = __builtin_amdgcn_mfma_f32_16x16x32_bf16(kf[c & 1][1], q1, z0, 0, 0, 0);
            s[2 * c + 1] = __builtin_amdgcn_mfma_f32_16x16x32_bf16(kf[c & 1][3], q1, z1, 0, 0, 0);
        }
    }
#undef AT_LOADK
    const int lanev16 = (fq ^ (2 * (fr & 7))) * 16;
    LAS const unsigned char* vp = Vt + fr * 512;
    bf16x8 vf[2][4], wf[2];
#define AT_LOADV(buf, c) do { const int co = (64 * (c)) ^ lanev16; \
        _Pragma("unroll") for (int dt = 0; dt < 4; ++dt) vf[buf][dt] = *(LAS const bf16x8*)(vp + dt * 8192 + co); \
        if constexpr (FOLD) wf[buf] = *(LAS const bf16x8*)(Wr + (32 * (c) + 8 * fq) * 2); } while (0)
    AT_LOADV(0, 0);
#pragma unroll
    for (int kt = 0; kt < 16; ++kt) {
        if (!CAUSAL || (kt >> 1) < nch) {
#pragma unroll
            for (int e = 0; e < 4; ++e) s[kt][e] = __builtin_amdgcn_exp2f(s[kt][e]);
        }
    }
#pragma unroll
    for (int dt = 0; dt < 4; ++dt) o[dt] = (f32x4){0.f, 0.f, 0.f, 0.f};
    f32x4 lsum = {0.f, 0.f, 0.f, 0.f};
    const bf16x8 ones = {(short)0x3f80, (short)0x3f80, (short)0x3f80, (short)0x3f80, (short)0x3f80, (short)0x3f80, (short)0x3f80, (short)0x3f80};
#pragma unroll
    for (int c = 0; c < 8; ++c) {
        if (!CAUSAL || c < nch) {
            if (c < 7) { if (!CAUSAL || c + 1 < nch) AT_LOADV((c + 1) & 1, c + 1); }
            u32x4 pw; pw.x = cvt_pk_bf16(s[2 * c][0], s[2 * c][1]); pw.y = cvt_pk_bf16(s[2 * c][2], s[2 * c][3]); pw.z = cvt_pk_bf16(s[2 * c + 1][0], s[2 * c + 1][1]); pw.w = cvt_pk_bf16(s[2 * c + 1][2], s[2 * c + 1][3]);
            const bf16x8 pf = __builtin_bit_cast(bf16x8, pw);
#pragma unroll
            for (int dt = 0; dt < 4; ++dt) o[dt] = __builtin_amdgcn_mfma_f32_16x16x32_bf16(vf[c & 1][dt], pf, o[dt], 0, 0, 0);
            lsum = __builtin_amdgcn_mfma_f32_16x16x32_bf16(FOLD ? wf[c & 1] : ones, pf, lsum, 0, 0, 0);
        }
    }
    const float l = lsum[0];
#undef AT_LOADV
    l_out = l;
}
__device__ __forceinline__ void kv_load(const bf16* K, const bf16* V, int n, int h, u32x4 (&kv)[4], u32x4 (&vv)[4], int tid, int wave, int lane) {
#pragma unroll
    for (int it = 0; it < 4; ++it) kv[it] = *(const u32x4*)(K + (size_t)(n * BS + it * 64 + (tid >> 3)) * D_ + h * 64 + (tid & 7) * 8);
#pragma unroll
    for (int it = 0; it < 4; ++it) vv[it] = *(const u32x4*)(V + (size_t)(n * BS + wave * 32 + (lane & 31)) * D_ + h * 64 + ((lane >> 5) * 4 + it) * 8);
}
template <bool FOLD = false>
__device__ __forceinline__ void kv_write(const u32x4 (&kv)[4], const u32x4 (&vv)[4], LAS unsigned char* lds, LAS unsigned* kmaxw, int tid, int wave, int lane, float slope2 = 0.f) {
    float kn = 0.f;
#pragma unroll
    for (int it = 0; it < 4; ++it) { const int r = it * 64 + (tid >> 3), c16 = tid & 7, swz = (((r >> 1) & 1) << 1) | (((r >> 4) & 1) << 2);
        *(LAS u32x4*)(lds + A_KS + r * 128 + ((c16 ^ swz) * 16)) = kv[it];
        float sq = 0.f;
#pragma unroll
        for (int w = 0; w < 4; ++w) { const float a = bf_lo(kv[it][w]), b = bf_hi(kv[it][w]); sq = __builtin_fmaf(a, a, sq); sq = __builtin_fmaf(b, b, sq); }
        sq += shx(sq, 1, lane); sq += shx(sq, 2, lane); sq += shx(sq, 4, lane); kn = fmaxf(kn, sq); }
    kn = fmaxf(kn, shx(kn, 8, lane)); kn = fmaxf(kn, shx(kn, 16, lane)); kn = fmaxf(kn, shx(kn, 32, lane));
    if (lane == 0) __hip_atomic_fetch_max(kmaxw, __float_as_uint(kn), __ATOMIC_RELAXED, __HIP_MEMORY_SCOPE_WORKGROUP);
#pragma unroll
    for (int it = 0; it < 4; ++it) {
        const int key = wave * 32 + (lane & 31), pc = (lane >> 5) * 4 + it;
        u32x4 v = vv[it];
        if constexpr (FOLD) {
            const float wk = __builtin_amdgcn_exp2f(slope2 * (float)(key - (BS - 1)));
            v.x = cvt_pk_bf16(bf_lo(v.x) * wk, bf_hi(v.x) * wk); v.y = cvt_pk_bf16(bf_lo(v.y) * wk, bf_hi(v.y) * wk); v.z = cvt_pk_bf16(bf_lo(v.z) * wk, bf_hi(v.z) * wk); v.w = cvt_pk_bf16(bf_lo(v.w) * wk, bf_hi(v.w) * wk);
            if (pc == 0) *(LAS unsigned short*)(lds + A_WROW + key * 2) = (unsigned short)(cvt_pk_bf16(wk, wk) & 0xffffu);
        }
        LAS unsigned char* vb = lds + A_VT + (pc * 8) * 512 + (key & 7) * 2; const int kc = key >> 3;
#define ST_VT(e, val) *(LAS unsigned short*)(vb + (e) * 512 + ((kc ^ (2 * (e))) * 16)) = (unsigned short)(val)
        ST_VT(0, v.x & 0xffffu); ST_VT(1, v.x >> 16); ST_VT(2, v.y & 0xffffu); ST_VT(3, v.y >> 16);
        ST_VT(4, v.z & 0xffffu); ST_VT(5, v.z >> 16); ST_VT(6, v.w & 0xffffu); ST_VT(7, v.w >> 16);
#undef ST_VT
    }
}

constexpr int SEL_NU = 1284;
__device__ const unsigned sel_unit_tab[SEL_NU] = {
    0xa0005u, 0xa0015u, 0xa0025u, 0xa0006u, 0xa0016u, 0xa0026u, 0xa0036u, 0xa0007u, 0x141407u, 0xa0017u, 0xa0027u, 0xa0037u, 0xa0047u, 0xa0008u, 0x141408u, 0xa0018u,
    0x141418u, 0xa0028u, 0xa0038u, 0xa0048u, 0xa0058u, 0xa0068u, 0xa0078u, 0xa0009u, 0x141409u, 0xa0019u, 0x141419u, 0xa0029u, 0x141429u, 0xa0039u, 0xa0049u, 0xa0059u,
    0xa0069u, 0xa0079u, 0xa0089u, 0xa0099u, 0xa00a9u, 0xa000au, 0x14140au, 0x1e280au, 0xa001au, 0x14141au, 0xa002au, 0x14142au, 0xa003au, 0x14143au, 0xa004au, 0x14144au,
    0xa005au, 0xa006au, 0xa007au, 0xa008au, 0xa009au, 0xa00aau, 0xa00bau, 0xa00cau, 0xa00dau, 0xa00eau, 0xa000bu, 0x14140bu, 0x1e280bu, 0xa001bu, 0x14141bu, 0x1e281bu,
    0xa002bu, 0x14142bu, 0xa003bu, 0x14143bu, 0xa004bu, 0x14144bu, 0xa005bu, 0x14145bu, 0xa006bu, 0xa007bu, 0xa008bu, 0xa009bu, 0xa00abu, 0xa00bbu, 0xa00cbu, 0xa00dbu,
    0xa00ebu, 0xa00fbu, 0xa010bu, 0xa011bu, 0xa012bu, 0xa013bu, 0xa014bu, 0xa000cu, 0x14140cu, 0x1e280cu, 0x283c0cu, 0xa001cu, 0x14141cu, 0x1e281cu, 0xa002cu, 0x14142cu,
    0x1e282cu, 0xa003cu, 0x14143cu, 0xa004cu, 0x14144cu, 0xa005cu, 0x14145cu, 0xa006cu, 0x14146cu, 0xa007cu, 0x14147cu, 0xa008cu, 0x14148cu, 0xa009cu, 0xa00acu, 0xa00bcu,
    0xa00ccu, 0xa00dcu, 0xa00ecu, 0xa00fcu, 0xa010cu, 0xa011cu, 0xa012cu, 0xa013cu, 0xa014cu, 0xa015cu, 0xa016cu, 0xa017cu, 0xa018cu, 0xa019cu, 0xa01acu, 0xa01bcu,
    0xa000du, 0x14140du, 0x1e280du, 0x283c0du, 0xa001du, 0x14141du, 0x1e281du, 0x283c1du, 0xa002du, 0x14142du, 0x1e282du, 0xa003du, 0x14143du, 0x1e283du, 0xa004du, 0x14144du,
    0x1e284du, 0xa005du, 0x14145du, 0xa006du, 0x14146du, 0xa007du, 0x14147du, 0xa008du, 0x14148du, 0xa009du, 0x14149du, 0xa00adu, 0x1414adu, 0xa00bdu, 0x1414bdu, 0xa00cdu,
    0xa00ddu, 0xa00edu, 0xa00fdu, 0xa010du, 0xa011du, 0xa012du, 0xa013du, 0xa014du, 0xa015du, 0xa016du, 0xa017du, 0xa018du, 0xa019du, 0xa01adu, 0xa01bdu, 0xa000eu,
    0x14140eu, 0x1e280eu, 0x283c0eu, 0xa001eu, 0x14141eu, 0x1e281eu, 0x283c1eu, 0xa002eu, 0x14142eu, 0x1e282eu, 0xa003eu, 0x14143eu, 0x1e283eu, 0xa004eu, 0x14144eu, 0x1e284eu,
    0xa005eu, 0x14145eu, 0xa006eu, 0x14146eu, 0xa007eu, 0x14147eu, 0xa008eu, 0x14148eu, 0xa009eu, 0x14149eu, 0xa00aeu, 0x1414aeu, 0xa00beu, 0x1414beu, 0xa00ceu, 0xa00deu,
    0xa00eeu, 0xa00feu, 0xa010eu, 0xa011eu, 0xa012eu, 0xa013eu, 0xa014eu, 0xa015eu, 0xa016eu, 0xa017eu, 0xa018eu, 0xa019eu, 0xa01aeu, 0xa01beu, 0xa000fu, 0x14140fu,
    0x1e280fu, 0x283c0fu, 0xa001fu, 0x14141fu, 0x1e281fu, 0x283c1fu, 0xa002fu, 0x14142fu, 0x1e282fu, 0xa003fu, 0x14143fu, 0x1e283fu, 0xa004fu, 0x14144fu, 0x1e284fu, 0xa005fu,
    0x14145fu, 0xa006fu, 0x14146fu, 0xa007fu, 0x14147fu, 0xa008fu, 0x14148fu, 0xa009fu, 0x14149fu, 0xa00afu, 0x1414afu, 0xa00bfu, 0x1414bfu, 0xa00cfu, 0xa00dfu, 0xa00efu,
    0xa00ffu, 0xa010fu, 0xa011fu, 0xa012fu, 0xa013fu, 0xa014fu, 0xa015fu, 0xa016fu, 0xa017fu, 0xa018fu, 0xa019fu, 0xa01afu, 0xa01bfu, 0x1e283cu, 0xa015bu, 0x14146bu,
    0x1e282bu, 0xa00fau, 0xfe0004u, 0xfe0057u, 0xfe016bu, 0xfe01ccu, 0xfe01cdu, 0xfe01ceu, 0xfe01cfu, 0x14149cu, 0x1e281au, 0xfe14cdu, 0xfe14ceu, 0xfe14cfu, 0xfe00b9u, 0xfe010au,
    0xfe017bu, 0xfe0014u, 0xfe285eu, 0xfe285fu, 0xfe01dcu, 0xfe01ddu, 0xfe01deu, 0xfe01dfu, 0xfe0088u, 0xfe1439u, 0xfe018bu, 0xfe1428u, 0xfe011au, 0xfe00c9u, 0xfe2809u, 0xfe285du,
    0xfe019bu, 0xfe0046u, 0xfe01ecu, 0xfe01edu, 0xfe01eeu, 0xfe01efu, 0xfe3c2eu, 0xfe3c2fu, 0xfe0067u, 0xfe012au, 0xfe14acu, 0xfe01abu, 0xfe14ddu, 0xfe14deu, 0xfe14dfu, 0xfe147bu,
    0xfe1417u, 0xfe0098u, 0xfe00d9u, 0xfe01fcu, 0xfe01fdu, 0xfe01feu, 0xfe01ffu, 0xfe01bbu, 0xfe013au, 0xfe145au, 0xfe0035u, 0xfe01cbu, 0xfe0024u, 0xfe014au, 0xfe00e9u, 0xfe020cu,
    0xfe020du, 0xfe020eu, 0xfe020fu, 0xfe01dbu, 0xfe00a8u, 0xfe0077u, 0xfe14bcu, 0xfe015au, 0xfe01ebu, 0xfe14edu, 0xfe14eeu, 0xfe14efu, 0xfe021cu, 0xfe021du, 0xfe021eu, 0xfe021fu,
    0xfe00f9u, 0xfe3c2du, 0xfe0056u, 0xfe01fbu, 0xfe016au, 0xfe3c1cu, 0xfe020bu, 0xfe00b8u, 0xfe148bu, 0xfe286eu, 0xfe286fu, 0xfe022cu, 0xfe022du, 0xfe022eu, 0xfe022fu, 0xfe0109u,
    0xfe017au, 0xfe284cu, 0xfe021bu, 0xfe1406u, 0xfe0087u, 0xfe022bu, 0xfe018au, 0xfe286du, 0xfe14ccu, 0xfe3c0bu, 0xfe0119u, 0xfe023cu, 0xfe023du, 0xfe023eu, 0xfe023fu, 0xfe00c8u,
    0xfe023bu, 0xfe0003u, 0xfe0013u, 0xfe14fdu, 0xfe14feu, 0xfe14ffu, 0xfe1449u, 0xfe019au, 0xfe0045u, 0xfe500eu, 0xfe500fu, 0xfe0066u, 0xfe0129u, 0xfe146au, 0xfe024bu, 0xfe024cu,
    0xfe024du, 0xfe024eu, 0xfe024fu, 0xfe01aau, 0xfe0097u, 0xfe00d8u, 0xfe01bau, 0xfe0139u, 0xfe149bu, 0xfe14dcu, 0xfe025bu, 0xfe025cu, 0xfe025du, 0xfe025eu, 0xfe025fu, 0xfe0034u,
    0xfe01cau, 0xfe283bu, 0xfe0149u, 0xfe00e8u, 0xfe0023u, 0xfe150du, 0xfe150eu, 0xfe150fu, 0xfe01dau, 0xfe00a7u, 0xfe282au, 0xfe0076u, 0xfe026bu, 0xfe026cu, 0xfe026du, 0xfe026eu,
    0xfe026fu, 0xfe1438u, 0xfe0159u, 0xfe01eau, 0xfe00f8u, 0xfe1427u, 0xfe0055u, 0xfe01fau, 0xfe0169u, 0xfe14ecu, 0xfe2819u, 0xfe027bu, 0xfe027cu, 0xfe027du, 0xfe027eu, 0xfe027fu,
    0xfe020au, 0xfe00b7u, 0xfe287eu, 0xfe287fu, 0xfe0108u, 0xfe0179u, 0xfe021au, 0xfe287du, 0xfe14abu, 0xfe151du, 0xfe151eu, 0xfe151fu, 0xfe0086u, 0xfe147au, 0xfe022au, 0xfe028bu,
    0xfe028cu, 0xfe028du, 0xfe028eu, 0xfe028fu, 0xfe0189u, 0xfe0118u, 0xfe00c7u, 0xfe023au, 0xfe500du, 0xfe0199u, 0xfe1416u, 0xfe0044u, 0xfe024au, 0xfe14fcu, 0xfe285cu, 0xfe0065u,
    0xfe029bu, 0xfe029cu, 0xfe029du, 0xfe029eu, 0xfe029fu, 0xfe0128u, 0xfe1459u, 0xfe01a9u, 0xfe025au, 0xfe0096u, 0xfe00d7u, 0xfe026au, 0xfe2808u, 0xfe01b9u, 0xfe0002u, 0xfe0012u,
    0xfe0138u, 0xfe027au, 0xfe02abu, 0xfe02acu, 0xfe02adu, 0xfe02aeu, 0xfe02afu, 0xfe152du, 0xfe152eu, 0xfe152fu, 0xfe01c9u, 0xfe0033u, 0xfe3c3eu, 0xfe3c3fu, 0xfe028au, 0xfe14bbu,
    0xfe0148u, 0xfe00e7u, 0xfe0022u, 0xfe029au, 0xfe01d9u, 0xfe150cu, 0xfe00a6u, 0xfe02aau, 0xfe0075u, 0xfe02bbu, 0xfe02bcu, 0xfe02bdu, 0xfe02beu, 0xfe02bfu, 0xfe0158u, 0xfe01e9u,
    0xfe02bau, 0xfe00f7u, 0xfe0054u, 0xfe01f9u, 0xfe148au, 0xfe0168u, 0xfe02cau, 0xfe02cbu, 0xfe02ccu, 0xfe02cdu, 0xfe02ceu, 0xfe02cfu, 0xfe0209u, 0xfe00b6u, 0xfe0107u, 0xfe0178u,
    0xfe153du, 0xfe153eu, 0xfe153fu, 0xfe0219u, 0xfe288du, 0xfe288eu, 0xfe288fu, 0xfe151cu, 0xfe0085u, 0xfe0229u, 0xfe0188u, 0xfe14cbu, 0xfe0117u, 0xfe02dau, 0xfe02dbu, 0xfe02dcu,
    0xfe02ddu, 0xfe02deu, 0xfe02dfu, 0xfe00c6u, 0xfe0239u, 0xfe0198u, 0xfe0249u, 0xfe0043u, 0xfe1448u, 0xfe3c3du, 0xfe0127u, 0xfe0064u, 0xfe01a8u, 0xfe0259u, 0xfe02eau, 0xfe02ebu,
    0xfe02ecu, 0xfe02edu, 0xfe02eeu, 0xfe02efu, 0xfe0095u, 0xfe00d6u, 0xfe3c2cu, 0xfe0269u, 0xfe1469u, 0xfe01b8u, 0xfe152cu, 0xfe0137u, 0xfe0279u, 0xfe284bu, 0xfe154du, 0xfe154eu,
    0xfe154fu, 0xfe01c8u, 0xfe0032u, 0xfe0289u, 0xfe0147u, 0xfe00e6u, 0xfe02fau, 0xfe02fbu, 0xfe02fcu, 0xfe02fdu, 0xfe02feu, 0xfe02ffu, 0xfe0299u, 0xfe0001u, 0xfe0011u, 0xfe0021u,
    0xfe01d8u, 0xfe149au, 0xfe3c1bu, 0xfe00a5u, 0xfe1405u, 0xfe286cu, 0xfe14dbu, 0xfe02a9u, 0xfe0074u, 0xfe0157u, 0xfe01e8u, 0xfe02b9u, 0xfe00f6u, 0xfe02c9u, 0xfe0053u, 0xfe01f8u,
    0xfe030au, 0xfe030bu, 0xfe030cu, 0xfe030du, 0xfe030eu, 0xfe030fu, 0xfe153cu, 0xfe0167u, 0xfe02d9u, 0xfe0208u, 0xfe00b5u, 0xfe02e9u, 0xfe0106u, 0xfe0177u, 0xfe0218u, 0xfe02f9u,
    0xfe1437u, 0xfe0084u, 0xfe0309u, 0xfe0228u, 0xfe155du, 0xfe155eu, 0xfe155fu, 0xfe031au, 0xfe031bu, 0xfe031cu, 0xfe031du, 0xfe031eu, 0xfe031fu, 0xfe0187u, 0xfe0319u, 0xfe0116u,
    0xfe1426u, 0xfe3c0au, 0xfe00c5u, 0xfe0238u, 0xfe0197u, 0xfe0248u, 0xfe0042u, 0xfe154cu, 0xfe14ebu, 0xfe0126u, 0xfe0063u, 0xfe289du, 0xfe289eu, 0xfe289fu, 0xfe01a7u, 0xfe0258u,
    0xfe0329u, 0xfe032au, 0xfe032bu, 0xfe032cu, 0xfe032du, 0xfe032eu, 0xfe032fu, 0xfe0094u, 0xfe501eu, 0xfe501fu, 0xfe00d5u, 0xfe0268u, 0xfe01b7u, 0xfe0136u, 0xfe0278u, 0xfe14aau,
    0xfe01c7u, 0xfe283au, 0xfe0288u, 0xfe0031u, 0xfe0146u, 0xfe00e5u, 0xfe1479u, 0xfe0298u, 0xfe01d7u, 0xfe0339u, 0xfe033au, 0xfe033bu, 0xfe033cu, 0xfe033du, 0xfe033eu, 0xfe033fu,
    0xfe00a4u, 0xfe02a8u, 0xfe0073u, 0xfe2829u, 0xfe0156u, 0xfe01e7u, 0xfe155cu, 0xfe156du, 0xfe156eu, 0xfe156fu, 0xfe02b8u, 0xfe0000u, 0xfe0010u, 0xfe0020u, 0xfe00f5u, 0xfe02c8u,
    0xfe01f7u, 0xfe0052u, 0xfe0166u, 0xfe02d8u, 0xfe0207u, 0xfe00b4u, 0xfe14fbu, 0xfe02e8u, 0xfe0105u, 0xfe0349u, 0xfe034au, 0xfe034bu, 0xfe034cu, 0xfe034du, 0xfe034eu, 0xfe034fu,
    0xfe0176u, 0xfe1458u, 0xfe0217u, 0xfe02f8u, 0xfe0083u, 0xfe0308u, 0xfe0227u, 0xfe0186u, 0xfe0318u, 0xfe0115u, 0xfe00c4u, 0xfe0237u, 0xfe0328u, 0xfe1415u, 0xfe0196u, 0xfe156cu,
    0xfe0338u, 0xfe0247u, 0xfe0041u, 0xfe0125u, 0xfe0359u, 0xfe035au, 0xfe035bu, 0xfe035cu, 0xfe035du, 0xfe035eu, 0xfe035fu, 0xfe0348u, 0xfe0062u, 0xfe01a6u, 0xfe0257u, 0xfe2818u,
    0xfe0358u, 0xfe0093u, 0xfe00d4u, 0xfe0267u, 0xfe01b6u, 0xfe0135u, 0xfe0277u, 0xfe287cu, 0xfe14bau, 0xfe157du, 0xfe157eu, 0xfe157fu, 0xfe01c6u, 0xfe0287u, 0xfe0145u, 0xfe00e4u,
    0xfe0297u, 0xfe01d6u, 0xfe0368u, 0xfe0369u, 0xfe036au, 0xfe036bu, 0xfe036cu, 0xfe036du, 0xfe036eu, 0xfe036fu, 0xfe150bu, 0xfe0030u, 0xfe00a3u, 0xfe02a7u, 0xfe0072u, 0xfe0155u,
    0xfe01e6u, 0xfe157cu, 0xfe02b7u, 0xfe00f4u, 0xfe3c4eu, 0xfe3c4fu, 0xfe02c7u, 0xfe01f6u, 0xfe0051u, 0xfe0165u, 0xfe02d7u, 0xfe0206u, 0xfe00b3u, 0xfe02e7u, 0xfe0104u, 0xfe0175u,
    0xfe0216u, 0xfe02f7u, 0xfe0378u, 0xfe0379u, 0xfe037au, 0xfe037bu, 0xfe037cu, 0xfe037du, 0xfe037eu, 0xfe037fu, 0xfe0307u, 0xfe0082u, 0xfe1489u, 0xfe0226u, 0xfe28adu, 0xfe28aeu,
    0xfe28afu, 0xfe0185u, 0xfe0317u, 0xfe0114u, 0xfe285bu, 0xfe0236u, 0xfe00c3u, 0xfe0327u, 0xfe0195u, 0xfe0337u, 0xfe0246u, 0xfe0124u, 0xfe0347u, 0xfe0061u, 0xfe0256u, 0xfe01a5u,
    0xfe0040u, 0xfe0357u, 0xfe0092u, 0xfe00d3u, 0xfe0266u, 0xfe0367u, 0xfe501du, 0xfe158cu, 0xfe158du, 0xfe158eu, 0xfe158fu, 0xfe01b5u, 0xfe0134u, 0xfe0377u, 0xfe0276u, 0xfe0388u,
    0xfe0389u, 0xfe038au, 0xfe038bu, 0xfe038cu, 0xfe038du, 0xfe038eu, 0xfe038fu, 0xfe151bu, 0xfe0387u, 0xfe01c5u, 0xfe0286u, 0xfe0144u, 0xfe00e3u, 0xfe0296u, 0xfe01d5u, 0xfe14cau,
    0xfe00a2u, 0xfe02a6u, 0xfe0071u, 0xfe0154u, 0xfe01e5u, 0xfe02b6u, 0xfe00f3u, 0xfe02c6u, 0xfe01f5u, 0xfe0164u, 0xfe02d6u, 0xfe0050u, 0xfe0205u, 0xfe00b2u, 0xfe02e6u, 0xfe0103u,
    0xfe0397u, 0xfe0398u, 0xfe0399u, 0xfe039au, 0xfe039bu, 0xfe039cu, 0xfe039du, 0xfe039eu, 0xfe039fu, 0xfe0174u, 0xfe0215u, 0xfe02f6u, 0xfe1447u, 0xfe0306u, 0xfe0081u, 0xfe0225u,
    0xfe0184u, 0xfe0316u, 0xfe0113u, 0xfe0235u, 0xfe00c2u, 0xfe0326u, 0xfe500cu, 0xfe0194u, 0xfe0336u, 0xfe0245u, 0xfe0346u, 0xfe0123u, 0xfe0255u, 0xfe01a4u, 0xfe0356u, 0xfe3c4du,
    0xfe0060u, 0xfe0091u, 0xfe00d2u, 0xfe0265u, 0xfe0366u, 0xfe01b4u, 0xfe1468u, 0xfe0133u, 0xfe0376u, 0xfe0275u, 0xfe0386u, 0xfe2807u, 0xfe01c4u, 0xfe152bu, 0xfe0285u, 0xfe03a7u,
    0xfe03a8u, 0xfe03a9u, 0xfe03aau, 0xfe03abu, 0xfe03acu, 0xfe03adu, 0xfe03aeu, 0xfe03afu, 0xfe0396u, 0xfe0143u, 0xfe00e2u, 0xfe03a6u, 0xfe0295u, 0xfe01d4u, 0xfe159cu, 0xfe159du,
    0xfe159eu, 0xfe159fu, 0xfe00a1u, 0xfe02a5u, 0xfe0153u, 0xfe01e4u, 0xfe02b5u, 0xfe0070u, 0xfe00f2u, 0xfe02c5u, 0xfe01f4u, 0xfe0163u, 0xfe02d5u, 0xfe0204u, 0xfe00b1u, 0xfe02e5u,
    0xfe0102u, 0xfe0173u, 0xfe0214u, 0xfe02f5u, 0xfe0305u, 0xfe0224u, 0xfe0183u, 0xfe0080u, 0xfe0315u, 0xfe0112u, 0xfe0234u, 0xfe00c1u, 0xfe0325u, 0xfe1499u, 0xfe0193u, 0xfe0335u,
    0xfe03b6u, 0xfe03b7u, 0xfe03b8u, 0xfe03b9u, 0xfe03bau, 0xfe03bbu, 0xfe03bcu, 0xfe03bdu, 0xfe03beu, 0xfe03bfu, 0xfe0244u, 0xfe0345u, 0xfe0122u, 0xfe14dau, 0xfe0254u, 0xfe01a3u,
    0xfe0355u, 0xfe00d1u, 0xfe0264u, 0xfe0365u, 0xfe0090u, 0xfe01b3u, 0xfe0132u, 0xfe0375u, 0xfe0274u, 0xfe0385u, 0xfe01c3u, 0xfe0284u, 0xfe0395u, 0xfe288cu, 0xfe0142u, 0xfe00e1u,
    0xfe03a5u, 0xfe0294u, 0xfe01d3u, 0xfe03b5u, 0xfe02a4u, 0xfe00a0u, 0xfe0152u, 0xfe01e3u, 0xfe02b4u, 0xfe00f1u, 0xfe02c4u, 0xfe01f3u, 0xfe0162u, 0xfe02d4u, 0xfe0203u, 0xfe02e4u,
    0xfe153bu, 0xfe00b0u, 0xfe0101u, 0xfe0172u, 0xfe0213u, 0xfe02f4u, 0xfe0304u, 0xfe0223u, 0xfe0182u, 0xfe03c5u, 0xfe03c6u, 0xfe03c7u, 0xfe03c8u, 0xfe03c9u, 0xfe03cau, 0xfe03cbu,
    0xfe03ccu, 0xfe03cdu, 0xfe03ceu, 0xfe03cfu, 0xfe0314u, 0xfe0111u, 0xfe0233u, 0xfe0324u, 0xfe00c0u, 0xfe0192u, 0xfe0334u, 0xfe0243u, 0xfe0344u, 0xfe0121u, 0xfe0253u, 0xfe01a2u,
    0xfe0354u, 0xfe0364u, 0xfe0263u, 0xfe00d0u, 0xfe01b2u, 0xfe0131u, 0xfe0374u, 0xfe0273u, 0xfe0384u, 0xfe01c2u, 0xfe0283u, 0xfe28bdu, 0xfe28beu, 0xfe28bfu, 0xfe0394u, 0xfe0141u,
    0xfe03a4u, 0xfe0293u, 0xfe00e0u, 0xfe01d2u, 0xfe15acu, 0xfe15adu, 0xfe15aeu, 0xfe15afu, 0xfe03b4u, 0xfe02a3u, 0xfe03c4u, 0xfe0151u, 0xfe01e2u, 0xfe02b3u, 0xfe1436u, 0xfe02c3u,
    0xfe00f0u, 0xfe01f2u, 0xfe0161u, 0xfe02d3u, 0xfe0202u, 0xfe02e3u, 0xfe0171u, 0xfe0100u, 0xfe0212u, 0xfe02f3u, 0xfe0303u, 0xfe0222u, 0xfe0181u, 0xfe0313u, 0xfe0110u, 0xfe0232u,
    0xfe0323u, 0xfe0191u, 0xfe0333u, 0xfe0242u, 0xfe0343u, 0xfe0120u, 0xfe0252u, 0xfe03d4u, 0xfe03d5u, 0xfe03d6u, 0xfe03d7u, 0xfe03d8u, 0xfe03d9u, 0xfe03dau, 0xfe03dbu, 0xfe03dcu,
    0xfe03ddu, 0xfe03deu, 0xfe03dfu, 0xfe01a1u, 0xfe0353u, 0xfe0363u, 0xfe0262u, 0xfe01b1u, 0xfe0373u, 0xfe0130u, 0xfe0272u, 0xfe0383u, 0xfe01c1u, 0xfe0282u, 0xfe0393u, 0xfe03a3u,
    0xfe0140u, 0xfe0292u, 0xfe01d1u, 0xfe03b3u, 0xfe02a2u, 0xfe03c3u, 0xfe01e1u, 0xfe03d3u, 0xfe0150u, 0xfe02b2u, 0xfe1425u, 0xfe02c2u, 0xfe01f1u, 0xfe0160u, 0xfe02d2u, 0xfe0201u,
    0xfe02e2u, 0xfe0170u, 0xfe0211u, 0xfe02f2u, 0xfe0302u, 0xfe0221u, 0xfe0180u, 0xfe0312u, 0xfe0231u, 0xfe0322u, 0xfe0190u, 0xfe0332u, 0xfe0241u, 0xfe0342u, 0xfe0251u, 0xfe01a0u,
    0xfe0352u, 0xfe0362u, 0xfe0261u, 0xfe154bu, 0xfe0372u, 0xfe01b0u, 0xfe14eau, 0xfe0271u, 0xfe0382u, 0xfe0281u, 0xfe0392u, 0xfe01c0u, 0xfe03a2u, 0xfe0291u, 0xfe03b2u, 0xfe01d0u,
    0xfe02a1u, 0xfe03c2u, 0xfe03d2u, 0xfe01e0u, 0xfe02b1u, 0xfe02c1u, 0xfe01f0u, 0xfe02d1u, 0xfe0200u, 0xfe02e1u, 0xfe02f1u, 0xfe0210u, 0xfe0301u, 0xfe0220u, 0xfe0311u, 0xfe0230u,
    0xfe0321u, 0xfe0331u, 0xfe0240u, 0xfe0341u, 0xfe0250u, 0xfe0351u, 0xfe03e2u, 0xfe03e3u, 0xfe03e4u, 0xfe03e5u, 0xfe03e6u, 0xfe03e7u, 0xfe03e8u, 0xfe03e9u, 0xfe03eau, 0xfe03ebu,
    0xfe03ecu, 0xfe03edu, 0xfe03eeu, 0xfe03efu, 0xfe0361u, 0xfe0260u, 0xfe0371u, 0xfe0270u, 0xfe0381u, 0xfe0391u, 0xfe0280u, 0xfe03a1u, 0xfe0290u, 0xfe03b1u, 0xfe02a0u, 0xfe03c1u,
    0xfe03d1u, 0xfe02b0u, 0xfe03e1u, 0xfe02c0u, 0xfe02d0u, 0xfe02e0u, 0xfe02f0u, 0xfe0300u, 0xfe0310u, 0xfe0320u, 0xfe0330u, 0xfe0340u, 0xfe0350u, 0xfe0360u, 0xfe0370u, 0xfe0380u,
    0xfe0390u, 0xfe03a0u, 0xfe03b0u, 0xfe03c0u, 0xfe03d0u, 0xfe03e0u, 0xfe284au, 0xfe14a9u, 0xfe15bcu, 0xfe15bdu, 0xfe15beu, 0xfe15bfu, 0xfe1478u, 0xfe3c1au, 0xfe14fau, 0xfe3c2bu,
    0xfe286bu, 0xfe155bu, 0xfe3c3cu, 0xfe289cu,
};
__device__ __forceinline__ void phase_attn_sel(const bf16* Q, const bf16* K, const bf16* V, const unsigned* lists, const gu32* lc, const float* qn2, bf16* part0, bf16* part12, float* lse, gu32* qctr, LAS unsigned char* lds, const int wave0, bool nostore = false) {
    int tid = wave0 * 64 + mk_lane(); asm volatile("" : "+v"(tid)); const int lane = tid & 63, wave = __builtin_amdgcn_readfirstlane(tid >> 6);
    const int fr = lane & 15, fq = lane >> 4;
    LAS unsigned* cw = (LAS unsigned*)(lds + A_CNT);
    LAS unsigned short* list = (LAS unsigned short*)(lds + A_LIST);
    constexpr int NU = SEL_NU;
    if (tid == 0) { cw[4] = __hip_atomic_fetch_add(qctr, 1u, RLX_AGENT); cw[0] = 0u; cw[1] = 0u; cw[2] = 0u; cw[3] = 0u; }
    __syncthreads();
    int unit = (int)cw[4];
    u32x4 kv[4], vv[4]; int pnt = 0; unsigned pl0 = 0u, pl1 = 0u;
#define SEL_PREFETCH(u_) do { const unsigned te2 = sel_unit_tab[u_]; const int h2 = (int)(te2 & 15u), n2 = (int)((te2 >> 4) & 63u), plo2 = (int)((te2 >> 10) & 127u); \
        kv_load(K, V, n2, h2, kv, vv, tid, wave, lane); pnt = (int)lc[h2 * 64 + n2]; \
        const unsigned* gl2 = lists + (size_t)h2 * LIST_HEAD + list_off(n2) + plo2 * 128; pl0 = gl2[tid]; pl1 = gl2[tid + NWAVES * 64]; } while (0)
    if (unit < NU) SEL_PREFETCH(unit);
    for (int par = 0; unit < NU; par ^= 1) {
        const unsigned te = sel_unit_tab[unit];
        const int h = (int)(te & 15u), n = (int)((te >> 4) & 63u), plo = (int)((te >> 10) & 127u), phi = (int)((te >> 17) & 127u);
        const float slope2 = head_slope2(h);
        const int ntot = pnt, e0 = plo * 128, e1 = phi == 127 ? ntot : min(ntot, phi * 128), N = max(e1 - e0, 0);
        { if (tid < N) list[tid] = (unsigned short)pl0;
          if (tid + NWAVES * 64 < N) list[tid + NWAVES * 64] = (unsigned short)pl1;
          const unsigned* gl = lists + (size_t)h * LIST_HEAD + list_off(n) + e0;
          for (int i = tid + 2 * NWAVES * 64; i < N; i += NWAVES * 64) list[i] = (unsigned short)gl[i]; }
        kv_write<true>(kv, vv, lds, cw + 2 + par, tid, wave, lane, slope2);
        if (tid == 0) { cw[4 + (par ^ 1)] = __hip_atomic_fetch_add(qctr, 1u, RLX_AGENT); cw[2 + (par ^ 1)] = 0u; }
        __syncthreads();
        const int ntiles = (N + 15) >> 4;
        const float kmax2 = __uint_as_float(cw[2 + par]);
        const int nunit = (int)cw[4 + (par ^ 1)];
        int tile = wave; bool valid = false; int t = 0, k = 0; bf16x8 q0 = {}, q1 = {}; float qn = 0.f;
        if (tile < ntiles) { int idx = tile * 16 + fr; valid = idx < N; if (!valid) idx = N - 1; const unsigned e = list[idx]; t = (int)(e & 0x3fffu); k = (int)(e >> 14);
            const bf16* qrow = Q + (size_t)t * D_ + h * 64; q0 = *(const bf16x8*)(qrow + 8 * fq); q1 = *(const bf16x8*)(qrow + 32 + 8 * fq); qn = qn2[(size_t)h * S_ + t]; }
        if (nunit < NU) SEL_PREFETCH(nunit);
        while (tile < ntiles) {
            const int ntile = tile + NWAVES; bool nvalid = false; int nt = 0, nk = 0; bf16x8 nq0 = {}, nq1 = {}; float nqn = 0.f;
            if (ntile < ntiles) { int idx = ntile * 16 + fr; nvalid = idx < N; if (!nvalid) idx = N - 1; const unsigned e = list[idx]; nt = (int)(e & 0x3fffu); nk = (int)(e >> 14);
                const bf16* qrow = Q + (size_t)nt * D_ + h * 64; nq0 = *(const bf16x8*)(qrow + 8 * fq); nq1 = *(const bf16x8*)(qrow + 32 + 8 * fq); nqn = qn2[(size_t)h * S_ + nt]; }
            const float m = __builtin_amdgcn_sqrtf(qn * kmax2) * 1.0005f + 0.01f;
            const float lcm = slope2 * (float)(n * BS + (BS - 1) - t) - m;
            f32x4 o[4]; float l;
            attn_tile<false, true>(lds + A_KS, lds + A_VT, q0, q1, lcm, slope2, 0, 8, fr, fq, o, l, lds + A_WROW);
            const bool lok = l > 1e-30f;
            const float il = lok ? 1.0f / l : 0.f;
            {
                LAS unsigned char* ost = lds + A_OST + wave * (16 * A_OPITCH);
#pragma unroll
                for (int dt = 0; dt < 4; ++dt) { u32x2 w; w.x = cvt_pk_bf16(o[dt][0] * il, o[dt][1] * il); w.y = cvt_pk_bf16(o[dt][2] * il, o[dt][3] * il); *(LAS u32x2*)(ost + fr * A_OPITCH + (16 * dt + 4 * fq) * 2) = w; }
                LDS_WAIT(); asm volatile("" ::: "memory");
#pragma unroll
                for (int i = 0; i < 2; ++i) {
                    const int q = (lane >> 3) + 8 * i, p = lane & 7;
                    const u32x4 v = *(LAS const u32x4*)(ost + q * A_OPITCH + p * 16);
                    const int tq = shi(t, q), kq = shi(k, q), vq = shi((int)valid, q);
                    if (vq && !nostore) *(u32x4*)((kq == 0 ? part0 : part12 + (size_t)(kq - 1) * S_ * D_) + (size_t)tq * D_ + h * 64 + p * 8) = v;
                }
                if (valid && fq == 0) lse[((size_t)k * S_ + t) * NH + h] = lok ? m + __builtin_amdgcn_logf(l) : -INFINITY;
                LDS_WAIT(); asm volatile("" ::: "memory");
            }
            tile = ntile; valid = nvalid; t = nt; k = nk; q0 = nq0; q1 = nq1; qn = nqn;
        }
        __syncthreads();
        unit = nunit;
    }
}
__device__ __forceinline__ void phase_attn_own(bf16* Q, const bf16* K, const bf16* V, const unsigned* sel, const float* qn2, const bf16* part0, const bf16* part12, const float* lse, LAS unsigned char* lds, const int wave0, bool nostore = false) {
    int tid = wave0 * 64 + mk_lane(); asm volatile("" : "+v"(tid)); const int lane = tid & 63, wave = __builtin_amdgcn_readfirstlane(tid >> 6);
    const int fr = lane & 15, fq = lane >> 4;
    LAS unsigned* cw = (LAS unsigned*)(lds + A_CNT);
    if (tid == 0) { cw[2] = 0u; cw[3] = 0u; }
    __syncthreads();
    int par = 0;
    u32x4 kv[4], vv[4];
    { const int u0 = (int)blockIdx.x; kv_load(K, V, u0 >> 4, ((u0 & 15) + 4 * (u0 >> 8)) & 15, kv, vv, tid, wave, lane); }
    for (int unit = blockIdx.x; unit < NBLK * NH; unit += gridDim.x, par ^= 1) {
        const int j = unit >> 4, h = ((unit & 15) + 4 * (unit >> 8)) & 15;
        const int nv = j < 3 ? j : 3;
        bf16x8 qf[2][2]; float qnv[2]; unsigned selv[2];
#pragma unroll
        for (int half = 0; half < 2; ++half) {
            const int t = j * BS + (half ? 15 - wave : wave) * 16 + fr;
            const bf16* qrow = Q + (size_t)t * D_ + h * 64;
            qf[half][0] = *(const bf16x8*)(qrow + 8 * fq); qf[half][1] = *(const bf16x8*)(qrow + 32 + 8 * fq);
            qnv[half] = qn2[(size_t)h * S_ + t];
            selv[half] = nv > 0 ? sel[(size_t)h * S_ + t] : 0xffffffffu;
        }
        kv_write(kv, vv, lds, cw + 2 + par, tid, wave, lane);
        if (tid == 0) cw[2 + (par ^ 1)] = 0u;
        __syncthreads();
        const float kmax2 = __uint_as_float(cw[2 + par]);
        const float slope2 = head_slope2(h);
#pragma unroll
        for (int half = 0; half < 2; ++half) {
            const int tile = half ? 15 - wave : wave;
            const int tq = tile * 16 + fr, t = j * BS + tq;
            const bf16x8 q0 = qf[half][0], q1 = qf[half][1];
            float lk[3]; u32x2 pv[3][4];
            const unsigned selw = selv[half];
#pragma unroll
            for (int k = 0; k < 3; ++k) {
                lk[k] = -INFINITY;
#pragma unroll
                for (int dt = 0; dt < 4; ++dt) pv[k][dt] = (u32x2){0u, 0u};
                if (k < nv && !alibi_dead(slope2, t, (int)((selw >> (8 * k)) & 0xffu))) {
                    lk[k] = lse[((size_t)k * S_ + t) * NH + h];
                    const bf16* pp = (k == 0 ? part0 : part12 + (size_t)(k - 1) * S_ * D_) + (size_t)t * D_ + h * 64 + 4 * fq;
#pragma unroll
                    for (int dt = 0; dt < 4; ++dt) pv[k][dt] = *(const u32x2*)(pp + dt * 16);
                }
            }
            if (half == 0) {
                const int nu = unit + (int)gridDim.x;
                if (nu < NBLK * NH) kv_load(K, V, nu >> 4, ((nu & 15) + 4 * (nu >> 8)) & 15, kv, vv, tid, wave, lane);
            }
            const float m = __builtin_amdgcn_sqrtf(qnv[half] * kmax2) * 1.0005f + 0.01f;
            const float lcm = slope2 * (float)(8 * fq - tq) - m;
            f32x4 o[4]; float l;
            attn_tile<true>(lds + A_KS, lds + A_VT, q0, q1, lcm, slope2, tq, (tile >> 1) + 1, fr, fq, o, l);
            const float lown = m + __builtin_amdgcn_logf(l), il = 1.0f / l;
            const float M = fmaxf(fmaxf(lown, lk[0]), fmaxf(lk[1], lk[2]));
            const float e0 = __builtin_amdgcn_exp2f(lown - M), w0 = e0 * il;
            float wsum = e0;
#pragma unroll
            for (int dt = 0; dt < 4; ++dt) o[dt] = o[dt] * w0;
#pragma unroll
            for (int k = 0; k < 3; ++k) {
                const float wk = __builtin_amdgcn_exp2f(lk[k] - M);
                wsum += wk;
#pragma unroll
                for (int dt = 0; dt < 4; ++dt) { o[dt][0] += wk * bf_lo(pv[k][dt].x); o[dt][1] += wk * bf_hi(pv[k][dt].x); o[dt][2] += wk * bf_lo(pv[k][dt].y); o[dt][3] += wk * bf_hi(pv[k][dt].y); }
            }
            const float inv = 1.0f / wsum;
            {
                LAS unsigned char* ost = lds + A_OST + wave * (16 * A_OPITCH);
#pragma unroll
                for (int dt = 0; dt < 4; ++dt) { u32x2 w; w.x = cvt_pk_bf16(o[dt][0] * inv, o[dt][1] * inv); w.y = cvt_pk_bf16(o[dt][2] * inv, o[dt][3] * inv); *(LAS u32x2*)(ost + fr * A_OPITCH + (16 * dt + 4 * fq) * 2) = w; }
                LDS_WAIT(); asm volatile("" ::: "memory");
#pragma unroll
                for (int i = 0; i < 2; ++i) {
                    const int q = (lane >> 3) + 8 * i, p = lane & 7;
                    const u32x4 v = *(LAS const u32x4*)(ost + q * A_OPITCH + p * 16);
                    if (!nostore) *(u32x4*)(Q + (size_t)(j * BS + tile * 16 + q) * D_ + h * 64 + p * 8) = v;
                }
                LDS_WAIT(); asm volatile("" ::: "memory");
            }
        }
        __syncthreads();
    }
}
__device__ __forceinline__ void phase_quant(const bf16* xb, const float* ssq, unsigned char* xq, float* xs, const int wave0, const int rb0 = -1) {
    int tid = wave0 * 64 + mk_lane(); asm volatile("" : "+v"(tid)); const int lane = tid & 63;
    for (int rb = rb0 >= 0 ? rb0 : (int)blockIdx.x; rb < (rb0 >= 0 ? rb0 + 1 : S_ / 64); rb += gridDim.x) {
        const int row = rb * 64 + (tid >> 3);
        u32x4 v[16];
#pragma unroll
        for (int i = 0; i < 16; ++i) v[i] = *(const u32x4*)(xb + (size_t)row * D_ + i * 64 + (tid & 7) * 8);
        const float rs = row_rstd(ssq, row);
        unsigned am = 0u;
#pragma unroll
        for (int i = 0; i < 16; ++i)
#pragma unroll
            for (int w = 0; w < 4; ++w) { const unsigned ww = v[i][w]; am = max(am, ww & 0x7fffu); am = max(am, (ww >> 16) & 0x7fffu); }
        am = max(am, shxu(am, 1, lane)); am = max(am, shxu(am, 2, lane)); am = max(am, shxu(am, 4, lane));
        const float amax = fmaxf(__uint_as_float(am << 16), 1e-20f), qs = 127.0f / amax;
        if ((tid & 7) == 0) { const float xv = amax * rs * (pg8::I8_IWQ / 127.0f); if (rb0 >= 0) __hip_atomic_store((GAS unsigned*)(xs + row), __float_as_uint(xv), RLX_AGENT); else xs[row] = xv; }
#pragma unroll
        for (int i = 0; i < 16; ++i) {
            unsigned o8[2];
#pragma unroll
            for (int hh = 0; hh < 2; ++hh) {
                const unsigned wa = hh ? v[i].z : v[i].x, wb = hh ? v[i].w : v[i].y;
                const int q0 = (int)__builtin_rintf(bf_lo(wa) * qs), q1 = (int)__builtin_rintf(bf_hi(wa) * qs), q2 = (int)__builtin_rintf(bf_lo(wb) * qs), q3 = (int)__builtin_rintf(bf_hi(wb) * qs);
                o8[hh] = ((unsigned)q0 & 255u) | (((unsigned)q1 & 255u) << 8) | (((unsigned)q2 & 255u) << 16) | (((unsigned)q3 & 255u) << 24);
            }
            if (rb0 >= 0) __hip_atomic_store((GAS unsigned long long*)(xq + (size_t)row * D_ + i * 64 + (tid & 7) * 8), ((unsigned long long)o8[1] << 32) | o8[0], RLX_AGENT);
            else { u32x2 ov; ov.x = o8[0]; ov.y = o8[1]; *(u32x2*)(xq + (size_t)row * D_ + i * 64 + (tid & 7) * 8) = ov; }
        }
    }
}
struct Args { const float* in[10]; float* out; unsigned char* ws; };
typedef const __attribute__((address_space(4))) Args* CArgsP;
__device__ __forceinline__ CArgsP KA() { unsigned long long p = (unsigned long long)__builtin_amdgcn_kernarg_segment_ptr(); asm volatile("" : "+s"(p)); return (CArgsP)p; }
__device__ __forceinline__ Ptrs make_ptrs(CArgsP a) { Ptrs P; P.x = a->in[0]; P.ln = a->in[1]; P.wg = a->in[2]; P.wu = a->in[3]; P.wd = a->in[4]; P.wqkv = a->in[5]; P.wo = a->in[6]; P.pw = a->in[7]; P.ps = a->in[8]; P.fg = a->in[9]; P.out = a->out; P.ws = a->ws; return P; }
__device__ __forceinline__ void phase_tailconv(LAS unsigned char* lds, int f, const int wave0) {
    int tid = wave0 * 64 + mk_lane(); asm volatile("" : "+v"(tid)); const int lane = tid & 63, wave = __builtin_amdgcn_readfirstlane(tid >> 6);
    const Ptrs P = make_ptrs(KA());
    const int ww = ((int)blockIdx.x - 128) * NWAVES + wave, n_ww = 128 * NWAVES;
    convert_items(P, lds, (f + 1) * IT_FFN, (f + 2) * IT_FFN, ww, n_ww, wave, lane);
    if (f == 0) convert_items(P, lds, 8 * IT_FFN + 2 * IT_ATT, IT_TOTAL, ww, n_ww, wave, lane);
    if (f == 2) convert_items(P, lds, 8 * IT_FFN + IT_ATT, 8 * IT_FFN + IT_ATT + IT_ATT / 2, ww, n_ww, wave, lane);
    if (f == 3) convert_items(P, lds, 8 * IT_FFN + IT_ATT + IT_ATT / 2, 8 * IT_FFN + 2 * IT_ATT, ww, n_ww, wave, lane);
}
__global__ void __launch_bounds__(NWAVES * 64, 2) mk_fwd(Args args) {
    extern __shared__ __attribute__((aligned(16))) unsigned char lds_raw[];
    LAS unsigned char* lds = (LAS unsigned char*)lds_raw;
    volatile LAS unsigned* MISC = (volatile LAS unsigned*)(lds + MISC_OFF);
    const int G = gridDim.x;
    gu32* ctl = (gu32*)(KA()->ws + WS_CTL);
    for (int u = threadIdx.x; u < (LDS_BYTES - LDSCTL_OFF) / 4; u += NWAVES * 64) ((LAS unsigned*)(lds + LDSCTL_OFF))[u] = 0u;
    __syncthreads();
    const int wave0 = __builtin_amdgcn_readfirstlane((int)threadIdx.x >> 6);
    XcdBarrier bar = xcd_barrier_post((unsigned*)(ctl + CW_BAR), MISC + 8, wave0 == 0 && mk_lane() == 0);
    (void)bar;
#define GRID_BAR() do { unsigned long long wsl_ = (unsigned long long)KA()->ws; XcdBarrier b_; b_.bar = (unsigned*)(wsl_ + WS_CTL) + CW_BAR; b_.x = xb_xcc_id(); \
        b_.st = (volatile LAS unsigned*)(lds + MISC_OFF) + 8; xcd_barrier(b_, wave0 == 0 && mk_lane() == 0); } while (0)
#define NREP(p) ((PROBE == (p)) ? 2 : 1)
    for (int rep = 0; rep < NREP(5); ++rep) { Ptrs P2 = make_ptrs(KA()); phase_prologue(P2, lds, wave0); GRID_BAR(); }
#define WSL() (KA()->ws)
#pragma clang loop unroll(full)
    for (int f = 0; f < 8; ++f) {
        for (int rep = 0; rep < NREP(3) * NREP(13); ++rep) {
            unsigned char* w = WSL();
            pg8::Gemm g{(const bf16*)(w + WS_XB), ws_wgu(w, f), S_, NGU, D_}; pg8::StaticOrder S; S.init(S_, NGU, G, (int)blockIdx.x);
            if ((I8_MASK >> f) & 1) {
                if (rep == 0 && f != 0) {
                    if (G == 256) {
                        pg8::Unit u0; S.next(0, u0);
                        phase_quant((const bf16*)(w + WS_XB), (const float*)(w + ((f & 3) == 3 ? WS_SSQB : WS_SSQ)), w + WS_XQ, (float*)(w + WS_XS), wave0, u0.pm * 4 + ((int)blockIdx.x >> 6));
                        asm volatile("s_waitcnt vmcnt(0)" ::: "memory");
                        __syncthreads();
                        if (wave0 == 0 && mk_lane() == 0) {
                            gu32* fl = (gu32*)(w + WS_CTL) + CW_RB + 16 * u0.pm + f;
                            __hip_atomic_fetch_add(fl, 1u, RLX_AGENT);
                            unsigned sp = 0u; while (__hip_atomic_load(fl, RLX_AGENT) < 4u) { __builtin_amdgcn_s_sleep(1); if (++sp > (1u << 22)) break; }
                            __builtin_amdgcn_fence(__ATOMIC_ACQUIRE, "agent"); asm volatile("s_waitcnt vmcnt(0)" ::: "memory");
                        }
                        __syncthreads();
                    } else { phase_quant((const bf16*)(w + WS_XB), (const float*)(w + ((f & 3) == 3 ? WS_SSQB : WS_SSQ)), w + WS_XQ, (float*)(w + WS_XS), wave0); GRID_BAR(); }
                }
                rstd_table<pg8::StaticOrder, true>(lds, (const float*)(w + WS_XS), S, wave0); }
            else rstd_table(lds, (const float*)(w + ((f & 3) == 3 ? WS_SSQB : WS_SSQ)), S, wave0);
#define GU_PHASE(EPI) do { EPI E{(bf16*)(w + ((PROBE == 13 && rep == 0) ? WS_END : WS_BIG)), (LAS const float*)(lds + RSTD_OFF), PROBE == 13 && rep == 0}; \
                if ((X8_MASK >> f) & 1) { pg8::Gemm g8 = g; g8.A = (const bf16*)(w + WS_X8); g8.K = D_ / 2; pg8::gemm_phase<EPI, pg8::StaticOrder, PG8_ALIGN, PG8_SP2, true, pg8::F8_SCALE_WGU, pg8::F8_SCALE_X>(lds, g8, S, E, wave0); } \
                else pg8::gemm_phase<EPI, pg8::StaticOrder, PG8_ALIGN, PG8_SP2>(lds, g, S, E, wave0); } while (0)
#define GU_PHASE_I8(EPI) do { EPI E{(bf16*)(w + WS_BIG), (LAS const float*)(lds + RSTD_OFF), 0}; \
                pg8::Gemm g8 = g; g8.A = (const bf16*)(w + WS_XQ); g8.K = D_ / 2; pg8::gemm_phase<EPI, pg8::StaticOrder, PG8_ALIGN, PG8_SP2, false, 0, 0, true>(lds, g8, S, E, wave0); } while (0)
            if ((I8_MASK >> f) & 1) { if ((FP8_MASK >> f) & 1) GU_PHASE_I8(EpiSwiGLU_F8I8); else GU_PHASE_I8(EpiSwiGLU_I8); }
            else if ((FP8_MASK >> f) & 1) GU_PHASE(EpiSwiGLUT<true>); else GU_PHASE(EpiSwiGLU);
#undef GU_PHASE
#undef GU_PHASE_I8
            if (TAILCONV && G == 256 && rep == 0 && f < 7 && blockIdx.x >= 128) phase_tailconv(lds, f, wave0);
            GRID_BAR();
        }
        for (int rep = 0; rep < NREP(4) * NREP(14) * NREP(24) * NREP(25); ++rep) {
            unsigned char* w = WSL();
            pg8::Gemm g{(const bf16*)(w + WS_BIG), ws_wd(w, f), S_, D_, FF_}; pg8::StaticOrder S; S.init(S_, D_, G, (int)blockIdx.x);
            EpiResid<false, 1> E{(bf16*)(w + WS_XB), (float*)(w + WS_SSQ), nullptr, (f & 3) == 2 ? (bf16*)(w + WS_HALO) : nullptr, ((f & 1) && f < 7 && ((X8_MASK >> (f + 1)) & 1)) ? w + WS_X8 : nullptr};
            if ((FP8_MASK >> f) & 1) { pg8::Gemm g8 = g; g8.K = FF_ / 2; pg8::gemm_phase<EpiResid<false, 1>, pg8::StaticOrder, false, PG8_SP2, true>(lds, g8, S, E, wave0); }
            else pg8::gemm_phase<EpiResid<false, 1>, pg8::StaticOrder, false, PG8_SP2>(lds, g, S, E, wave0);
            GRID_BAR();
        }
        if ((f & 1) == 0) {
            const int L = f >> 1, mi = L >> 1;
            if ((L & 1) == 0) {
                for (int rep = 0; rep < NREP(6); ++rep) {
                    unsigned char* w = WSL();
                    pg8::Gemm g{(const bf16*)(w + WS_XB), ws_wqkv(w, mi), S_, 3 * D_, D_}; pg8::StaticOrder S; S.init(S_, 3 * D_, G, (int)blockIdx.x);
                    rstd_table(lds, (const float*)(w + WS_SSQ), S, wave0);
                    EpiQKV E{(bf16*)(w + WS_BIG), (LAS const float*)(lds + RSTD_OFF), (float*)(w + WS_KPART)};
                    pg8::gemm_phase<EpiQKV, pg8::StaticOrder, PG8_ALIGN, PG8_SP2>(lds, g, S, E, wave0);
                    GRID_BAR();
                }
                for (int rep = 0; rep < NREP(1); ++rep) {
                    for (int r2 = 0; r2 < NREP(7); ++r2) { unsigned char* w = WSL(); phase_gate((const bf16*)(w + WS_BIG), (const float*)(w + WS_KPART), (unsigned*)(w + WS_SEL), (float*)(w + WS_QN2), (unsigned*)(w + WS_WFFN + (size_t)(mi == 0 ? 4 : 2) * WFFN_STRIDE), (gu32*)(w + WS_CTL) + CW_LC + 1024 * mi, lds, wave0); GRID_BAR(); }
                    for (int r2 = 0; r2 < NREP(8) * NREP(18) * NREP(28) * NREP(29); ++r2) { unsigned char* w = WSL(); bf16* B = (bf16*)(w + WS_BIG);
                      phase_attn_sel(B, B + (size_t)S_ * D_, B + (size_t)2 * S_ * D_, (const unsigned*)(w + WS_WFFN + (size_t)(mi == 0 ? 4 : 2) * WFFN_STRIDE), (const gu32*)(w + WS_CTL) + CW_LC + 1024 * mi, (const float*)(w + WS_QN2), (bf16*)(w + WS_WFFN + (size_t)(mi == 0 ? 2 : 0) * WFFN_STRIDE), (bf16*)(w + WS_XB + 32 * MiB), (float*)(w + WS_LSE), (gu32*)(w + WS_CTL) + CW_QA + 64 * (mi + 2 * (rep + r2)), lds, wave0, (PROBE == 18 || PROBE == 28 || PROBE == 29) && r2 == 0 && ((const unsigned*)(w + WS_CTL))[2] == 0u);
                      GRID_BAR(); }
                    for (int r2 = 0; r2 < NREP(9); ++r2) { unsigned char* w = WSL(); bf16* B = (bf16*)(w + WS_BIG);
                      phase_attn_own(B, B + (size_t)S_ * D_, B + (size_t)2 * S_ * D_, (const unsigned*)(w + WS_SEL), (const float*)(w + WS_QN2), (const bf16*)(w + WS_WFFN + (size_t)(mi == 0 ? 2 : 0) * WFFN_STRIDE), (const bf16*)(w + WS_XB + 32 * MiB), (const float*)(w + WS_LSE), lds, wave0, (rep + r2 + 1) < NREP(1) * NREP(9));
                      GRID_BAR(); }
                }
                for (int rep = 0; rep < NREP(6); ++rep) {
                    unsigned char* w = WSL();
                    pg8::Gemm g{(const bf16*)(w + WS_BIG), ws_wo(w, mi), S_, D_, D_}; pg8::StaticOrder S; S.init(S_, D_, G, (int)blockIdx.x);
                    EpiResid<false, 2> E{(bf16*)(w + WS_XB), (float*)(w + WS_SSQ), nullptr, nullptr, ((X8_MASK >> (f + 1)) & 1) ? w + WS_X8 : nullptr};
                    pg8::gemm_phase<EpiResid<false, 2>, pg8::StaticOrder, false, PG8_SP2>(lds, g, S, E, wave0);
                    GRID_BAR();
                }
            } else {
                for (int rep = 0; rep < NREP(2); ++rep) {
                    { unsigned char* w = WSL(); phase_pool_elem((const bf16*)(w + WS_XB), (const float*)(w + WS_SSQ), KA()->in[1] + (L * 3 + 1) * D_, (bf16*)(w + WS_BIG), (const bf16*)(w + WS_HALO), lds, wave0); }
                    {
                        unsigned char* w = WSL();
                        pg8::Gemm g{(const bf16*)(w + WS_BIG), ws_wp(w, mi), 4 * S_, 256, 256}; PoolOrder S{G, (int)blockIdx.x};
                        if ((X8_MASK >> (f + 1)) & 1) { EpiResid<true, 2, true> E{(bf16*)(w + WS_XB), (float*)(w + WS_SSQB), KA()->in[8] + mi * D_, nullptr, w + WS_X8};
                            pg8::gemm_phase<EpiResid<true, 2, true>, PoolOrder, false, PG8_SP2>(lds, g, S, E, wave0); }
                        else { EpiResid<true, 2, false> E{(bf16*)(w + WS_XB), (float*)(w + WS_SSQB), KA()->in[8] + mi * D_, nullptr, nullptr};
                            pg8::gemm_phase<EpiResid<true, 2, false>, PoolOrder, false, PG8_SP2>(lds, g, S, E, wave0); }
                    }
                    GRID_BAR();
                }
            }
        }
    }
    { Ptrs P2 = make_ptrs(KA()); const bool poison = (__hip_atomic_load((gu32*)(P2.ws + WS_CTL) + CW_BAR + XB_TMO, RLX_AGENT) != 0u) || (G != 256);
      phase_final(P2, poison, wave0); }
}

extern "C" void kernel_launch(void* const* d_in, const int* in_sizes, int n_in, void* d_out, int out_size, void* d_ws, size_t ws_size, hipStream_t stream) {
    static int grid = 0;
    if (grid == 0) {
        if (n_in != 10 || in_sizes[0] != S_ * D_ || out_size != S_ * D_ || ws_size < WS_END) { fprintf(stderr, "kernel_launch: unexpected shapes / workspace (%zu < %zu)\n", ws_size, (size_t)WS_END); grid = -1; return; }
        int dev = 0, cus = 0, per_cu = 0;
        if (hipGetDevice(&dev) != hipSuccess || hipDeviceGetAttribute(&cus, hipDeviceAttributeMultiprocessorCount, dev) != hipSuccess) { grid = -1; return; }
        if (hipFuncSetAttribute((const void*)mk_fwd, hipFuncAttributeMaxDynamicSharedMemorySize, LDS_BYTES) != hipSuccess) { fprintf(stderr, "kernel_launch: hipFuncSetAttribute failed\n"); grid = -1; return; }
        if (hipOccupancyMaxActiveBlocksPerMultiprocessor(&per_cu, (const void*)mk_fwd, NWAVES * 64, LDS_BYTES) != hipSuccess || per_cu < 1) { fprintf(stderr, "kernel_launch: occupancy query says %d\n", per_cu); }
        (void)hipGetLastError();
        grid = cus;
    }
    if (grid < 0) return;
    if (hipMemsetAsync((char*)d_ws + WS_CTL, 0, CTL_ZERO_BYTES, stream) != hipSuccess) return;
    Args a{};
    for (int i = 0; i < 10; ++i) a.in[i] = (const float*)d_in[i];
    a.out = (float*)d_out; a.ws = (unsigned char*)d_ws;
    hipLaunchKernelGGL(mk_fwd, dim3(grid), dim3(NWAVES * 64), LDS_BYTES, stream, a);
}
```

```cpp
#include <hip/hip_runtime.h>
#include <cstdio>
#include <cstdint>
#include <type_traits>
__device__ __forceinline__ float shx(float v, int mask, int lane) { return __builtin_bit_cast(float, __builtin_amdgcn_ds_bpermute((lane ^ mask) << 2, __builtin_bit_cast(int, v))); }
__device__ __forceinline__ unsigned shxu(unsigned v, int mask, int lane) { return (unsigned)__builtin_amdgcn_ds_bpermute((lane ^ mask) << 2, (int)v); }
__device__ __forceinline__ int shi(int v, int src) { return __builtin_amdgcn_ds_bpermute(src << 2, v); }
__device__ __forceinline__ int mk_lane() { int l; asm volatile("v_mbcnt_lo_u32_b32 %0, -1, 0\n\tv_mbcnt_hi_u32_b32 %0, -1, %0" : "=v"(l)); return l; }
namespace pg8 {
#define PG8_LAS __attribute__((address_space(3)))
typedef unsigned short bf16_t;
typedef short bf16x8 __attribute__((ext_vector_type(8)));
typedef float f32x4 __attribute__((ext_vector_type(4)));
typedef unsigned u32x4 __attribute__((ext_vector_type(4)));
typedef int i32x4 __attribute__((ext_vector_type(4)));
typedef int i32x8 __attribute__((ext_vector_type(8)));
constexpr int F8_SCALE_H = 0x7c7c7c7c, F8_SCALE_W = 0x76767676;
constexpr int F8_SCALE_X = 0x7c7c7c7c, F8_SCALE_WGU = 0x77777777;
constexpr float I8_WQ = 127.0f * 32.0f / 3.9f, I8_IWQ = 1.0f / I8_WQ;
constexpr int BM = 256, BK = 64, HALF = 128, HTB = HALF * BK * 2  , STAGE_BYTES = 8 * HTB, NXCD = 8, WGM = 8;

__host__ __device__ __forceinline__ int lds_byte(int r, int c) { const int st = (r >> 4) * 2 + (c >> 5), rr = r & 15, cc = c & 31, ob = rr * 64 + cc * 2; return st * 1024 + (ob ^ (((ob >> 9) & 1) << 5)); }
__host__ __device__ __forceinline__ void stage_rc(int b, int& R, int& C) { const int st = b / 1024, sb = b % 1024, swz = sb ^ (((sb >> 9) & 1) << 5); R = (st >> 1) * 16 + swz / 64; C = (st & 1) * 32 + (swz % 64) / 2; }
__host__ __device__ __forceinline__ int perm32(int rho) { const int n = rho >> 4, i = rho & 15; return 8 * (i >> 2) + 4 * n + (i & 3); }

struct Unit { int pm, pn, idx; };
struct Gemm { const bf16_t* A; const bf16_t* Bt; int M, N, K; };

struct StaticOrder {
    int nM, nN, nwg, G, c;
    __host__ __device__ __forceinline__ void init(int M, int N, int G_, int c_) { nM = M / BM; nN = N / BM; nwg = nM * nN; G = G_; c = c_; }
    __host__ __device__ __forceinline__ bool next(int i, Unit& u) const {
        const long L = (long)i * G + c; if (L >= nwg) return false;
        int wgid = (int)L; { const int q = nwg / NXCD, r = nwg % NXCD, xcd = wgid % NXCD, off = wgid / NXCD; wgid = (xcd < r ? xcd * (q + 1) : r * (q + 1) + (xcd - r) * q) + off; }
        const int nig = WGM * nN, gid = wgid / nig, fm = gid * WGM, gsz = (nM - fm) < WGM ? (nM - fm) : WGM;
        u.pm = fm + ((wgid % nig) % gsz); u.pn = (wgid % nig) / gsz; u.idx = i; return true;
    }
    __device__ __forceinline__ void a_ready(const Unit&) const {}
    __device__ __forceinline__ void done(const Unit&) const {}
};

__device__ __forceinline__ unsigned cvt_pk_bf16(float lo, float hi) { unsigned r; asm volatile("v_cvt_pk_bf16_f32 %0, %1, %2" : "=v"(r) : "v"(lo), "v"(hi)); return r; }
typedef float f32x2 __attribute__((ext_vector_type(2)));
template <class Epi, class Sched, bool ALIGN_EPI = false, bool SP2 = false, bool FP8 = false, int SW = F8_SCALE_W, int SH = F8_SCALE_H, bool I8 = false>
__device__ __forceinline__ void gemm_phase(PG8_LAS unsigned char* lds, const Gemm g, const Sched& S, const Epi& E, const int wave0) {
    int tid_ = wave0 * 64 + mk_lane(); asm volatile("" : "+v"(tid_));
    const int tid = tid_, wid = __builtin_amdgcn_readfirstlane(tid >> 6), lane = tid & 63, wr = wid >> 2, wc = wid & 3, fr = lane & 15, fq = lane >> 4;
    const int K = g.K, nt = K / BK;
    unsigned voffA[2], voffB[2];
#pragma unroll
    for (int i = 0; i < 2; ++i) { int R, C; stage_rc(tid * 16 + i * 8192, R, C); const int Rb = Epi::PERM ? ((R & ~31) + perm32(R & 31)) : R;
        voffA[i] = (unsigned)(R * K + C) * 2u; voffB[i] = (unsigned)(Rb * K + C) * 2u; }
    const size_t kstep = (size_t)(BK * 2);
    const size_t hstep = (size_t)HALF * K * 2;
    const size_t tstep = 2 * hstep;
    const unsigned ldsw = (unsigned)wid * 1024u;
    const int aoff = lds_byte(wr * 64 + fr, fq * 8), boff = lds_byte(wc * 32 + fr, fq * 8);
#define PG8_SA(b, h) (((b) * 2 + (h)) * HTB)
#define PG8_SB(b, h) ((4 + (b) * 2 + (h)) * HTB)
#define PG8_STAGE(bufoff, gbase, voff) do { _Pragma("unroll") for (int _i = 0; _i < 2; ++_i) \
        __builtin_amdgcn_global_load_lds((const unsigned*)((const char*)(gbase) + (voff)[_i]), (PG8_LAS unsigned*)(lds + (bufoff) + ldsw + _i * 8192), 16, 0, 0); } while (0)
#define PG8_LDA(dst, b, h) do { _Pragma("unroll") for (int m = 0; m < 4; ++m) { if constexpr (FP8) { dst##8[m].lo = *(const PG8_LAS i32x4*)(lds + PG8_SA(b, h) + aoff + m * 2048); dst##8[m].hi = *(const PG8_LAS i32x4*)(lds + PG8_SA(b, h) + aoff + m * 2048 + 1024); } \
        else { _Pragma("unroll") for (int k = 0; k < 2; ++k) dst[m][k] = *(const PG8_LAS bf16x8*)(lds + PG8_SA(b, h) + aoff + m * 2048 + k * 1024); } } } while (0)
#define PG8_LDB(dst, b, h) do { _Pragma("unroll") for (int n = 0; n < 2; ++n) { if constexpr (FP8) { dst##8[n].lo = *(const PG8_LAS i32x4*)(lds + PG8_SB(b, h) + boff + n * 2048); dst##8[n].hi = *(const PG8_LAS i32x4*)(lds + PG8_SB(b, h) + boff + n * 2048 + 1024); } \
        else { _Pragma("unroll") for (int k = 0; k < 2; ++k) dst[n][k] = *(const PG8_LAS bf16x8*)(lds + PG8_SB(b, h) + boff + n * 2048 + k * 1024); } } } while (0)
#define PG8_MMA(ai, bj, At, Bt) do { __builtin_amdgcn_s_setprio(1); _Pragma("unroll") for (int m = 0; m < 4; ++m) _Pragma("unroll") for (int n = 0; n < 2; ++n) { \
        if constexpr (FP8) asm volatile("v_mfma_scale_f32_16x16x128_f8f6f4 %0, %1, %2, %0, %3, %4 op_sel_hi:[0,0,0]" : "+v"(acc[ai][bj][m][n]) : "v"(Bt##8[n]), "v"(At##8[m]), "v"(f8sw), "v"(f8sh)); \
        else if constexpr (I8) { _Pragma("unroll") for (int k = 0; k < 2; ++k) acc[ai][bj][m][n] = __builtin_bit_cast(f32x4, __builtin_amdgcn_mfma_i32_16x16x64_i8(__builtin_bit_cast(i32x4, Bt[n][k]), __builtin_bit_cast(i32x4, At[m][k]), __builtin_bit_cast(i32x4, acc[ai][bj][m][n]), 0, 0, 0)); } \
        else { _Pragma("unroll") for (int k = 0; k < 2; ++k) acc[ai][bj][m][n] = __builtin_amdgcn_mfma_f32_16x16x32_bf16(Bt[n][k], At[m][k], acc[ai][bj][m][n], 0, 0, 0); } } \
        __builtin_amdgcn_s_setprio(0); } while (0)
#define PG8_WAIT_V(n) asm volatile("s_waitcnt vmcnt(" #n ")" ::: "memory")
#define PG8_WAIT_L(n) asm volatile("s_waitcnt lgkmcnt(" #n ")" ::: "memory")
#define PG8_BAR __builtin_amdgcn_s_barrier()
#define PG8_SCHED __builtin_amdgcn_sched_barrier(0)
    Unit cur, nxt; int ui = 0;
    if (!S.next(0, cur)) return;
    f32x4 acc[2][2][4][2];
    typename Epi::Pre pre;
    if constexpr (Epi::PRELOAD) E.pre_issue(pre, cur, wr, wc, fr, fq);
    else {
#pragma unroll
    for (int a = 0; a < 2; ++a)
#pragma unroll
        for (int b = 0; b < 2; ++b)
#pragma unroll
            for (int m = 0; m < 4; ++m)
#pragma unroll
                for (int n = 0; n < 2; ++n) acc[a][b][m][n] = (f32x4){0.f, 0.f, 0.f, 0.f};
    }
    bf16x8 At[4][2], B0[2][2], B1[2][2]; i32x8 At8[4], B08[2], B18[2];
    int f8sw = SW, f8sh = SH; if constexpr (FP8) asm volatile("" : "+v"(f8sw), "+v"(f8sh));
    const char* cA = (const char*)g.A + (size_t)cur.pm * tstep; const char* cB = (const char*)g.Bt + (size_t)cur.pn * tstep;
    S.a_ready(cur);
    if constexpr (SP2) {
        PG8_STAGE(PG8_SB(0, 0), cB, voffB); PG8_STAGE(PG8_SB(0, 1), cB + hstep, voffB); PG8_STAGE(PG8_SA(0, 0), cA, voffA); PG8_STAGE(PG8_SA(0, 1), cA + hstep, voffA);
        if constexpr (Epi::PRELOAD) E.pre_finish(acc, pre);
        if (wr == 1) PG8_BAR;
        PG8_WAIT_V(2); PG8_BAR;
        PG8_STAGE(PG8_SB(1, 0), cB + kstep, voffB); PG8_STAGE(PG8_SA(1, 0), cA + kstep, voffA); PG8_STAGE(PG8_SB(1, 1), cB + hstep + kstep, voffB);
        PG8_WAIT_V(6); PG8_BAR;
    } else {
        PG8_STAGE(PG8_SB(0, 0), cB, voffB); PG8_STAGE(PG8_SA(0, 0), cA, voffA); PG8_STAGE(PG8_SB(0, 1), cB + hstep, voffB); PG8_STAGE(PG8_SA(0, 1), cA + hstep, voffA);
        if constexpr (Epi::PRELOAD) E.pre_finish(acc, pre);
        if (wr == 1) PG8_BAR;
        PG8_WAIT_V(4); PG8_BAR;
        PG8_STAGE(PG8_SB(1, 0), cB + kstep, voffB); PG8_STAGE(PG8_SA(1, 0), cA + kstep, voffA); PG8_STAGE(PG8_SB(1, 1), cB + hstep + kstep, voffB);
        PG8_WAIT_V(6); PG8_BAR;
    }
    for (;;) {
        const bool has_next = S.next(ui + 1, nxt);
        const char* nA = has_next ? (const char*)g.A + (size_t)nxt.pm * tstep : cA; const char* nB = has_next ? (const char*)g.Bt + (size_t)nxt.pn * tstep : cB;
        for (int t = 0; t < nt; t += 2) {
            const bool last = (t == nt - 2);
            const char* a1 = cA + (size_t)(t + 1) * kstep;
            const char* a2 = last ? nA : cA + (size_t)(t + 2) * kstep; const char* b2 = last ? nB : cB + (size_t)(t + 2) * kstep;
            const char* a3 = a2 + kstep; const char* b3 = b2 + kstep;
            if (last && has_next) S.a_ready(nxt);
            if constexpr (SP2) {
            PG8_LDB(B0, 0, 0); PG8_LDB(B1, 0, 1); PG8_SCHED; PG8_LDA(At, 0, 0); PG8_STAGE(PG8_SA(1, 1), a1 + hstep, voffA);
            PG8_WAIT_V(8); PG8_WAIT_L(0); PG8_BAR; PG8_MMA(0, 0, At, B0); PG8_MMA(0, 1, At, B1); PG8_BAR; PG8_SCHED;
            PG8_LDA(At, 0, 1); PG8_STAGE(PG8_SB(0, 0), b2, voffB); PG8_STAGE(PG8_SB(0, 1), b2 + hstep, voffB); PG8_STAGE(PG8_SA(0, 0), a2, voffA);
            PG8_WAIT_V(8); PG8_WAIT_L(0); PG8_BAR; PG8_MMA(1, 0, At, B0); PG8_MMA(1, 1, At, B1); PG8_BAR; PG8_SCHED;
            PG8_LDB(B0, 1, 0); PG8_LDB(B1, 1, 1); PG8_SCHED; PG8_LDA(At, 1, 0); PG8_STAGE(PG8_SA(0, 1), a2 + hstep, voffA);
            PG8_WAIT_V(8); PG8_WAIT_L(0); PG8_BAR; PG8_MMA(0, 0, At, B0); PG8_MMA(0, 1, At, B1); PG8_BAR; PG8_SCHED;
            PG8_LDA(At, 1, 1); PG8_STAGE(PG8_SB(1, 0), b3, voffB); PG8_STAGE(PG8_SB(1, 1), b3 + hstep, voffB); PG8_STAGE(PG8_SA(1, 0), a3, voffA);
            PG8_WAIT_V(8); PG8_WAIT_L(0); PG8_BAR; PG8_MMA(1, 0, At, B0); PG8_MMA(1, 1, At, B1); PG8_BAR; PG8_SCHED;
            } else {
            PG8_LDB(B0, 0, 0); PG8_SCHED; PG8_LDA(At, 0, 0); PG8_STAGE(PG8_SA(1, 1), a1 + hstep, voffA);
            PG8_WAIT_L(8); PG8_BAR; PG8_WAIT_L(0); PG8_MMA(0, 0, At, B0); PG8_BAR; PG8_SCHED;
            PG8_LDB(B1, 0, 1); PG8_STAGE(PG8_SB(0, 0), b2, voffB);
            PG8_BAR; PG8_WAIT_L(0); PG8_MMA(0, 1, At, B1); PG8_BAR;
            PG8_LDA(At, 0, 1); PG8_STAGE(PG8_SA(0, 0), a2, voffA);
            PG8_BAR; PG8_WAIT_L(0); PG8_MMA(1, 0, At, B0); PG8_BAR; PG8_SCHED;
            PG8_STAGE(PG8_SB(0, 1), b2 + hstep, voffB);
            PG8_WAIT_V(6); PG8_BAR; PG8_MMA(1, 1, At, B1); PG8_BAR;
            PG8_LDB(B0, 1, 0); PG8_SCHED; PG8_LDA(At, 1, 0); PG8_STAGE(PG8_SA(0, 1), a2 + hstep, voffA);
            PG8_WAIT_L(8); PG8_BAR; PG8_WAIT_L(0); PG8_MMA(0, 0, At, B0); PG8_BAR; PG8_SCHED;
            PG8_LDB(B1, 1, 1); PG8_STAGE(PG8_SB(1, 0), b3, voffB);
            PG8_BAR; PG8_WAIT_L(0); PG8_MMA(0, 1, At, B1); PG8_BAR;
            PG8_LDA(At, 1, 1); PG8_STAGE(PG8_SA(1, 0), a3, voffA);
            PG8_BAR; PG8_WAIT_L(0); PG8_MMA(1, 0, At, B0); PG8_BAR; PG8_SCHED;
            PG8_STAGE(PG8_SB(1, 1), b3 + hstep, voffB);
            PG8_WAIT_V(6); PG8_BAR; PG8_MMA(1, 1, At, B1); PG8_BAR;
            }
        }
        if constexpr (FP8) asm volatile("s_nop 15\n\ts_nop 15" ::: "memory");
        if constexpr (ALIGN_EPI) { if (wr == 0) PG8_BAR; }
        if constexpr (!Epi::AFTER_DRAIN) { E(acc, cur, wr, wc, fr, fq); S.done(cur); }
        if (!has_next) break;
        if constexpr (Epi::PRELOAD) { typename Epi::Pre pre2; E.pre_issue(pre2, nxt, wr, wc, fr, fq); E.pre_finish(acc, pre2); }
        else {
#pragma unroll
        for (int a = 0; a < 2; ++a)
#pragma unroll
            for (int b = 0; b < 2; ++b)
#pragma unroll
                for (int m = 0; m < 4; ++m)
#pragma unroll
                    for (int n = 0; n < 2; ++n) acc[a][b][m][n] = (f32x4){0.f, 0.f, 0.f, 0.f};
        }
        cur = nxt; cA = nA; cB = nB; ++ui;
        if constexpr (ALIGN_EPI) { if (wr == 1) PG8_BAR; }
    }
    PG8_WAIT_V(0);
    if constexpr (!ALIGN_EPI) { if (wr == 0) PG8_BAR; }
    PG8_BAR;
    if constexpr (Epi::AFTER_DRAIN) { E.fused(acc, cur, wr, wc, fr, fq, lds, wid, lane); S.done(cur); }
#undef PG8_SA
#undef PG8_SB
#undef PG8_STAGE
#undef PG8_LDA
#undef PG8_LDB
#undef PG8_MMA
#undef PG8_WAIT_V
#undef PG8_WAIT_L
#undef PG8_BAR
#undef PG8_SCHED
}
}

#ifndef PROBE
#define PROBE 0
#endif
#ifndef I8_MASK
#define I8_MASK 0xFF
#endif
#ifndef X8_MASK
#define X8_MASK 0x00
#endif
#ifndef FP8_MASK
#define FP8_MASK 0xF8
#endif
#ifndef PG8_SP2
#define PG8_SP2 true
#endif
#ifndef PG8_ALIGN
#define PG8_ALIGN true
#endif

#define GAS __attribute__((address_space(1)))
#define LAS __attribute__((address_space(3)))
typedef unsigned short bf16;
typedef pg8::f32x4 f32x4;
typedef pg8::f32x2 f32x2;
typedef pg8::u32x4 u32x4;
typedef pg8::bf16x8 bf16x8;
typedef unsigned u32x2 __attribute__((ext_vector_type(2)));
typedef GAS unsigned gu32;
#define RLX_AGENT __ATOMIC_RELAXED, __HIP_MEMORY_SCOPE_AGENT
#define LDS_WAIT() asm volatile("s_waitcnt lgkmcnt(0)" ::: "memory")
#define VM_WAIT() asm volatile("s_waitcnt vmcnt(0)" ::: "memory")
using pg8::cvt_pk_bf16;

constexpr int S_ = 16384, D_ = 1024, FF_ = 2816, NGU = 2 * FF_, NH = 16, HD = 64, NBLK = 64, BS = 256;
constexpr int NWAVES = 8;
constexpr float EPS = 1e-6f, LOG2E = 1.4426950408889634f;

constexpr size_t MiB = 1u << 20;
constexpr size_t WS_CTL = 0, CTL_ZERO_BYTES = 64 * 1024;
constexpr size_t WS_SSQ = 1 * MiB;
constexpr size_t WS_KPART = 2 * MiB;
constexpr size_t WS_SEL = 3 * MiB;
constexpr size_t WS_LSE = 4 * MiB;
constexpr size_t WS_QN2 = 348 * MiB;
constexpr size_t WS_WP = 7 * MiB;
constexpr size_t WS_WATT = 8 * MiB, WATT_STRIDE = 8 * MiB, WATT_WO = 6 * MiB;
constexpr size_t WS_WFFN = 24 * MiB, WFFN_STRIDE = 17301504, WFFN_WD = 11 * MiB;
constexpr size_t WS_XB = 156 * MiB;
constexpr size_t WS_BIG = 252 * MiB;
constexpr size_t WS_HALO = 349 * MiB;
constexpr size_t WS_SSQB = 351 * MiB;
constexpr size_t WS_XS = 352 * MiB;
constexpr size_t WS_END = 352 * MiB + 65536;
static_assert(WS_WFFN + 8 * WFFN_STRIDE == WS_XB, "ws map");
constexpr size_t WS_X8 = WS_WFFN + 4 * WFFN_STRIDE;
static_assert((X8_MASK & 0x1f) == 0 && (X8_MASK & I8_MASK) == 0, "x8 copy region");
constexpr size_t WS_XQ = WS_XB + 32 * MiB;
constexpr int CW_RB = 12288;
constexpr int CW_BAR = 4096, CW_QA = 8192, CW_LC = 10240;
static_assert((CW_RB + 64 * 16) * 4 <= (int)CTL_ZERO_BYTES && CW_LC + 2 * 1024 <= CW_RB && (CW_LC + 2 * 1024) * 4 <= (int)CTL_ZERO_BYTES && CW_QA + 64 * 16 <= CW_LC, "list counters inside the memset region");
constexpr int LIST_HEAD = 256 * 2016;
__host__ __device__ __forceinline__ int list_off(int n) { return 256 * (63 * n - ((n * (n - 1)) >> 1)); }
static_assert((CW_QA + 64 * 16) * 4 <= (int)CTL_ZERO_BYTES && (CW_BAR + 3456) <= CW_QA, "control words inside the memset region");

constexpr int RING_BYTES = 131072, LDSCTL_OFF = RING_BYTES, MISC_OFF = LDSCTL_OFF + 320, RSTD_OFF = MISC_OFF + 128, LDS_BYTES = 147456;
static_assert(RSTD_OFF + 6 * 1024 <= LDS_BYTES, "LDS map");
constexpr int A_KS = 0, A_VT = 32768, A_LIST = 65536, A_CNT = A_LIST + 32768, A_OST = A_CNT + 256, A_OPITCH = 144;
constexpr int A_WROW = A_OST + 8 * 16 * A_OPITCH;
static_assert(A_WROW + 512 <= RING_BYTES, "attention LDS");

#define XB_TMO      128
#define XB_XCNT(j)  (256  + 64 * (j))
#define XB_XSUB(j)  (1280 + 64 * (j))
#define XB_XGEN(j)  (2304 + 64 * (j))
#define XB_TOP      3328
#define XB_TOPGEN   3392
#define XCD_BAR_WORDS 3456
#define XB_SPIN_CAP (1u << 18)

__device__ __forceinline__ unsigned xb_ld(unsigned* p)              { return __hip_atomic_load(p, __ATOMIC_RELAXED, __HIP_MEMORY_SCOPE_AGENT); }
__device__ __forceinline__ unsigned xb_add(unsigned* p, unsigned v) { return __hip_atomic_fetch_add(p, v, __ATOMIC_RELAXED, __HIP_MEMORY_SCOPE_AGENT); }
__device__ __forceinline__ unsigned xb_xcc_id() { return (unsigned)__builtin_amdgcn_s_getreg((3 << 11) | 20) & 0xFu; }
#define XB_SPIN(cond, bar) do { unsigned _sp = 0; while (cond) { __builtin_amdgcn_s_sleep(1); \
    if ((++_sp & 255u) == 0u) { if (xb_ld(&(bar)[XB_TMO])) break; if (_sp > XB_SPIN_CAP) { atomicAdd(&(bar)[XB_TMO], 1u); break; } } } } while (0)

struct XcdBarrier {
    unsigned* bar; unsigned x;
    volatile LAS unsigned* st;
};

__device__ __forceinline__ XcdBarrier xcd_barrier_post(unsigned* bar, volatile LAS unsigned* st, const bool thread0) {
    XcdBarrier b; b.bar = bar; b.x = xb_xcc_id(); b.st = st;
    if (thread0) (void)xb_add(&bar[XB_XCNT(b.x)], 1u);
    return b;
}
__device__ __forceinline__ void xcd_barrier_complete(unsigned* bar, unsigned x, unsigned& nloc, unsigned& nx) {
    const unsigned G = gridDim.x * gridDim.y * gridDim.z;
    unsigned sum, cnt, mine, sp = 0u;
    for (;;) {
        sum = 0u; cnt = 0u; mine = 0u;
#pragma unroll
        for (unsigned j = 0; j < 16; ++j) { const unsigned c = xb_ld(&bar[XB_XCNT(j)]); sum += c; cnt += (c > 0u) ? 1u : 0u; mine = (j == x) ? c : mine; }
        if (sum == G) break;
        __builtin_amdgcn_s_sleep(1);
        if ((++sp & 255u) == 0u) { if (xb_ld(&bar[XB_TMO])) break; if (sp > XB_SPIN_CAP) { atomicAdd(&bar[XB_TMO], 1u); break; } }
    }
    nloc = mine > 0u ? mine : 1u; nx = cnt > 0u ? cnt : 1u;
}

__device__ __forceinline__ void xcd_barrier(const XcdBarrier& b, const bool thread0) {
    asm volatile("s_waitcnt vmcnt(0)" ::: "memory");
    __syncthreads();
    if (thread0) {
        unsigned* bar = b.bar;
        __builtin_amdgcn_s_waitcnt(0);
        unsigned nloc = b.st[0], nx = b.st[1];
        if (nloc == 0u) { xcd_barrier_complete(bar, b.x, nloc, nx); b.st[0] = nloc; b.st[1] = nx; }
        const unsigned old = xb_add(&bar[XB_XSUB(b.x)], 1u);
        const unsigned gen = old / nloc;
        if (old + 1u == (gen + 1u) * nloc) {
            __builtin_amdgcn_fence(__ATOMIC_RELEASE, "agent");
            asm volatile("s_waitcnt vmcnt(0)" ::: "memory");
            (void)xb_add(&bar[XB_TOP], 1u);
        }
        XB_SPIN(xb_ld(&bar[XB_TOP]) < (gen + 1u) * nx, bar);
        __builtin_amdgcn_fence(__ATOMIC_ACQUIRE, "agent");
        asm volatile("s_waitcnt vmcnt(0)" ::: "memory");
    }
    __syncthreads();
}
__device__ __forceinline__ float row_rstd(const float* ssq, int row) {
    const f32x4* p = (const f32x4*)(ssq + (size_t)row * 16);
    const f32x4 a = p[0], b = p[1], c = p[2], d = p[3];
    const float s = (((a.x + a.y) + (a.z + a.w)) + ((b.x + b.y) + (b.z + b.w))) + (((c.x + c.y) + (c.z + c.w)) + ((d.x + d.y) + (d.z + d.w)));
    return __builtin_amdgcn_rsqf(s * (1.0f / 1024.0f) + EPS);
}
template <class Sched, bool XS = false> __device__ __forceinline__ void rstd_table(LAS unsigned char* lds, const float* ssq, const Sched& S, const int wave0) {
    int tid = wave0 * 64 + mk_lane(); asm volatile("" : "+v"(tid));
    LAS float* T = (LAS float*)(lds + RSTD_OFF);
#pragma unroll
    for (int i2 = 0; i2 < 3; ++i2) { pg8::Unit u; const int i = 2 * i2 + (tid >> 8); if (S.next(i, u)) T[i * 256 + (tid & 255)] = XS ? ssq[u.pm * 256 + (tid & 255)] : row_rstd(ssq, u.pm * 256 + (tid & 255)); }
    __syncthreads();
}
__device__ __forceinline__ float bf_lo(unsigned w) { return __uint_as_float(w << 16); }
__device__ __forceinline__ float bf_hi(unsigned w) { return __uint_as_float(w & 0xffff0000u); }

struct EpiNull {
    static constexpr bool PERM = false, AFTER_DRAIN = false;
    float* dummy;
    __device__ __forceinline__ void operator()(const f32x4 (&acc)[2][2][4][2], const pg8::Unit& u, int wr, int wc, int fr, int fq) const {
        f32x4 s = {0.f, 0.f, 0.f, 0.f};
#pragma unroll
        for (int ai = 0; ai < 2; ++ai)
#pragma unroll
            for (int bj = 0; bj < 2; ++bj)
#pragma unroll
                for (int m = 0; m < 4; ++m)
#pragma unroll
                    for (int n = 0; n < 2; ++n) s += acc[ai][bj][m][n];
        dummy[(size_t)blockIdx.x * 512 + (wr * 4 + wc) * 64 + fq * 16 + fr] = (s.x + s.y) + (s.z + s.w);
    }
};
struct NoPre {};
template <bool F8, bool I8 = false> struct EpiSwiGLUT {
    static constexpr bool PERM = true, AFTER_DRAIN = false, PRELOAD = false; typedef NoPre Pre;
    bf16* H; LAS const float* rt; int nullmode;
    __device__ __forceinline__ void operator()(const f32x4 (&acc)[2][2][4][2], const pg8::Unit& u, int wr, int wc, int fr, int fq) const {
#if PROBE == 13
        if (nullmode) { EpiNull en{(float*)H}; en(acc, u, wr, wc, fr, fq); return; }
#endif
        const int row0 = u.pm * 256 + wr * 64 + fr, col0 = u.pn * 128 + wc * 32 + 8 * fq;
#pragma unroll
        for (int ai = 0; ai < 2; ++ai)
#pragma unroll
            for (int m = 0; m < 4; ++m) {
                const int row = row0 + ai * 128 + m * 16;
                const float rs = rt[u.idx * 256 + (row & 255)], rsl = rs * (-LOG2E), irs2 = __builtin_amdgcn_rcpf(rs * rs * (F8 ? 8.0f : 1.0f));
                float hv[8];
#pragma unroll
                for (int n = 0; n < 2; ++n)
#pragma unroll
                    for (int e = 0; e < 4; ++e) {
                        const float ga = I8 ? (float)__float_as_int(acc[ai][0][m][n][e]) : acc[ai][0][m][n][e], ua = I8 ? (float)__float_as_int(acc[ai][1][m][n][e]) : acc[ai][1][m][n][e];
                        const float ex = __builtin_amdgcn_exp2f(ga * rsl);
                        hv[n * 4 + e] = (ga * ua) * __builtin_amdgcn_rcpf(__builtin_fmaf(ex, irs2, irs2));
                    }
                if constexpr (F8) {
                    int w0 = 0, w1 = 0;
                    w0 = __builtin_amdgcn_cvt_pk_fp8_f32(hv[0], hv[1], w0, false); w0 = __builtin_amdgcn_cvt_pk_fp8_f32(hv[2], hv[3], w0, true);
                    w1 = __builtin_amdgcn_cvt_pk_fp8_f32(hv[4], hv[5], w1, false); w1 = __builtin_amdgcn_cvt_pk_fp8_f32(hv[6], hv[7], w1, true);
                    u32x2 w8; w8.x = (unsigned)w0; w8.y = (unsigned)w1;
                    *(u32x2*)((unsigned char*)H + (size_t)row * FF_ + col0) = w8;
                } else {
                u32x4 w; w.x = cvt_pk_bf16(hv[0], hv[1]); w.y = cvt_pk_bf16(hv[2], hv[3]); w.z = cvt_pk_bf16(hv[4], hv[5]); w.w = cvt_pk_bf16(hv[6], hv[7]);
                *(u32x4*)(H + (size_t)row * FF_ + col0) = w;
                }
            }
    }
};
typedef EpiSwiGLUT<false> EpiSwiGLU;
typedef EpiSwiGLUT<true, true> EpiSwiGLU_F8I8;
typedef EpiSwiGLUT<false, true> EpiSwiGLU_I8;

template <bool POOL, int ALPHA2, bool X8OUT = !POOL> struct EpiResid {
    static constexpr bool PERM = true, AFTER_DRAIN = false;
    static constexpr bool PRELOAD = !POOL;
    struct PreTile { u32x4 r[16]; };
    typedef typename std::conditional<POOL, NoPre, PreTile>::type Pre;
    static constexpr float alpha = 0.5f * (float)ALPHA2;
    bf16* xb; float* ssq; const float* cscale; bf16* halo; unsigned char* x8;
    __device__ __forceinline__ void pre_issue(PreTile& pre, const pg8::Unit& u, int wr, int wc, int fr, int fq) const {
        const int row0 = u.pm * 256 + wr * 64 + fr, col0 = u.pn * 256 + wc * 32 + 8 * fq;
#pragma unroll
        for (int ai = 0; ai < 2; ++ai)
#pragma unroll
            for (int m = 0; m < 4; ++m)
#pragma unroll
                for (int bj = 0; bj < 2; ++bj) pre.r[(ai * 4 + m) * 2 + bj] = *(const u32x4*)(xb + (size_t)(row0 + ai * 128 + m * 16) * D_ + col0 + bj * 128);
    }
    __device__ __forceinline__ void pre_finish(f32x4 (&acc)[2][2][4][2], const PreTile& pre) const {
        const float ia = 1.0f / alpha;
#pragma unroll
        for (int ai = 0; ai < 2; ++ai)
#pragma unroll
            for (int m = 0; m < 4; ++m)
#pragma unroll
                for (int bj = 0; bj < 2; ++bj) { const u32x4 b = pre.r[(ai * 4 + m) * 2 + bj];
                    acc[ai][bj][m][0] = (f32x4){bf_lo(b.x), bf_hi(b.x), bf_lo(b.y), bf_hi(b.y)} * ia; acc[ai][bj][m][1] = (f32x4){bf_lo(b.z), bf_hi(b.z), bf_lo(b.w), bf_hi(b.w)} * ia; }
    }
    __device__ __forceinline__ void operator()(const f32x4 (&acc)[2][2][4][2], const pg8::Unit& u, int wr, int wc, int fr, int fq) const {
        if (POOL) { const int l2 = mk_lane(); fr = l2 & 15; fq = l2 >> 4; }
        const int pmr = POOL ? (u.pm & 63) : u.pm;
        const int row0 = pmr * 256 + wr * 64 + fr, col0 = u.pn * 256 + wc * 32 + 8 * fq;
        f32x4 cs[2][2];
#pragma unroll
        for (int bj = 0; bj < 2; ++bj)
#pragma unroll
            for (int n = 0; n < 2; ++n) { if (POOL) cs[bj][n] = *(const f32x4*)(cscale + col0 + bj * 128 + 4 * n) * alpha; }
#pragma unroll
        for (int ai = 0; ai < 2; ++ai) {
            u32x4 bx[4][2];
            constexpr int MB = POOL ? 2 : 4;
#pragma unroll
            for (int m = 0; m < 4; ++m) {
                if (POOL && (m % MB) == 0) {
#pragma unroll
                    for (int m2 = m; m2 < m + MB; ++m2)
#pragma unroll
                        for (int bj = 0; bj < 2; ++bj) bx[m2][bj] = *(const u32x4*)(xb + (size_t)(row0 + ai * 128 + m2 * 16) * D_ + col0 + bj * 128);
                }
                const int row = row0 + ai * 128 + m * 16; float s = 0.f;
#pragma unroll
                for (int bj = 0; bj < 2; ++bj) {
                    f32x4 v0, v1;
                    if (POOL) { v0 = acc[ai][bj][m][0] * cs[bj][0]; v1 = acc[ai][bj][m][1] * cs[bj][1]; } else { v0 = acc[ai][bj][m][0] * alpha; v1 = acc[ai][bj][m][1] * alpha; }
                    if (POOL) { const u32x4 b = bx[m][bj]; v0 += (f32x4){bf_lo(b.x), bf_hi(b.x), bf_lo(b.y), bf_hi(b.y)}; v1 += (f32x4){bf_lo(b.z), bf_hi(b.z), bf_lo(b.w), bf_hi(b.w)}; }
                    s += ((v0.x * v0.x + v0.y * v0.y) + (v0.z * v0.z + v0.w * v0.w)) + ((v1.x * v1.x + v1.y * v1.y) + (v1.z * v1.z + v1.w * v1.w));
                    u32x4 w; w.x = cvt_pk_bf16(v0.x, v0.y); w.y = cvt_pk_bf16(v0.z, v0.w); w.z = cvt_pk_bf16(v1.x, v1.y); w.w = cvt_pk_bf16(v1.z, v1.w);
                    *(u32x4*)(xb + (size_t)row * D_ + col0 + bj * 128) = w;
                    if (X8OUT && x8) { int p0 = 0, p1 = 0;
                        p0 = __builtin_amdgcn_cvt_pk_fp8_f32(v0.x * 8.0f, v0.y * 8.0f, p0, false); p0 = __builtin_amdgcn_cvt_pk_fp8_f32(v0.z * 8.0f, v0.w * 8.0f, p0, true);
                        p1 = __builtin_amdgcn_cvt_pk_fp8_f32(v1.x * 8.0f, v1.y * 8.0f, p1, false); p1 = __builtin_amdgcn_cvt_pk_fp8_f32(v1.z * 8.0f, v1.w * 8.0f, p1, true);
                        u32x2 w8; w8.x = (unsigned)p0; w8.y = (unsigned)p1; *(u32x2*)(x8 + (size_t)row * D_ + col0 + bj * 128) = w8; }
                    if (!POOL && ai == 1 && m == 3) { if (halo && wr == 1) *(u32x4*)(halo + ((size_t)u.pm * 16 + fr) * D_ + col0 + bj * 128) = w; }
                }
                s += shx(s, 16, fq * 16 + fr); s += shx(s, 32, fq * 16 + fr);
                if (fq == 0) ssq[(size_t)row * 16 + u.pn * 4 + wc] = s;
            }
        }
    }
};

struct EpiQKV {
    static constexpr bool PERM = true, AFTER_DRAIN = false, PRELOAD = false; typedef NoPre Pre;
    bf16* QKV; LAS const float* rt; float* kpart;
    __device__ __forceinline__ void operator()(const f32x4 (&acc)[2][2][4][2], const pg8::Unit& u, int wr, int wc, int fr, int fq) const {
        const int t = u.pn >> 2, colt = (u.pn & 3) * 256;
        bf16* dst = QKV + (size_t)t * S_ * D_;
        const int row0 = u.pm * 256 + wr * 64 + fr, col0 = colt + wc * 32 + 8 * fq;
        f32x4 csum[2][2];
#pragma unroll
        for (int bj = 0; bj < 2; ++bj)
#pragma unroll
            for (int n = 0; n < 2; ++n) csum[bj][n] = (f32x4){0.f, 0.f, 0.f, 0.f};
#pragma unroll
        for (int ai = 0; ai < 2; ++ai)
#pragma unroll
            for (int m = 0; m < 4; ++m) {
                const int row = row0 + ai * 128 + m * 16;
                const float rs = rt[u.idx * 256 + (row & 255)];
#pragma unroll
                for (int bj = 0; bj < 2; ++bj) {
                    const f32x4 v0 = acc[ai][bj][m][0] * rs, v1 = acc[ai][bj][m][1] * rs;
                    u32x4 w; w.x = cvt_pk_bf16(v0.x, v0.y); w.y = cvt_pk_bf16(v0.z, v0.w); w.z = cvt_pk_bf16(v1.x, v1.y); w.w = cvt_pk_bf16(v1.z, v1.w);
                    *(u32x4*)(dst + (size_t)row * D_ + col0 + bj * 128) = w;
                    csum[bj][0] += v0; csum[bj][1] += v1;
                }
            }
        if (t == 1) {
#pragma unroll
            for (int bj = 0; bj < 2; ++bj)
#pragma unroll
                for (int n = 0; n < 2; ++n) {
                    f32x4 c = csum[bj][n];
#pragma unroll
                    for (int e = 0; e < 4; ++e) { float x = c[e]; x += shx(x, 1, fq * 16 + fr); x += shx(x, 2, fq * 16 + fr); x += shx(x, 4, fq * 16 + fr); x += shx(x, 8, fq * 16 + fr); c[e] = x; }
                    if (fr == 0) *(f32x4*)(kpart + ((size_t)wr * NBLK + u.pm) * D_ + col0 + bj * 128 + 4 * n) = c;
                }
        }
    }
};


struct PoolOrder {
    int G, c;
    __device__ __forceinline__ bool next(int i, pg8::Unit& u) const { const int L = i * G + c; if (L >= 256) return false; u.pm = L; u.pn = L >> 6; u.idx = i; return true; }
    __device__ __forceinline__ void a_ready(const pg8::Unit&) const {}
    __device__ __forceinline__ void done(const pg8::Unit&) const {}
};
__device__ __forceinline__ float wave_sum(float v, int lane) {
#pragma unroll
    for (int o = 1; o < 64; o <<= 1) v += shx(v, o, lane);
    return v;
}
__device__ __forceinline__ void tr_item(const float* src, int N, int k0, int n0, bf16* dst, int dpitch, int drow0, const float* gain, float cs, LAS float* scr, int lane, int f8 = 0) {
    f32x4 v[8];
#pragma unroll
    for (int i = 0; i < 8; ++i) v[i] = __builtin_nontemporal_load((const f32x4*)(src + (size_t)(k0 + 8 * i + (lane >> 3)) * N + n0 + 4 * (lane & 7)));
#pragma unroll
    for (int i = 0; i < 8; ++i) {
        const int kk = 8 * i + (lane >> 3);
        const float g = gain ? gain[k0 + kk] * cs : cs;
        LAS float* d = scr + kk * 33 + 4 * (lane & 7);
        d[0] = v[i].x * g; d[1] = v[i].y * g; d[2] = v[i].z * g; d[3] = v[i].w * g;
    }
    LDS_WAIT(); asm volatile("" ::: "memory");
    const int c = lane & 7;
#pragma unroll
    for (int j = 0; j < 4; ++j) {
        const int n = (lane >> 3) + 8 * j; const LAS float* s = scr + (8 * c) * 33 + n;
        if (f8 == 2) {
            unsigned o8[2];
#pragma unroll
            for (int hh = 0; hh < 2; ++hh) { unsigned wv = 0u;
#pragma unroll
                for (int b = 0; b < 4; ++b) { const int q = max(-127, min(127, (int)__builtin_rintf(s[(hh * 4 + b) * 33]))); wv |= ((unsigned)q & 255u) << (8 * b); }
                o8[hh] = wv; }
            u32x2 ov; ov.x = o8[0]; ov.y = o8[1];
            *(u32x2*)((unsigned char*)dst + (size_t)(drow0 + n) * dpitch + k0 + 8 * c) = ov;
        } else if (f8) {
            int w0 = 0, w1 = 0;
            w0 = __builtin_amdgcn_cvt_pk_fp8_f32(s[0 * 33], s[1 * 33], w0, false); w0 = __builtin_amdgcn_cvt_pk_fp8_f32(s[2 * 33], s[3 * 33], w0, true);
            w1 = __builtin_amdgcn_cvt_pk_fp8_f32(s[4 * 33], s[5 * 33], w1, false); w1 = __builtin_amdgcn_cvt_pk_fp8_f32(s[6 * 33], s[7 * 33], w1, true);
            u32x2 o8; o8.x = (unsigned)w0; o8.y = (unsigned)w1;
            *(u32x2*)((unsigned char*)dst + (size_t)(drow0 + n) * dpitch + k0 + 8 * c) = o8;
        } else {
        u32x4 o; o.x = cvt_pk_bf16(s[0 * 33], s[1 * 33]); o.y = cvt_pk_bf16(s[2 * 33], s[3 * 33]); o.z = cvt_pk_bf16(s[4 * 33], s[5 * 33]); o.w = cvt_pk_bf16(s[6 * 33], s[7 * 33]);
        *(u32x4*)(dst + (size_t)(drow0 + n) * dpitch + k0 + 8 * c) = o;
        }
    }
    LDS_WAIT(); asm volatile("" ::: "memory");
}
__device__ __forceinline__ unsigned char* launder_s(unsigned char* p) { unsigned long long v = (unsigned long long)p; asm volatile("" : "+s"(v)); return (unsigned char*)v; }
struct Ptrs {
    const float *x, *ln, *wg, *wu, *wd, *wqkv, *wo, *pw, *ps, *fg;
    float* out; unsigned char* ws;
};
__device__ __forceinline__ bf16* ws_wgu(unsigned char* ws, int f) { return (bf16*)(ws + WS_WFFN + (size_t)f * WFFN_STRIDE); }
__device__ __forceinline__ bf16* ws_wd(unsigned char* ws, int f) { return (bf16*)(ws + WS_WFFN + (size_t)f * WFFN_STRIDE + WFFN_WD); }
__device__ __forceinline__ bf16* ws_wqkv(unsigned char* ws, int a) { return (bf16*)(ws + WS_WATT + (size_t)a * WATT_STRIDE); }
__device__ __forceinline__ bf16* ws_wo(unsigned char* ws, int a) { return (bf16*)(ws + WS_WATT + (size_t)a * WATT_STRIDE + WATT_WO); }
__device__ __forceinline__ bf16* ws_wp(unsigned char* ws, int p) { return (bf16*)(ws + WS_WP + (size_t)p * 524288); }

constexpr int IT_F = 1408, IT_FFN = 3 * IT_F, IT_ATT = 2048, IT_QKV = 1536, IT_POOL = 128;
constexpr int IT_TOTAL = 8 * IT_FFN + 2 * IT_ATT + 2 * IT_POOL;
__device__ __forceinline__ void convert_items(const Ptrs& P, LAS unsigned char* lds, int it_lo, int it_hi, int ww, int n_ww, int wave, int lane) {
    LAS float* scr = (LAS float*)(lds + wave * 16384);
    for (int it = it_lo + ww; it < it_hi; it += n_ww) {
        if (it < 8 * IT_FFN) {
            const int f = it / IT_FFN, r = it % IT_FFN, m = r / IT_F, q = r % IT_F;
            if (m < 2) {
                const int kb = q / 88, nb = q % 88, n0 = 32 * nb;
                const float* src = (m == 0 ? P.wg : P.wu) + (size_t)f * D_ * FF_;
                const float* gain = P.ln + ((f >> 1) * 3 + ((f & 1) ? 2 : 0)) * D_;
                const bool x8 = ((X8_MASK >> f) & 1) != 0, i8 = ((I8_MASK >> f) & 1) != 0;
                tr_item(src, FF_, 64 * kb, n0, ws_wgu(P.ws, f), D_, (n0 >> 7) * 256 + m * 128 + (n0 & 127), gain, i8 ? pg8::I8_WQ : x8 ? 256.0f : 1.0f, scr, lane, i8 ? 2 : (x8 ? 1 : 0));
            } else {
                const int kb = q / 32, nb = q % 32;
                const bool f8 = ((FP8_MASK >> f) & 1) != 0;
                tr_item(P.wd + (size_t)f * D_ * FF_, D_, 64 * kb, 32 * nb, ws_wd(P.ws, f), FF_, 32 * nb, nullptr, f8 ? 512.0f : 1.0f, scr, lane, f8 ? 1 : 0);
            }
        } else if (it < 8 * IT_FFN + 2 * IT_ATT) {
            const int r = it - 8 * IT_FFN, a = r / IT_ATT; int q = r % IT_ATT;
            if (q < IT_QKV) {
                const int kb = q / 96, nb = q % 96, n0 = 32 * nb;
                tr_item(P.wqkv + (size_t)a * D_ * 3 * D_, 3 * D_, 64 * kb, n0, ws_wqkv(P.ws, a), D_, n0, P.ln + ((2 * a) * 3 + 1) * D_, n0 < D_ ? 0.125f * LOG2E : 1.0f, scr, lane);
            } else {
                q -= IT_QKV; const int kb = q / 32, nb = q % 32;
                tr_item(P.wo + (size_t)a * D_ * D_, D_, 64 * kb, 32 * nb, ws_wo(P.ws, a), D_, 32 * nb, nullptr, 1.0f, scr, lane);
            }
        } else {
            const int r = it - 8 * IT_FFN - 2 * IT_ATT, p = r / IT_POOL, g = (r % IT_POOL) / 32, q = r % 32, kb = q / 8, nb = q % 8;
            tr_item(P.pw + (size_t)(p * 4 + g) * 65536, 256, 64 * kb, 32 * nb, ws_wp(P.ws, p), 256, g * 256 + 32 * nb, nullptr, 1.0f, scr, lane);
        }
    }
}
#ifndef TAILCONV
#define TAILCONV 1
#endif
__device__ __forceinline__ void phase_prologue(const Ptrs& P, LAS unsigned char* lds, const int wave0) {
    int tid = wave0 * 64 + mk_lane(); asm volatile("" : "+v"(tid)); const int lane = tid & 63, wave = __builtin_amdgcn_readfirstlane(tid >> 6); (void)lane; (void)wave;
    const int gw = blockIdx.x * NWAVES + wave, NGW = gridDim.x * NWAVES;
    if (TAILCONV && gridDim.x == 256) {
        convert_items(P, lds, 0, IT_FFN, gw, NGW, wave, lane);
        convert_items(P, lds, 8 * IT_FFN, 8 * IT_FFN + IT_ATT, gw, NGW, wave, lane);
    } else convert_items(P, lds, 0, IT_TOTAL, gw, NGW, wave, lane);
    bf16* XB = (bf16*)(P.ws + WS_XB); float* ssq = (float*)(P.ws + WS_SSQ);
    for (int row = gw; row < S_; row += NGW) {
        const f32x4* xr = (const f32x4*)(P.x + (size_t)row * D_) + lane;
        f32x4 v[4]; float s = 0.f;
#pragma unroll
        for (int j = 0; j < 4; ++j) { v[j] = __builtin_nontemporal_load(xr + 64 * j); s += (v[j].x * v[j].x + v[j].y * v[j].y) + (v[j].z * v[j].z + v[j].w * v[j].w); }
        s = wave_sum(s, lane);
        if ((I8_MASK & 1) != 0) {
            float am = 0.f;
#pragma unroll
            for (int j = 0; j < 4; ++j) am = fmaxf(fmaxf(am, fmaxf(fabsf(v[j].x), fabsf(v[j].y))), fmaxf(fabsf(v[j].z), fabsf(v[j].w)));
            am = fmaxf(am, shx(am, 1, lane)); am = fmaxf(am, shx(am, 2, lane)); am = fmaxf(am, shx(am, 4, lane)); am = fmaxf(am, shx(am, 8, lane)); am = fmaxf(am, shx(am, 16, lane)); am = fmaxf(am, shx(am, 32, lane));
            am = fmaxf(am, 1e-20f); const float qs = 127.0f / am;
            unsigned* oq = (unsigned*)(P.ws + WS_XQ + (size_t)row * D_) + lane;
#pragma unroll
            for (int j = 0; j < 4; ++j) { const int q0 = (int)__builtin_rintf(v[j].x * qs), q1 = (int)__builtin_rintf(v[j].y * qs), q2 = (int)__builtin_rintf(v[j].z * qs), q3 = (int)__builtin_rintf(v[j].w * qs);
                oq[64 * j] = ((unsigned)q0 & 255u) | (((unsigned)q1 & 255u) << 8) | (((unsigned)q2 & 255u) << 16) | (((unsigned)q3 & 255u) << 24); }
            if (lane == 0) ((float*)(P.ws + WS_XS))[row] = am * __builtin_amdgcn_rsqf(s * (1.0f / 1024.0f) + EPS) * (pg8::I8_IWQ / 127.0f);
        }
        u32x2* o8 = (u32x2*)(XB + (size_t)row * D_) + lane;
#pragma unroll
        for (int j = 0; j < 4; ++j) { u32x2 w; w.x = cvt_pk_bf16(v[j].x, v[j].y); w.y = cvt_pk_bf16(v[j].z, v[j].w); o8[64 * j] = w; }
        if (lane < 16) ssq[(size_t)row * 16 + lane] = lane == 0 ? s : 0.f;
    }
}

__device__ __forceinline__ void phase_final(const Ptrs& P, bool poison, const int wave0) {
    int tid = wave0 * 64 + mk_lane(); asm volatile("" : "+v"(tid)); const int lane = tid & 63, wave = __builtin_amdgcn_readfirstlane(tid >> 6); (void)lane; (void)wave;
    const int gw = blockIdx.x * NWAVES + wave, NGW = gridDim.x * NWAVES;
    const float* ssq = (const float*)(P.ws + WS_SSQ);
    const float qnan = __builtin_nanf("");
    for (int row = gw; row < S_; row += NGW) {
        const float rs = row_rstd(ssq, row);
        f32x4* xr = (f32x4*)(P.out + (size_t)row * D_) + lane; const f32x4* gr = (const f32x4*)P.fg + lane;
        const u32x2* h8 = (const u32x2*)((const bf16*)(P.ws + WS_XB) + (size_t)row * D_) + lane;
#pragma unroll
        for (int j = 0; j < 4; ++j) { const u32x2 hv = h8[64 * j]; f32x4 x4 = {bf_lo(hv.x), bf_hi(hv.x), bf_lo(hv.y), bf_hi(hv.y)};
            f32x4 v = x4 * gr[64 * j] * rs; if (poison) v = (f32x4){qnan, qnan, qnan, qnan}; __builtin_nontemporal_store(v, xr + 64 * j); }
    }
}

__device__ __forceinline__ void phase_pool_elem(const bf16* xhi, const float* ssq, const float* gain, bf16* Y, const bf16* halo, LAS unsigned char* lds, const int wave0) {
    int tid = wave0 * 64 + mk_lane(); asm volatile("" : "+v"(tid)); const int lane = tid & 63, wave = __builtin_amdgcn_readfirstlane(tid >> 6); (void)lane; (void)wave;
    LAS float* rs = (LAS float*)lds;
    const int L = blockIdx.x, g = L >> 6, strip = wave >> 1;
    const int t0 = (L & 63) * 256 + strip * 64;
    if (tid < 320) { const int st = tid / 80, r = (L & 63) * 256 + st * 64 - 16 + tid % 80; rs[tid] = r >= 0 ? row_rstd(ssq, r) : 0.f; }
    __syncthreads();
    const int cg = 2 * (tid & 127), c = g * 256 + cg;
    const f32x2 gn = *(const f32x2*)(gain + c);
    f32x2 hist[16], S2 = {0.f, 0.f}, S4 = {0.f, 0.f}, S8 = {0.f, 0.f}, S16 = {0.f, 0.f};
#pragma unroll
    for (int i = 0; i < 16; ++i) hist[i] = (f32x2){0.f, 0.f};
    const int w = 2 << g;
    bf16* Yg = Y + (size_t)g * S_ * 256 + cg;
    LAS const float* rss = rs + strip * 80;
    unsigned hwv[80];
#pragma unroll
    for (int r = 0; r < 80; ++r) {
        const int row = t0 - 16 + r; hwv[r] = 0u;
        if (row >= 0) { const bf16* src = (r < 16 && strip == 0) ? halo + ((size_t)((L & 63) - 1) * 16 + r) * D_ + c : xhi + (size_t)row * D_ + c; hwv[r] = *(const unsigned*)src; }
    }
#pragma unroll
    for (int b = 0; b < 5; ++b) {
#pragma unroll
        for (int i = 0; i < 16; ++i) {
            const int r = 16 * b + i, row = t0 - 16 + r;
            const unsigned hw = hwv[r];
            const f32x2 hv = (f32x2){bf_lo(hw), bf_hi(hw)} * gn * rss[r];
            S16 += hv - hist[i]; S8 += hv - hist[(i + 8) & 15]; S4 += hv - hist[(i + 12) & 15]; S2 += hv - hist[(i + 14) & 15]; hist[i] = hv;
            if (b > 0) {
                const f32x2 sw = g == 0 ? S2 : g == 1 ? S4 : g == 2 ? S8 : S16;
                const int cnt = row + 1 < w ? row + 1 : w;
                const f32x2 y = sw * (1.0f / (float)cnt) - hv;
                *(unsigned*)(Yg + (size_t)row * 256) = cvt_pk_bf16(y.x, y.y);
            }
        }
    }
    asm volatile("s_waitcnt vmcnt(0)" ::: "memory");
    __builtin_amdgcn_fence(__ATOMIC_ACQUIRE, "agent");
    asm volatile("s_waitcnt vmcnt(0)" ::: "memory");
    __syncthreads();
}

__device__ __forceinline__ bool alibi_dead(float slope2, int t, int n) { return slope2 * (float)(t - n * BS - (BS - 1)) >= 160.0f; }
__device__ __forceinline__ float head_slope2(int h) { return exp2f(-0.5f * (float)(h + 1)) * LOG2E; }
__device__ __forceinline__ void top3_insert(float gt, unsigned n, float& v0, float& v1, float& v2, unsigned& i0, unsigned& i1, unsigned& i2) {
    const bool g0 = gt > v0, g1 = gt > v1, g2 = gt > v2;
    v2 = g1 ? v1 : (g2 ? gt : v2); i2 = g1 ? i1 : (g2 ? n : i2);
    v1 = g0 ? v0 : (g1 ? gt : v1); i1 = g0 ? i0 : (g1 ? n : i1);
    v0 = g0 ? gt : v0;             i0 = g0 ? n : i0;
}
__device__ __forceinline__ void phase_gate(const bf16* Q, const float* kpart, unsigned* sel, float* qn2, unsigned* lists, gu32* lc, LAS unsigned char* lds, const int wave0) {
    int tid = wave0 * 64 + mk_lane(); asm volatile("" : "+v"(tid)); const int lane = tid & 63, wave = __builtin_amdgcn_readfirstlane(tid >> 6);
    const int fr = lane & 15, fq = lane >> 4;
    constexpr int KP = 144, LO = 64 * KP;
    for (int wgt = blockIdx.x; wgt < 256; wgt += gridDim.x) {
        const int h = wgt & 15, part = wgt >> 4;
        const float slope2g = head_slope2(h);
        unsigned apos[8], aent[8];
        bf16x8 qa[8][2];
#pragma unroll
        for (int i = 0; i < 8; ++i) { const bf16* qrow = Q + (size_t)(part * 1024 + (wave + 8 * i) * 16 + fr) * D_ + h * 64; qa[i][0] = *(const bf16x8*)(qrow + 8 * fq); qa[i][1] = *(const bf16x8*)(qrow + 32 + 8 * fq); }
        {
            const int n = tid >> 3, d0 = (tid & 7) * 8;
            const float* pa = kpart + (size_t)n * D_ + h * 64 + d0; const float* pb = pa + (size_t)NBLK * D_;
            const f32x4 a0 = *(const f32x4*)pa, a1 = *(const f32x4*)(pa + 4), b0 = *(const f32x4*)pb, b1 = *(const f32x4*)(pb + 4);
            const f32x4 s0 = a0 + b0, s1 = a1 + b1;
            u32x4 hi; hi.x = cvt_pk_bf16(s0.x, s0.y); hi.y = cvt_pk_bf16(s0.z, s0.w); hi.z = cvt_pk_bf16(s1.x, s1.y); hi.w = cvt_pk_bf16(s1.z, s1.w);
            u32x4 lo; lo.x = cvt_pk_bf16(s0.x - bf_lo(hi.x), s0.y - bf_hi(hi.x)); lo.y = cvt_pk_bf16(s0.z - bf_lo(hi.y), s0.w - bf_hi(hi.y));
            lo.z = cvt_pk_bf16(s1.x - bf_lo(hi.z), s1.y - bf_hi(hi.z)); lo.w = cvt_pk_bf16(s1.z - bf_lo(hi.w), s1.w - bf_hi(hi.w));
            *(LAS u32x4*)(lds + n * KP + d0 * 2) = hi; *(LAS u32x4*)(lds + LO + n * KP + d0 * 2) = lo;
        }
        LAS unsigned* lcn = (LAS unsigned*)(lds + 2 * LO + 2048);
        if (tid < 64) lcn[tid] = 0u;
        __syncthreads();
#pragma unroll
        for (int ti = 0; ti < 8; ++ti) {
            const int tile = wave + 8 * ti;
            const int t0 = part * 1024 + tile * 16, j = t0 >> 8, t = t0 + fr;
            const bf16x8 q0 = qa[ti][0], q1 = qa[ti][1];
            float v0 = -INFINITY, v1 = -INFINITY, v2 = -INFINITY; unsigned i0 = 255u, i1 = 255u, i2 = 255u;
            LAS const unsigned char* kp = lds + fr * KP + fq * 16;
#pragma unroll
            for (int bt = 0; bt < 4; ++bt) {
                if (16 * bt < j) {
                    const bf16x8 h0 = *(LAS const bf16x8*)(kp + bt * 16 * KP), h1 = *(LAS const bf16x8*)(kp + bt * 16 * KP + 64);
                    const bf16x8 l0 = *(LAS const bf16x8*)(kp + LO + bt * 16 * KP), l1 = *(LAS const bf16x8*)(kp + LO + bt * 16 * KP + 64);
                    f32x4 z = {0.f, 0.f, 0.f, 0.f};
                    z = __builtin_amdgcn_mfma_f32_16x16x32_bf16(l0, q0, z, 0, 0, 0); z = __builtin_amdgcn_mfma_f32_16x16x32_bf16(l1, q1, z, 0, 0, 0);
                    z = __builtin_amdgcn_mfma_f32_16x16x32_bf16(h0, q0, z, 0, 0, 0); z = __builtin_amdgcn_mfma_f32_16x16x32_bf16(h1, q1, z, 0, 0, 0);
#pragma unroll
                    for (int e = 0; e < 4; ++e) { const int n = 16 * bt + 4 * fq + e; if (n < j) top3_insert(z[e], (unsigned)n, v0, v1, v2, i0, i1, i2); }
                }
            }
#pragma unroll
            for (int sh = 16; sh <= 32; sh <<= 1) {
                const float p0 = shx(v0, sh, lane), p1 = shx(v1, sh, lane), p2 = shx(v2, sh, lane);
                const unsigned q0i = shxu(i0, sh, lane), q1i = shxu(i1, sh, lane), q2i = shxu(i2, sh, lane);
                if (q0i != 255u) top3_insert(p0, q0i, v0, v1, v2, i0, i1, i2);
                if (q1i != 255u) top3_insert(p1, q1i, v0, v1, v2, i0, i1, i2);
                if (q2i != 255u) top3_insert(p2, q2i, v0, v1, v2, i0, i1, i2);
            }
            float qq = 0.f;
#pragma unroll
            for (int i = 0; i < 8; ++i) { const float a = __uint_as_float((unsigned)(unsigned short)q0[i] << 16), b = __uint_as_float((unsigned)(unsigned short)q1[i] << 16); qq = __builtin_fmaf(a, a, qq); qq = __builtin_fmaf(b, b, qq); }
            qq += shx(qq, 16, lane); qq += shx(qq, 32, lane);
            const unsigned word = i0 | (i1 << 8) | (i2 << 16) | 0xff000000u;
            if (fq == 0) { sel[(size_t)h * S_ + t] = word; qn2[(size_t)h * S_ + t] = qq; }
            const unsigned w0 = (unsigned)shi((int)word, fr);
            const unsigned nk = fq < 3 ? ((w0 >> (8 * fq)) & 255u) : 255u;
            apos[ti] = 0u; aent[ti] = 0xffffffffu;
            if (nk != 255u && !alibi_dead(slope2g, t, (int)nk)) { apos[ti] = __hip_atomic_fetch_add(lcn + nk, 1u, __ATOMIC_RELAXED, __HIP_MEMORY_SCOPE_WORKGROUP); aent[ti] = (nk << 16) | (unsigned)t | ((unsigned)fq << 14); }
        }
        __syncthreads();
        if (tid < 64) { const unsigned c = lcn[tid]; lcn[64 + tid] = c ? __hip_atomic_fetch_add(lc + h * 64 + tid, c, RLX_AGENT) : 0u; }
        __syncthreads();
#pragma unroll
        for (int ti = 0; ti < 8; ++ti) if (aent[ti] != 0xffffffffu) { const int n = (int)(aent[ti] >> 16); lists[(size_t)h * LIST_HEAD + list_off(n) + lcn[64 + n] + apos[ti]] = aent[ti] & 0xffffu; }
        __syncthreads();
    }
}

template <bool CAUSAL, bool FOLD = false>
__device__ __forceinline__ void attn_tile(LAS const unsigned char* Ks, LAS const unsigned char* Vt, bf16x8 q0, bf16x8 q1, float lcm, float slope2, int tq_rel, int nch, int fr, int fq,
                                          f32x4 (&o)[4], float& l_out, LAS const unsigned char* Wr = nullptr) {
    const int rowbase = 8 * (fr >> 2) + (fr & 3), sw = (((fr >> 1) & 1) << 1) | (((fr >> 3) & 1) << 2);
    LAS const unsigned char* kp0 = Ks + rowbase * 128 + ((fq ^ sw) * 16);
    LAS const unsigned char* kp1 = Ks + rowbase * 128 + (((4 | fq) ^ sw) * 16);
    const float thr_f = (float)(tq_rel - 8 * fq);
    f32x4 s[16];
    bf16x8 kf[2][4];
#define AT_LOADK(buf, c) do { _Pragma("unroll") for (int u = 0; u < 2; ++u) { const int ro = (32 * (c) + 4 * u) * 128; \
        kf[buf][2 * u] = *(LAS const bf16x8*)(kp0 + ro); kf[buf][2 * u + 1] = *(LAS const bf16x8*)(kp1 + ro); } } while (0)
    AT_LOADK(0, 0);
#pragma unroll
    for (int c = 0; c < 8; ++c) {
        if (!CAUSAL || c < nch) {
            if (c < 7) { if (!CAUSAL || c + 1 < nch) AT_LOADK((c + 1) & 1, c + 1); }
            __builtin_amdgcn_sched_barrier(0);
            f32x4 c0, c1;
            float lcc = lcm, thc = thr_f; asm volatile("" : "+v"(lcc), "+v"(thc));
            if constexpr (FOLD) { c0 = (f32x4){lcc, lcc, lcc, lcc}; c1 = c0; } else {
#pragma unroll
            for (int e = 0; e < 4; ++e) {
                c0[e] = __builtin_fmaf(slope2, (float)(32 * c + e), lcc); c1[e] = __builtin_fmaf(slope2, (float)(32 * c + 4 + e), lcc);
                if (CAUSAL) { c0[e] = __builtin_fmaf(fminf(thc - (float)(32 * c + e), 0.f), 1e9f, c0[e]); c1[e] = __builtin_fmaf(fminf(thc - (float)(32 * c + 4 + e), 0.f), 1e9f, c1[e]); }
            }
            }
            const f32x4 z0 = __builtin_amdgcn_mfma_f32_16x16x32_bf16(kf[c & 1][0], q0, c0, 0, 0, 0);
            const f32x4 z1 = __builtin_amdgcn_mfma_f32_16x16x32_bf16(kf[c & 1][2], q0, c1, 0, 0, 0);
            s[2 * c] = __builtin_amdgcn_mfma_f32_16x16x32_bf16(kf[c & 1][1], q1, z0, 0, 0, 0);
            s[2 * c + 1] = __builtin_amdgcn_mfma_f32_16x16x32_bf16(kf[c & 1][3], q1, z1, 0, 0, 0);
        }
    }
#undef AT_LOADK
    const int lanev16 = (fq ^ (2 * (fr & 7))) * 16;
    LAS const unsigned char* vp = Vt + fr * 512;
    bf16x8 vf[2][4], wf[2];
#define AT_LOADV(buf, c) do { const int co = (64 * (c)) ^ lanev16; \
        _Pragma("unroll") for (int dt = 0; dt < 4; ++dt) vf[buf][dt] = *(LAS const bf16x8*)(vp + dt * 8192 + co); \
        if constexpr (FOLD) wf[buf] = *(LAS const bf16x8*)(Wr + (32 * (c) + 8 * fq) * 2); } while (0)
    AT_LOADV(0, 0);
#pragma unroll
    for (int kt = 0; kt < 16; ++kt) {
        if (!CAUSAL || (kt >> 1) < nch) {
#pragma unroll
            for (int e = 0; e < 4; ++e) s[kt][e] = __builtin_amdgcn_exp2f(s[kt][e]);
        }
    }
#pragma unroll
    for (int dt = 0; dt < 4; ++dt) o[dt] = (f32x4){0.f, 0.f, 0.f, 0.f};
    f32x4 lsum = {0.f, 0.f, 0.f, 0.f};
    const bf16x8 ones = {(short)0x3f80, (short)0x3f80, (short)0x3f80, (short)0x3f80, (short)0x3f80, (short)0x3f80, (short)0x3f80, (short)0x3f80};
#pragma unroll
    for (int c = 0; c < 8; ++c) {
        if (!CAUSAL || c < nch) {
            if (c < 7) { if (!CAUSAL || c + 1 < nch) AT_LOADV((c + 1) & 1, c + 1); }
            u32x4 pw; pw.x = cvt_pk_bf16(s[2 * c][0], s[2 * c][1]); pw.y = cvt_pk_bf16(s[2 * c][2], s[2 * c][3]); pw.z = cvt_pk_bf16(s[2 * c + 1][0], s[2 * c + 1][1]); pw.w = cvt_pk_bf16(s[2 * c + 1][2], s[2 * c + 1][3]);
            const bf16x8 pf = __builtin_bit_cast(bf16x8, pw);
#pragma unroll
            for (int dt = 0; dt < 4; ++dt) o[dt] = __builtin_amdgcn_mfma_f32_16x16x32_bf16(vf[c & 1][dt], pf, o[dt], 0, 0, 0);
            lsum = __builtin_amdgcn_mfma_f32_16x16x32_bf16(FOLD ? wf[c & 1] : ones, pf, lsum, 0, 0, 0);
        }
    }
    const float l = lsum[0];
#undef AT_LOADV
    l_out = l;
}
__device__ __forceinline__ void kv_load(const bf16* K, const bf16* V, int n, int h, u32x4 (&kv)[4], u32x4 (&vv)[4], int tid, int wave, int lane) {
#pragma unroll
    for (int it = 0; it < 4; ++it) kv[it] = *(const u32x4*)(K + (size_t)(n * BS + it * 64 + (tid >> 3)) * D_ + h * 64 + (tid & 7) * 8);
#pragma unroll
    for (int it = 0; it < 4; ++it) vv[it] = *(const u32x4*)(V + (size_t)(n * BS + wave * 32 + (lane & 31)) * D_ + h * 64 + ((lane >> 5) * 4 + it) * 8);
}
template <bool FOLD = false>
__device__ __forceinline__ void kv_write(const u32x4 (&kv)[4], const u32x4 (&vv)[4], LAS unsigned char* lds, LAS unsigned* kmaxw, int tid, int wave, int lane, float slope2 = 0.f) {
    float kn = 0.f;
#pragma unroll
    for (int it = 0; it < 4; ++it) { const int r = it * 64 + (tid >> 3), c16 = tid & 7, swz = (((r >> 1) & 1) << 1) | (((r >> 4) & 1) << 2);
        *(LAS u32x4*)(lds + A_KS + r * 128 + ((c16 ^ swz) * 16)) = kv[it];
        float sq = 0.f;
#pragma unroll
        for (int w = 0; w < 4; ++w) { const float a = bf_lo(kv[it][w]), b = bf_hi(kv[it][w]); sq = __builtin_fmaf(a, a, sq); sq = __builtin_fmaf(b, b, sq); }
        sq += shx(sq, 1, lane); sq += shx(sq, 2, lane); sq += shx(sq, 4, lane); kn = fmaxf(kn, sq); }
    kn = fmaxf(kn, shx(kn, 8, lane)); kn = fmaxf(kn, shx(kn, 16, lane)); kn = fmaxf(kn, shx(kn, 32, lane));
    if (lane == 0) __hip_atomic_fetch_max(kmaxw, __float_as_uint(kn), __ATOMIC_RELAXED, __HIP_MEMORY_SCOPE_WORKGROUP);
#pragma unroll
    for (int it = 0; it < 4; ++it) {
        const int key = wave * 32 + (lane & 31), pc = (lane >> 5) * 4 + it;
        u32x4 v = vv[it];
        if constexpr (FOLD) {
            const float wk = __builtin_amdgcn_exp2f(slope2 * (float)(key - (BS - 1)));
            v.x = cvt_pk_bf16(bf_lo(v.x) * wk, bf_hi(v.x) * wk); v.y = cvt_pk_bf16(bf_lo(v.y) * wk, bf_hi(v.y) * wk); v.z = cvt_pk_bf16(bf_lo(v.z) * wk, bf_hi(v.z) * wk); v.w = cvt_pk_bf16(bf_lo(v.w) * wk, bf_hi(v.w) * wk);
            if (pc == 0) *(LAS unsigned short*)(lds + A_WROW + key * 2) = (unsigned short)(cvt_pk_bf16(wk, wk) & 0xffffu);
        }
        LAS unsigned char* vb = lds + A_VT + (pc * 8) * 512 + (key & 7) * 2; const int kc = key >> 3;
#define ST_VT(e, val) *(LAS unsigned short*)(vb + (e) * 512 + ((kc ^ (2 * (e))) * 16)) = (unsigned short)(val)
        ST_VT(0, v.x & 0xffffu); ST_VT(1, v.x >> 16); ST_VT(2, v.y & 0xffffu); ST_VT(3, v.y >> 16);
        ST_VT(4, v.z & 0xffffu); ST_VT(5, v.z >> 16); ST_VT(6, v.w & 0xffffu); ST_VT(7, v.w >> 16);
#undef ST_VT
    }
}

constexpr int SEL_NU = 1284;
__device__ const unsigned sel_unit_tab[SEL_NU] = {
    0xa0005u, 0xa0015u, 0xa0025u, 0xa0006u, 0xa0016u, 0xa0026u, 0xa0036u, 0xa0007u, 0x141407u, 0xa0017u, 0xa0027u, 0xa0037u, 0xa0047u, 0xa0008u, 0x141408u, 0xa0018u,
    0x141418u, 0xa0028u, 0xa0038u, 0xa0048u, 0xa0058u, 0xa0068u, 0xa0078u, 0xa0009u, 0x141409u, 0xa0019u, 0x141419u, 0xa0029u, 0x141429u, 0xa0039u, 0xa0049u, 0xa0059u,
    0xa0069u, 0xa0079u, 0xa0089u, 0xa0099u, 0xa00a9u, 0xa000au, 0x14140au, 0x1e280au, 0xa001au, 0x14141au, 0xa002au, 0x14142au, 0xa003au, 0x14143au, 0xa004au, 0x14144au,
    0xa005au, 0xa006au, 0xa007au, 0xa008au, 0xa009au, 0xa00aau, 0xa00bau, 0xa00cau, 0xa00dau, 0xa00eau, 0xa000bu, 0x14140bu, 0x1e280bu, 0xa001bu, 0x14141bu, 0x1e281bu,
    0xa002bu, 0x14142bu, 0xa003bu, 0x14143bu, 0xa004bu, 0x14144bu, 0xa005bu, 0x14145bu, 0xa006bu, 0xa007bu, 0xa008bu, 0xa009bu, 0xa00abu, 0xa00bbu, 0xa00cbu, 0xa00dbu,
    0xa00ebu, 0xa00fbu, 0xa010bu, 0xa011bu, 0xa012bu, 0xa013bu, 0xa014bu, 0xa000cu, 0x14140cu, 0x1e280cu, 0x283c0cu, 0xa001cu, 0x14141cu, 0x1e281cu, 0xa002cu, 0x14142cu,
    0x1e282cu, 0xa003cu, 0x14143cu, 0xa004cu, 0x14144cu, 0xa005cu, 0x14145cu, 0xa006cu, 0x14146cu, 0xa007cu, 0x14147cu, 0xa008cu, 0x14148cu, 0xa009cu, 0xa00acu, 0xa00bcu,
    0xa00ccu, 0xa00dcu, 0xa00ecu, 0xa00fcu, 0xa010cu, 0xa011cu, 0xa012cu, 0xa013cu, 0xa014cu, 0xa015cu, 0xa016cu, 0xa017cu, 0xa018cu, 0xa019cu, 0xa01acu, 0xa01bcu,
    0xa000du, 0x14140du, 0x1e280du, 0x283c0du, 0xa001du, 0x14141du, 0x1e281du, 0x283c1du, 0xa002du, 0x14142du, 0x1e282du, 0xa003du, 0x14143du, 0x1e283du, 0xa004du, 0x14144du,
    0x1e284du, 0xa005du, 0x14145du, 0xa006du, 0x14146du, 0xa007du, 0x14147du, 0xa008du, 0x14148du, 0xa009du, 0x14149du, 0xa00adu, 0x1414adu, 0xa00bdu, 0x1414bdu, 0xa00cdu,
    0xa00ddu, 0xa00edu, 0xa00fdu, 0xa010du, 0xa011du, 0xa012du, 0xa013du, 0xa014du, 0xa015du, 0xa016du, 0xa017du, 0xa018du, 0xa019du, 0xa01adu, 0xa01bdu, 0xa000eu,
    0x14140eu, 0x1e280eu, 0x283c0eu, 0xa001eu, 0x14141eu, 0x1e281eu, 0x283c1eu, 0xa002eu, 0x14142eu, 0x1e282eu, 0xa003eu, 0x14143eu, 0x1e283eu, 0xa004eu, 0x14144eu, 0x1e284eu,
    0xa005eu, 0x14145eu, 0xa006eu, 0x14146eu, 0xa007eu, 0x14147eu, 0xa008eu, 0x14148eu, 0xa009eu, 0x14149eu, 0xa00aeu, 0x1414aeu, 0xa00beu, 0x1414beu, 0xa00ceu, 0xa00deu,
    0xa00eeu, 0xa00feu, 0xa010eu, 0xa011eu, 0xa012eu, 0xa013eu, 0xa014eu, 0xa015eu, 0xa016eu, 0xa017eu, 0xa018eu, 0xa019eu, 0xa01aeu, 0xa01beu, 0xa000fu, 0x14140fu,
    0x1e280fu, 0x283c0fu, 0xa001fu, 0x14141fu, 0x1e281fu, 0x283c1fu, 0xa002fu, 0x14142fu, 0x1e282fu, 0xa003fu, 0x14143fu, 0x1e283fu, 0xa004fu, 0x14144fu, 0x1e284fu, 0xa005fu,
    0x14145fu, 0xa006fu, 0x14146fu, 0xa007fu, 0x14147fu, 0xa008fu, 0x14148fu, 0xa009fu, 0x14149fu, 0xa00afu, 0x1414afu, 0xa00bfu, 0x1414bfu, 0xa00cfu, 0xa00dfu, 0xa00efu,
    0xa00ffu, 0xa010fu, 0xa011fu, 0xa012fu, 0xa013fu, 0xa014fu, 0xa015fu, 0xa016fu, 0xa017fu, 0xa018fu, 0xa019fu, 0xa01afu, 0xa01bfu, 0x1e283cu, 0xa015bu, 0x14146bu,
    0x1e282bu, 0xa00fau, 0xfe0004u, 0xfe0057u, 0xfe016bu, 0xfe01ccu, 0xfe01cdu, 0xfe01ceu, 0xfe01cfu, 0x14149cu, 0x1e281au, 0xfe14cdu, 0xfe14ceu, 0xfe14cfu, 0xfe00b9u, 0xfe010au,
    0xfe017bu, 0xfe0014u, 0xfe285eu, 0xfe285fu, 0xfe01dcu, 0xfe01ddu, 0xfe01deu, 0xfe01dfu, 0xfe0088u, 0xfe1439u, 0xfe018bu, 0xfe1428u, 0xfe011au, 0xfe00c9u, 0xfe2809u, 0xfe285du,
    0xfe019bu, 0xfe0046u, 0xfe01ecu, 0xfe01edu, 0xfe01eeu, 0xfe01efu, 0xfe3c2eu, 0xfe3c2fu, 0xfe0067u, 0xfe012au, 0xfe14acu, 0xfe01abu, 0xfe14ddu, 0xfe14deu, 0xfe14dfu, 0xfe147bu,
    0xfe1417u, 0xfe0098u, 0xfe00d9u, 0xfe01fcu, 0xfe01fdu, 0xfe01feu, 0xfe01ffu, 0xfe01bbu, 0xfe013au, 0xfe145au, 0xfe0035u, 0xfe01cbu, 0xfe0024u, 0xfe014au, 0xfe00e9u, 0xfe020cu,
    0xfe020du, 0xfe020eu, 0xfe020fu, 0xfe01dbu, 0xfe00a8u, 0xfe0077u, 0xfe14bcu, 0xfe015au, 0xfe01ebu, 0xfe14edu, 0xfe14eeu, 0xfe14efu, 0xfe021cu, 0xfe021du, 0xfe021eu, 0xfe021fu,
    0xfe00f9u, 0xfe3c2du, 0xfe0056u, 0xfe01fbu, 0xfe016au, 0xfe3c1cu, 0xfe020bu, 0xfe00b8u, 0xfe148bu, 0xfe286eu, 0xfe286fu, 0xfe022cu, 0xfe022du, 0xfe022eu, 0xfe022fu, 0xfe0109u,
    0xfe017au, 0xfe284cu, 0xfe021bu, 0xfe1406u, 0xfe0087u, 0xfe022bu, 0xfe018au, 0xfe286du, 0xfe14ccu, 0xfe3c0bu, 0xfe0119u, 0xfe023cu, 0xfe023du, 0xfe023eu, 0xfe023fu, 0xfe00c8u,
    0xfe023bu, 0xfe0003u, 0xfe0013u, 0xfe14fdu, 0xfe14feu, 0xfe14ffu, 0xfe1449u, 0xfe019au, 0xfe0045u, 0xfe500eu, 0xfe500fu, 0xfe0066u, 0xfe0129u, 0xfe146au, 0xfe024bu, 0xfe024cu,
    0xfe024du, 0xfe024eu, 0xfe024fu, 0xfe01aau, 0xfe0097u, 0xfe00d8u, 0xfe01bau, 0xfe0139u, 0xfe149bu, 0xfe14dcu, 0xfe025bu, 0xfe025cu, 0xfe025du, 0xfe025eu, 0xfe025fu, 0xfe0034u,
    0xfe01cau, 0xfe283bu, 0xfe0149u, 0xfe00e8u, 0xfe0023u, 0xfe150du, 0xfe150eu, 0xfe150fu, 0xfe01dau, 0xfe00a7u, 0xfe282au, 0xfe0076u, 0xfe026bu, 0xfe026cu, 0xfe026du, 0xfe026eu,
    0xfe026fu, 0xfe1438u, 0xfe0159u, 0xfe01eau, 0xfe00f8u, 0xfe1427u, 0xfe0055u, 0xfe01fau, 0xfe0169u, 0xfe14ecu, 0xfe2819u, 0xfe027bu, 0xfe027cu, 0xfe027du, 0xfe027eu, 0xfe027fu,
    0xfe020au, 0xfe00b7u, 0xfe287eu, 0xfe287fu, 0xfe0108u, 0xfe0179u, 0xfe021au, 0xfe287du, 0xfe14abu, 0xfe151du, 0xfe151eu, 0xfe151fu, 0xfe0086u, 0xfe147au, 0xfe022au, 0xfe028bu,
    0xfe028cu, 0xfe028du, 0xfe028eu, 0xfe028fu, 0xfe0189u, 0xfe0118u, 0xfe00c7u, 0xfe023au, 0xfe500du, 0xfe0199u, 0xfe1416u, 0xfe0044u, 0xfe024au, 0xfe14fcu, 0xfe285cu, 0xfe0065u,
    0xfe029bu, 0xfe029cu, 0xfe029du, 0xfe029eu, 0xfe029fu, 0xfe0128u, 0xfe1459u, 0xfe01a9u, 0xfe025au, 0xfe0096u, 0xfe00d7u, 0xfe026au, 0xfe2808u, 0xfe01b9u, 0xfe0002u, 0xfe0012u,
    0xfe0138u, 0xfe027au, 0xfe02abu, 0xfe02acu, 0xfe02adu, 0xfe02aeu, 0xfe02afu, 0xfe152du, 0xfe152eu, 0xfe152fu, 0xfe01c9u, 0xfe0033u, 0xfe3c3eu, 0xfe3c3fu, 0xfe028au, 0xfe14bbu,
    0xfe0148u, 0xfe00e7u, 0xfe0022u, 0xfe029au, 0xfe01d9u, 0xfe150cu, 0xfe00a6u, 0xfe02aau, 0xfe0075u, 0xfe02bbu, 0xfe02bcu, 0xfe02bdu, 0xfe02beu, 0xfe02bfu, 0xfe0158u, 0xfe01e9u,
    0xfe02bau, 0xfe00f7u, 0xfe0054u, 0xfe01f9u, 0xfe148au, 0xfe0168u, 0xfe02cau, 0xfe02cbu, 0xfe02ccu, 0xfe02cdu, 0xfe02ceu, 0xfe02cfu, 0xfe0209u, 0xfe00b6u, 0xfe0107u, 0xfe0178u,
    0xfe153du, 0xfe153eu, 0xfe153fu, 0xfe0219u, 0xfe288du, 0xfe288eu, 0xfe288fu, 0xfe151cu, 0xfe0085u, 0xfe0229u, 0xfe0188u, 0xfe14cbu, 0xfe0117u, 0xfe02dau, 0xfe02dbu, 0xfe02dcu,
    0xfe02ddu, 0xfe02deu, 0xfe02dfu, 0xfe00c6u, 0xfe0239u, 0xfe0198u, 0xfe0249u, 0xfe0043u, 0xfe1448u, 0xfe3c3du, 0xfe0127u, 0xfe0064u, 0xfe01a8u, 0xfe0259u, 0xfe02eau, 0xfe02ebu,
    0xfe02ecu, 0xfe02edu, 0xfe02eeu, 0xfe02efu, 0xfe0095u, 0xfe00d6u, 0xfe3c2cu, 0xfe0269u, 0xfe1469u, 0xfe01b8u, 0xfe152cu, 0xfe0137u, 0xfe0279u, 0xfe284bu, 0xfe154du, 0xfe154eu,
    0xfe154fu, 0xfe01c8u, 0xfe0032u, 0xfe0289u, 0xfe0147u, 0xfe00e6u, 0xfe02fau, 0xfe02fbu, 0xfe02fcu, 0xfe02fdu, 0xfe02feu, 0xfe02ffu, 0xfe0299u, 0xfe0001u, 0xfe0011u, 0xfe0021u,
    0xfe01d8u, 0xfe149au, 0xfe3c1bu, 0xfe00a5u, 0xfe1405u, 0xfe286cu, 0xfe14dbu, 0xfe02a9u, 0xfe0074u, 0xfe0157u, 0xfe01e8u, 0xfe02b9u, 0xfe00f6u, 0xfe02c9u, 0xfe0053u, 0xfe01f8u,
    0xfe030au, 0xfe030bu, 0xfe030cu, 0xfe030du, 0xfe030eu, 0xfe030fu, 0xfe153cu, 0xfe0167u, 0xfe02d9u, 0xfe0208u, 0xfe00b5u, 0xfe02e9u, 0xfe0106u, 0xfe0177u, 0xfe0218u, 0xfe02f9u,
    0xfe1437u, 0xfe0084u, 0xfe0309u, 0xfe0228u, 0xfe155du, 0xfe155eu, 0xfe155fu, 0xfe031au, 0xfe031bu, 0xfe031cu, 0xfe031du, 0xfe031eu, 0xfe031fu, 0xfe0187u, 0xfe0319u, 0xfe0116u,
    0xfe1426u, 0xfe3c0au, 0xfe00c5u, 0xfe0238u, 0xfe0197u, 0xfe0248u, 0xfe0042u, 0xfe154cu, 0xfe14ebu, 0xfe0126u, 0xfe0063u, 0xfe289du, 0xfe289eu, 0xfe289fu, 0xfe01a7u, 0xfe0258u,
    0xfe0329u, 0xfe032au, 0xfe032bu, 0xfe032cu, 0xfe032du, 0xfe032eu, 0xfe032fu, 0xfe0094u, 0xfe501eu, 0xfe501fu, 0xfe00d5u, 0xfe0268u, 0xfe01b7u, 0xfe0136u, 0xfe0278u, 0xfe14aau,
    0xfe01c7u, 0xfe283au, 0xfe0288u, 0xfe0031u, 0xfe0146u, 0xfe00e5u, 0xfe1479u, 0xfe0298u, 0xfe01d7u, 0xfe0339u, 0xfe033au, 0xfe033bu, 0xfe033cu, 0xfe033du, 0xfe033eu, 0xfe033fu,
    0xfe00a4u, 0xfe02a8u, 0xfe0073u, 0xfe2829u, 0xfe0156u, 0xfe01e7u, 0xfe155cu, 0xfe156du, 0xfe156eu, 0xfe156fu, 0xfe02b8u, 0xfe0000u, 0xfe0010u, 0xfe0020u, 0xfe00f5u, 0xfe02c8u,
    0xfe01f7u, 0xfe0052u, 0xfe0166u, 0xfe02d8u, 0xfe0207u, 0xfe00b4u, 0xfe14fbu, 0xfe02e8u, 0xfe0105u, 0xfe0349u, 0xfe034au, 0xfe034bu, 0xfe034cu, 0xfe034du, 0xfe034eu, 0xfe034fu,
    0xfe0176u, 0xfe1458u, 0xfe0217u, 0xfe02f8u, 0xfe0083u, 0xfe0308u, 0xfe0227u, 0xfe0186u, 0xfe0318u, 0xfe0115u, 0xfe00c4u, 0xfe0237u, 0xfe0328u, 0xfe1415u, 0xfe0196u, 0xfe156cu,
    0xfe0338u, 0xfe0247u, 0xfe0041u, 0xfe0125u, 0xfe0359u, 0xfe035au, 0xfe035bu, 0xfe035cu, 0xfe035du, 0xfe035eu, 0xfe035fu, 0xfe0348u, 0xfe0062u, 0xfe01a6u, 0xfe0257u, 0xfe2818u,
    0xfe0358u, 0xfe0093u, 0xfe00d4u, 0xfe0267u, 0xfe01b6u, 0xfe0135u, 0xfe0277u, 0xfe287cu, 0xfe14bau, 0xfe157du, 0xfe157eu, 0xfe157fu, 0xfe01c6u, 0xfe0287u, 0xfe0145u, 0xfe00e4u,
    0xfe0297u, 0xfe01d6u, 0xfe0368u, 0xfe0369u, 0xfe036au, 0xfe036bu, 0xfe036cu, 0xfe036du, 0xfe036eu, 0xfe036fu, 0xfe150bu, 0xfe0030u, 0xfe00a3u, 0xfe02a7u, 0xfe0072u, 0xfe0155u,
    0xfe01e6u, 0xfe157cu, 0xfe02b7u, 0xfe00f4u, 0xfe3c4eu, 0xfe3c4fu, 0xfe02c7u, 0xfe01f6u, 0xfe0051u, 0xfe0165u, 0xfe02d7u, 0xfe0206u, 0xfe00b3u, 0xfe02e7u, 0xfe0104u, 0xfe0175u,
    0xfe0216u, 0xfe02f7u, 0xfe0378u, 0xfe0379u, 0xfe037au, 0xfe037bu, 0xfe037cu, 0xfe037du, 0xfe037eu, 0xfe037fu, 0xfe0307u, 0xfe0082u, 0xfe1489u, 0xfe0226u, 0xfe28adu, 0xfe28aeu,
    0xfe28afu, 0xfe0185u, 0xfe0317u, 0xfe0114u, 0xfe285bu, 0xfe0236u, 0xfe00c3u, 0xfe0327u, 0xfe0195u, 0xfe0337u, 0xfe0246u, 0xfe0124u, 0xfe0347u, 0xfe0061u, 0xfe0256u, 0xfe01a5u,
    0xfe0040u, 0xfe0357u, 0xfe0092u, 0xfe00d3u, 0xfe0266u, 0xfe0367u, 0xfe501du, 0xfe158cu, 0xfe158du, 0xfe158eu, 0xfe158fu, 0xfe01b5u, 0xfe0134u, 0xfe0377u, 0xfe0276u, 0xfe0388u,
    0xfe0389u, 0xfe038au, 0xfe038bu, 0xfe038cu, 0xfe038du, 0xfe038eu, 0xfe038fu, 0xfe151bu, 0xfe0387u, 0xfe01c5u, 0xfe0286u, 0xfe0144u, 0xfe00e3u, 0xfe0296u, 0xfe01d5u, 0xfe14cau,
    0xfe00a2u, 0xfe02a6u, 0xfe0071u, 0xfe0154u, 0xfe01e5u, 0xfe02b6u, 0xfe00f3u, 0xfe02c6u, 0xfe01f5u, 0xfe0164u, 0xfe02d6u, 0xfe0050u, 0xfe0205u, 0xfe00b2u, 0xfe02e6u, 0xfe0103u,
    0xfe0397u, 0xfe0398u, 0xfe0399u, 0xfe039au, 0xfe039bu, 0xfe039cu, 0xfe039du, 0xfe039eu, 0xfe039fu, 0xfe0174u, 0xfe0215u, 0xfe02f6u, 0xfe1447u, 0xfe0306u, 0xfe0081u, 0xfe0225u,
    0xfe0184u, 0xfe0316u, 0xfe0113u, 0xfe0235u, 0xfe00c2u, 0xfe0326u, 0xfe500cu, 0xfe0194u, 0xfe0336u, 0xfe0245u, 0xfe0346u, 0xfe0123u, 0xfe0255u, 0xfe01a4u, 0xfe0356u, 0xfe3c4du,
    0xfe0060u, 0xfe0091u, 0xfe00d2u, 0xfe0265u, 0xfe0366u, 0xfe01b4u, 0xfe1468u, 0xfe0133u, 0xfe0376u, 0xfe0275u, 0xfe0386u, 0xfe2807u, 0xfe01c4u, 0xfe152bu, 0xfe0285u, 0xfe03a7u,
    0xfe03a8u, 0xfe03a9u, 0xfe03aau, 0xfe03abu, 0xfe03acu, 0xfe03adu, 0xfe03aeu, 0xfe03afu, 0xfe0396u, 0xfe0143u, 0xfe00e2u, 0xfe03a6u, 0xfe0295u, 0xfe01d4u, 0xfe159cu, 0xfe159du,
    0xfe159eu, 0xfe159fu, 0xfe00a1u, 0xfe02a5u, 0xfe0153u, 0xfe01e4u, 0xfe02b5u, 0xfe0070u, 0xfe00f2u, 0xfe02c5u, 0xfe01f4u, 0xfe0163u, 0xfe02d5u, 0xfe0204u, 0xfe00b1u, 0xfe02e5u,
    0xfe0102u, 0xfe0173u, 0xfe0214u, 0xfe02f5u, 0xfe0305u, 0xfe0224u, 0xfe0183u, 0xfe0080u, 0xfe0315u, 0xfe0112u, 0xfe0234u, 0xfe00c1u, 0xfe0325u, 0xfe1499u, 0xfe0193u, 0xfe0335u,
    0xfe03b6u, 0xfe03b7u, 0xfe03b8u, 0xfe03b9u, 0xfe03bau, 0xfe03bbu, 0xfe03bcu, 0xfe03bdu, 0xfe03beu, 0xfe03bfu, 0xfe0244u, 0xfe0345u, 0xfe0122u, 0xfe14dau, 0xfe0254u, 0xfe01a3u,
    0xfe0355u, 0xfe00d1u, 0xfe0264u, 0xfe0365u, 0xfe0090u, 0xfe01b3u, 0xfe0132u, 0xfe0375u, 0xfe0274u, 0xfe0385u, 0xfe01c3u, 0xfe0284u, 0xfe0395u, 0xfe288cu, 0xfe0142u, 0xfe00e1u,
    0xfe03a5u, 0xfe0294u, 0xfe01d3u, 0xfe03b5u, 0xfe02a4u, 0xfe00a0u, 0xfe0152u, 0xfe01e3u, 0xfe02b4u, 0xfe00f1u, 0xfe02c4u, 0xfe01f3u, 0xfe0162u, 0xfe02d4u, 0xfe0203u, 0xfe02e4u,
    0xfe153bu, 0xfe00b0u, 0xfe0101u, 0xfe0172u, 0xfe0213u, 0xfe02f4u, 0xfe0304u, 0xfe0223u, 0xfe0182u, 0xfe03c5u, 0xfe03c6u, 0xfe03c7u, 0xfe03c8u, 0xfe03c9u, 0xfe03cau, 0xfe03cbu,
    0xfe03ccu, 0xfe03cdu, 0xfe03ceu, 0xfe03cfu, 0xfe0314u, 0xfe0111u, 0xfe0233u, 0xfe0324u, 0xfe00c0u, 0xfe0192u, 0xfe0334u, 0xfe0243u, 0xfe0344u, 0xfe0121u, 0xfe0253u, 0xfe01a2u,
    0xfe0354u, 0xfe0364u, 0xfe0263u, 0xfe00d0u, 0xfe01b2u, 0xfe0131u, 0xfe0374u, 0xfe0273u, 0xfe0384u, 0xfe01c2u, 0xfe0283u, 0xfe28bdu, 0xfe28beu, 0xfe28bfu, 0xfe0394u, 0xfe0141u,
    0xfe03a4u, 0xfe0293u, 0xfe00e0u, 0xfe01d2u, 0xfe15acu, 0xfe15adu, 0xfe15aeu, 0xfe15afu, 0xfe03b4u, 0xfe02a3u, 0xfe03c4u, 0xfe0151u, 0xfe01e2u, 0xfe02b3u, 0xfe1436u, 0xfe02c3u,
    0xfe00f0u, 0xfe01f2u, 0xfe0161u, 0xfe02d3u, 0xfe0202u, 0xfe02e3u, 0xfe0171u, 0xfe0100u, 0xfe0212u, 0xfe02f3u, 0xfe0303u, 0xfe0222u, 0xfe0181u, 0xfe0313u, 0xfe0110u, 0xfe0232u,
    0xfe0323u, 0xfe0191u, 0xfe0333u, 0xfe0242u, 0xfe0343u, 0xfe0120u, 0xfe0252u, 0xfe03d4u, 0xfe03d5u, 0xfe03d6u, 0xfe03d7u, 0xfe03d8u, 0xfe03d9u, 0xfe03dau, 0xfe03dbu, 0xfe03dcu,
    0xfe03ddu, 0xfe03deu, 0xfe03dfu, 0xfe01a1u, 0xfe0353u, 0xfe0363u, 0xfe0262u, 0xfe01b1u, 0xfe0373u, 0xfe0130u, 0xfe0272u, 0xfe0383u, 0xfe01c1u, 0xfe0282u, 0xfe0393u, 0xfe03a3u,
    0xfe0140u, 0xfe0292u, 0xfe01d1u, 0xfe03b3u, 0xfe02a2u, 0xfe03c3u, 0xfe01e1u, 0xfe03d3u, 0xfe0150u, 0xfe02b2u, 0xfe1425u, 0xfe02c2u, 0xfe01f1u, 0xfe0160u, 0xfe02d2u, 0xfe0201u,
    0xfe02e2u, 0xfe0170u, 0xfe0211u, 0xfe02f2u, 0xfe0302u, 0xfe0221u, 0xfe0180u, 0xfe0312u, 0xfe0231u, 0xfe0322u, 0xfe0190u, 0xfe0332u, 0xfe0241u, 0xfe0342u, 0xfe0251u, 0xfe01a0u,
    0xfe0352u, 0xfe0362u, 0xfe0261u, 0xfe154bu, 0xfe0372u, 0xfe01b0u, 0xfe14eau, 0xfe0271u, 0xfe0382u, 0xfe0281u, 0xfe0392u, 0xfe01c0u, 0xfe03a2u, 0xfe0291u, 0xfe03b2u, 0xfe01d0u,
    0xfe02a1u, 0xfe03c2u, 0xfe03d2u, 0xfe01e0u, 0xfe02b1u, 0xfe02c1u, 0xfe01f0u, 0xfe02d1u, 0xfe0200u, 0xfe02e1u, 0xfe02f1u, 0xfe0210u, 0xfe0301u, 0xfe0220u, 0xfe0311u, 0xfe0230u,
    0xfe0321u, 0xfe0331u, 0xfe0240u, 0xfe0341u, 0xfe0250u, 0xfe0351u, 0xfe03e2u, 0xfe03e3u, 0xfe03e4u, 0xfe03e5u, 0xfe03e6u, 0xfe03e7u, 0xfe03e8u, 0xfe03e9u, 0xfe03eau, 0xfe03ebu,
    0xfe03ecu, 0xfe03edu, 0xfe03eeu, 0xfe03efu, 0xfe0361u, 0xfe0260u, 0xfe0371u, 0xfe0270u, 0xfe0381u, 0xfe0391u, 0xfe0280u, 0xfe03a1u, 0xfe0290u, 0xfe03b1u, 0xfe02a0u, 0xfe03c1u,
    0xfe03d1u, 0xfe02b0u, 0xfe03e1u, 0xfe02c0u, 0xfe02d0u, 0xfe02e0u, 0xfe02f0u, 0xfe0300u, 0xfe0310u, 0xfe0320u, 0xfe0330u, 0xfe0340u, 0xfe0350u, 0xfe0360u, 0xfe0370u, 0xfe0380u,
    0xfe0390u, 0xfe03a0u, 0xfe03b0u, 0xfe03c0u, 0xfe03d0u, 0xfe03e0u, 0xfe284au, 0xfe14a9u, 0xfe15bcu, 0xfe15bdu, 0xfe15beu, 0xfe15bfu, 0xfe1478u, 0xfe3c1au, 0xfe14fau, 0xfe3c2bu,
    0xfe286bu, 0xfe155bu, 0xfe3c3cu, 0xfe289cu,
};
__device__ __forceinline__ void phase_attn_sel(const bf16* Q, const bf16* K, const bf16* V, const unsigned* lists, const gu32* lc, const float* qn2, bf16* part0, bf16* part12, float* lse, gu32* qctr, LAS unsigned char* lds, const int wave0, bool nostore = false) {
    int tid = wave0 * 64 + mk_lane(); asm volatile("" : "+v"(tid)); const int lane = tid & 63, wave = __builtin_amdgcn_readfirstlane(tid >> 6);
    const int fr = lane & 15, fq = lane >> 4;
    LAS unsigned* cw = (LAS unsigned*)(lds + A_CNT);
    LAS unsigned short* list = (LAS unsigned short*)(lds + A_LIST);
    constexpr int NU = SEL_NU;
    if (tid == 0) { cw[4] = __hip_atomic_fetch_add(qctr, 1u, RLX_AGENT); cw[0] = 0u; cw[1] = 0u; cw[2] = 0u; cw[3] = 0u; }
    __syncthreads();
    int unit = (int)cw[4];
    u32x4 kv[4], vv[4]; int pnt = 0; unsigned pl0 = 0u, pl1 = 0u;
#define SEL_PREFETCH(u_) do { const unsigned te2 = sel_unit_tab[u_]; const int h2 = (int)(te2 & 15u), n2 = (int)((te2 >> 4) & 63u), plo2 = (int)((te2 >> 10) & 127u); \
        kv_load(K, V, n2, h2, kv, vv, tid, wave, lane); pnt = (int)lc[h2 * 64 + n2]; \
        const unsigned* gl2 = lists + (size_t)h2 * LIST_HEAD + list_off(n2) + plo2 * 128; pl0 = gl2[tid]; pl1 = gl2[tid + NWAVES * 64]; } while (0)
    if (unit < NU) SEL_PREFETCH(unit);
    for (int par = 0; unit < NU; par ^= 1) {
        const unsigned te = sel_unit_tab[unit];
        const int h = (int)(te & 15u), n = (int)((te >> 4) & 63u), plo = (int)((te >> 10) & 127u), phi = (int)((te >> 17) & 127u);
        const float slope2 = head_slope2(h);
        const int ntot = pnt, e0 = plo * 128, e1 = phi == 127 ? ntot : min(ntot, phi * 128), N = max(e1 - e0, 0);
        { if (tid < N) list[tid] = (unsigned short)pl0;
          if (tid + NWAVES * 64 < N) list[tid + NWAVES * 64] = (unsigned short)pl1;
          const unsigned* gl = lists + (size_t)h * LIST_HEAD + list_off(n) + e0;
          for (int i = tid + 2 * NWAVES * 64; i < N; i += NWAVES * 64) list[i] = (unsigned short)gl[i]; }
        kv_write<true>(kv, vv, lds, cw + 2 + par, tid, wave, lane, slope2);
        if (tid == 0) { cw[4 + (par ^ 1)] = __hip_atomic_fetch_add(qctr, 1u, RLX_AGENT); cw[2 + (par ^ 1)] = 0u; }
        __syncthreads();
        const int ntiles = (N + 15) >> 4;
        const float kmax2 = __uint_as_float(cw[2 + par]);
        const int nunit = (int)cw[4 + (par ^ 1)];
        int tile = wave; bool valid = false; int t = 0, k = 0; bf16x8 q0 = {}, q1 = {}; float qn = 0.f;
        if (tile < ntiles) { int idx = tile * 16 + fr; valid = idx < N; if (!valid) idx = N - 1; const unsigned e = list[idx]; t = (int)(e & 0x3fffu); k = (int)(e >> 14);
            const bf16* qrow = Q + (size_t)t * D_ + h * 64; q0 = *(const bf16x8*)(qrow + 8 * fq); q1 = *(const bf16x8*)(qrow + 32 + 8 * fq); qn = qn2[(size_t)h * S_ + t]; }
        if (nunit < NU) SEL_PREFETCH(nunit);
        while (tile < ntiles) {
            const int ntile = tile + NWAVES; bool nvalid = false; int nt = 0, nk = 0; bf16x8 nq0 = {}, nq1 = {}; float nqn = 0.f;
            if (ntile < ntiles) { int idx = ntile * 16 + fr; nvalid = idx < N; if (!nvalid) idx = N - 1; const unsigned e = list[idx]; nt = (int)(e & 0x3fffu); nk = (int)(e >> 14);
                const bf16* qrow = Q + (size_t)nt * D_ + h * 64; nq0 = *(const bf16x8*)(qrow + 8 * fq); nq1 = *(const bf16x8*)(qrow + 32 + 8 * fq); nqn = qn2[(size_t)h * S_ + nt]; }
            const float m = __builtin_amdgcn_sqrtf(qn * kmax2) * 1.0005f + 0.01f;
            const float lcm = slope2 * (float)(n * BS + (BS - 1) - t) - m;
            f32x4 o[4]; float l;
            attn_tile<false, true>(lds + A_KS, lds + A_VT, q0, q1, lcm, slope2, 0, 8, fr, fq, o, l, lds + A_WROW);
            const bool lok = l > 1e-30f;
            const float il = lok ? 1.0f / l : 0.f;
            {
                LAS unsigned char* ost = lds + A_OST + wave * (16 * A_OPITCH);
#pragma unroll
                for (int dt = 0; dt < 4; ++dt) { u32x2 w; w.x = cvt_pk_bf16(o[dt][0] * il, o[dt][1] * il); w.y = cvt_pk_bf16(o[dt][2] * il, o[dt][3] * il); *(LAS u32x2*)(ost + fr * A_OPITCH + (16 * dt + 4 * fq) * 2) = w; }
                LDS_WAIT(); asm volatile("" ::: "memory");
#pragma unroll
                for (int i = 0; i < 2; ++i) {
                    const int q = (lane >> 3) + 8 * i, p = lane & 7;
                    const u32x4 v = *(LAS const u32x4*)(ost + q * A_OPITCH + p * 16);
                    const int tq = shi(t, q), kq = shi(k, q), vq = shi((int)valid, q);
                    if (vq && !nostore) *(u32x4*)((kq == 0 ? part0 : part12 + (size_t)(kq - 1) * S_ * D_) + (size_t)tq * D_ + h * 64 + p * 8) = v;
                }
                if (valid && fq == 0) lse[((size_t)k * S_ + t) * NH + h] = lok ? m + __builtin_amdgcn_logf(l) : -INFINITY;
                LDS_WAIT(); asm volatile("" ::: "memory");
            }
            tile = ntile; valid = nvalid; t = nt; k = nk; q0 = nq0; q1 = nq1; qn = nqn;
        }
        __syncthreads();
        unit = nunit;
    }
}
__device__ __forceinline__ void phase_attn_own(bf16* Q, const bf16* K, const bf16* V, const unsigned* sel, const float* qn2, const bf16* part0, const bf16* part12, const float* lse, LAS unsigned char* lds, const int wave0, bool nostore = false) {
    int tid = wave0 * 64 + mk_lane(); asm volatile("" : "+v"(tid)); const int lane = tid & 63, wave = __builtin_amdgcn_readfirstlane(tid >> 6);
    const int fr = lane & 15, fq = lane >> 4;
    LAS unsigned* cw = (LAS unsigned*)(lds + A_CNT);
    if (tid == 0) { cw[2] = 0u; cw[3] = 0u; }
    __syncthreads();
    int par = 0;
    u32x4 kv[4], vv[4];
    { const int u0 = (int)blockIdx.x; kv_load(K, V, u0 >> 4, ((u0 & 15) + 4 * (u0 >> 8)) & 15, kv, vv, tid, wave, lane); }
    for (int unit = blockIdx.x; unit < NBLK * NH; unit += gridDim.x, par ^= 1) {
        const int j = unit >> 4, h = ((unit & 15) + 4 * (unit >> 8)) & 15;
        const int nv = j < 3 ? j : 3;
        bf16x8 qf[2][2]; float qnv[2]; unsigned selv[2];
#pragma unroll
        for (int half = 0; half < 2; ++half) {
            const int t = j * BS + (half ? 15 - wave : wave) * 16 + fr;
            const bf16* qrow = Q + (size_t)t * D_ + h * 64;
            qf[half][0] = *(const bf16x8*)(qrow + 8 * fq); qf[half][1] = *(const bf16x8*)(qrow + 32 + 8 * fq);
            qnv[half] = qn2[(size_t)h * S_ + t];
            selv[half] = nv > 0 ? sel[(size_t)h * S_ + t] : 0xffffffffu;
        }
        kv_write(kv, vv, lds, cw + 2 + par, tid, wave, lane);
        if (tid == 0) cw[2 + (par ^ 1)] = 0u;
        __syncthreads();
        const float kmax2 = __uint_as_float(cw[2 + par]);
        const float slope2 = head_slope2(h);
#pragma unroll
        for (int half = 0; half < 2; ++half) {
            const int tile = half ? 15 - wave : wave;
            const int tq = tile * 16 + fr, t = j * BS + tq;
            const bf16x8 q0 = qf[half][0], q1 = qf[half][1];
            float lk[3]; u32x2 pv[3][4];
            const unsigned selw = selv[half];
#pragma unroll
            for (int k = 0; k < 3; ++k) {
                lk[k] = -INFINITY;
#pragma unroll
                for (int dt = 0; dt < 4; ++dt) pv[k][dt] = (u32x2){0u, 0u};
                if (k < nv && !alibi_dead(slope2, t, (int)((selw >> (8 * k)) & 0xffu))) {
                    lk[k] = lse[((size_t)k * S_ + t) * NH + h];
                    const bf16* pp = (k == 0 ? part0 : part12 + (size_t)(k - 1) * S_ * D_) + (size_t)t * D_ + h * 64 + 4 * fq;
#pragma unroll
                    for (int dt = 0; dt < 4; ++dt) pv[k][dt] = *(const u32x2*)(pp + dt * 16);
                }
            }
            if (half == 0) {
                const int nu = unit + (int)gridDim.x;
                if (nu < NBLK * NH) kv_load(K, V, nu >> 4, ((nu & 15) + 4 * (nu >> 8)) & 15, kv, vv, tid, wave, lane);
            }
            const float m = __builtin_amdgcn_sqrtf(qnv[half] * kmax2) * 1.0005f + 0.01f;
            const float lcm = slope2 * (float)(8 * fq - tq) - m;
            f32x4 o[4]; float l;
            attn_tile<true>(lds + A_KS, lds + A_VT, q0, q1, lcm, slope2, tq, (tile >> 1) + 1, fr, fq, o, l);
            const float lown = m + __builtin_amdgcn_logf(l), il = 1.0f / l;
            const float M = fmaxf(fmaxf(lown, lk[0]), fmaxf(lk[1], lk[2]));
            const float e0 = __builtin_amdgcn_exp2f(lown - M), w0 = e0 * il;
            float wsum = e0;
#pragma unroll
            for (int dt = 0; dt < 4; ++dt) o[dt] = o[dt] * w0;
#pragma unroll
            for (int k = 0; k < 3; ++k) {
                const float wk = __builtin_amdgcn_exp2f(lk[k] - M);
                wsum += wk;
#pragma unroll
                for (int dt = 0; dt < 4; ++dt) { o[dt][0] += wk * bf_lo(pv[k][dt].x); o[dt][1] += wk * bf_hi(pv[k][dt].x); o[dt][2] += wk * bf_lo(pv[k][dt].y); o[dt][3] += wk * bf_hi(pv[k][dt].y); }
            }
            const float inv = 1.0f / wsum;
            {
                LAS unsigned char* ost = lds + A_OST + wave * (16 * A_OPITCH);
#pragma unroll
                for (int dt = 0; dt < 4; ++dt) { u32x2 w; w.x = cvt_pk_bf16(o[dt][0] * inv, o[dt][1] * inv); w.y = cvt_pk_bf16(o[dt][2] * inv, o[dt][3] * inv); *(LAS u32x2*)(ost + fr * A_OPITCH + (16 * dt + 4 * fq) * 2) = w; }
                LDS_WAIT(); asm volatile("" ::: "memory");
#pragma unroll
                for (int i = 0; i < 2; ++i) {
                    const int q = (lane >> 3) + 8 * i, p = lane & 7;
                    const u32x4 v = *(LAS const u32x4*)(ost + q * A_OPITCH + p * 16);
                    if (!nostore) *(u32x4*)(Q + (size_t)(j * BS + tile * 16 + q) * D_ + h * 64 + p * 8) = v;
                }
                LDS_WAIT(); asm volatile("" ::: "memory");
            }
        }
        __syncthreads();
    }
}
__device__ __forceinline__ void phase_quant(const bf16* xb, const float* ssq, unsigned char* xq, float* xs, const int wave0, const int rb0 = -1) {
    int tid = wave0 * 64 + mk_lane(); asm volatile("" : "+v"(tid)); const int lane = tid & 63;
    for (int rb = rb0 >= 0 ? rb0 : (int)blockIdx.x; rb < (rb0 >= 0 ? rb0 + 1 : S_ / 64); rb += gridDim.x) {
        const int row = rb * 64 + (tid >> 3);
        u32x4 v[16];
#pragma unroll
        for (int i = 0; i < 16; ++i) v[i] = *(const u32x4*)(xb + (size_t)row * D_ + i * 64 + (tid & 7) * 8);
        const float rs = row_rstd(ssq, row);
        unsigned am = 0u;
#pragma unroll
        for (int i = 0; i < 16; ++i)
#pragma unroll
            for (int w = 0; w < 4; ++w) { const unsigned ww = v[i][w]; am = max(am, ww & 0x7fffu); am = max(am, (ww >> 16) & 0x7fffu); }
        am = max(am, shxu(am, 1, lane)); am = max(am, shxu(am, 2, lane)); am = max(am, shxu(am, 4, lane));
        const float amax = fmaxf(__uint_as_float(am << 16), 1e-20f), qs = 127.0f / amax;
        if ((tid & 7) == 0) { const float xv = amax * rs * (pg8::I8_IWQ / 127.0f); if (rb0 >= 0) __hip_atomic_store((GAS unsigned*)(xs + row), __float_as_uint(xv), RLX_AGENT); else xs[row] = xv; }
#pragma unroll
        for (int i = 0; i < 16; ++i) {
            unsigned o8[2];
#pragma unroll
            for (int hh = 0; hh < 2; ++hh) {
                const unsigned wa = hh ? v[i].z : v[i].x, wb = hh ? v[i].w : v[i].y;
                const int q0 = (int)__builtin_rintf(bf_lo(wa) * qs), q1 = (int)__builtin_rintf(bf_hi(wa) * qs), q2 = (int)__builtin_rintf(bf_lo(wb) * qs), q3 = (int)__builtin_rintf(bf_hi(wb) * qs);
                o8[hh] = ((unsigned)q0 & 255u) | (((unsigned)q1 & 255u) << 8) | (((unsigned)q2 & 255u) << 16) | (((unsigned)q3 & 255u) << 24);
            }
            if (rb0 >= 0) __hip_atomic_store((GAS unsigned long long*)(xq + (size_t)row * D_ + i * 64 + (tid & 7) * 8), ((unsigned long long)o8[1] << 32) | o8[0], RLX_AGENT);
            else { u32x2 ov; ov.x = o8[0]; ov.y = o8[1]; *(u32x2*)(xq + (size_t)row * D_ + i * 64 + (tid & 7) * 8) = ov; }
        }
    }
}
struct Args { const float* in[10]; float* out; unsigned char* ws; };
typedef const __attribute__((address_space(4))) Args* CArgsP;
__device__ __forceinline__ CArgsP KA() { unsigned long long p = (unsigned long long)__builtin_amdgcn_kernarg_segment_ptr(); asm volatile("" : "+s"(p)); return (CArgsP)p; }
__device__ __forceinline__ Ptrs make_ptrs(CArgsP a) { Ptrs P; P.x = a->in[0]; P.ln = a->in[1]; P.wg = a->in[2]; P.wu = a->in[3]; P.wd = a->in[4]; P.wqkv = a->in[5]; P.wo = a->in[6]; P.pw = a->in[7]; P.ps = a->in[8]; P.fg = a->in[9]; P.out = a->out; P.ws = a->ws; return P; }
__device__ __forceinline__ void phase_tailconv(LAS unsigned char* lds, int f, const int wave0) {
    int tid = wave0 * 64 + mk_lane(); asm volatile("" : "+v"(tid)); const int lane = tid & 63, wave = __builtin_amdgcn_readfirstlane(tid >> 6);
    const Ptrs P = make_ptrs(KA());
    const int ww = ((int)blockIdx.x - 128) * NWAVES + wave, n_ww = 128 * NWAVES;
    convert_items(P, lds, (f + 1) * IT_FFN, (f + 2) * IT_FFN, ww, n_ww, wave, lane);
    if (f == 0) convert_items(P, lds, 8 * IT_FFN + 2 * IT_ATT, IT_TOTAL, ww, n_ww, wave, lane);
    if (f == 2) convert_items(P, lds, 8 * IT_FFN + IT_ATT, 8 * IT_FFN + IT_ATT + IT_ATT / 2, ww, n_ww, wave, lane);
    if (f == 3) convert_items(P, lds, 8 * IT_FFN + IT_ATT + IT_ATT / 2, 8 * IT_FFN + 2 * IT_ATT, ww, n_ww, wave, lane);
}
__global__ void __launch_bounds__(NWAVES * 64, 2) mk_fwd(Args args) {
    extern __shared__ __attribute__((aligned(16))) unsigned char lds_raw[];
    LAS unsigned char* lds = (LAS unsigned char*)lds_raw;
    volatile LAS unsigned* MISC = (volatile LAS unsigned*)(lds + MISC_OFF);
    const int G = gridDim.x;
    gu32* ctl = (gu32*)(KA()->ws + WS_CTL);
    for (int u = threadIdx.x; u < (LDS_BYTES - LDSCTL_OFF) / 4; u += NWAVES * 64) ((LAS unsigned*)(lds + LDSCTL_OFF))[u] = 0u;
    __syncthreads();
    const int wave0 = __builtin_amdgcn_readfirstlane((int)threadIdx.x >> 6);
    XcdBarrier bar = xcd_barrier_post((unsigned*)(ctl + CW_BAR), MISC + 8, wave0 == 0 && mk_lane() == 0);
    (void)bar;
#define GRID_BAR() do { unsigned long long wsl_ = (unsigned long long)KA()->ws; XcdBarrier b_; b_.bar = (unsigned*)(wsl_ + WS_CTL) + CW_BAR; b_.x = xb_xcc_id(); \
        b_.st = (volatile LAS unsigned*)(lds + MISC_OFF) + 8; xcd_barrier(b_, wave0 == 0 && mk_lane() == 0); } while (0)
#define NREP(p) ((PROBE == (p)) ? 2 : 1)
    for (int rep = 0; rep < NREP(5); ++rep) { Ptrs P2 = make_ptrs(KA()); phase_prologue(P2, lds, wave0); GRID_BAR(); }
#define WSL() (KA()->ws)
#pragma clang loop unroll(full)
    for (int f = 0; f < 8; ++f) {
        for (int rep = 0; rep < NREP(3) * NREP(13); ++rep) {
            unsigned char* w = WSL();
            pg8::Gemm g{(const bf16*)(w + WS_XB), ws_wgu(w, f), S_, NGU, D_}; pg8::StaticOrder S; S.init(S_, NGU, G, (int)blockIdx.x);
            if ((I8_MASK >> f) & 1) {
                if (rep == 0 && f != 0) {
                    if (G == 256) {
                        pg8::Unit u0; S.next(0, u0);
                        phase_quant((const bf16*)(w + WS_XB), (const float*)(w + ((f & 3) == 3 ? WS_SSQB : WS_SSQ)), w + WS_XQ, (float*)(w + WS_XS), wave0, u0.pm * 4 + ((int)blockIdx.x >> 6));
                        asm volatile("s_waitcnt vmcnt(0)" ::: "memory");
                        __syncthreads();
                        if (wave0 == 0 && mk_lane() == 0) {
                            gu32* fl = (gu32*)(w + WS_CTL) + CW_RB + 16 * u0.pm + f;
                            __hip_atomic_fetch_add(fl, 1u, RLX_AGENT);
                            unsigned sp = 0u; while (__hip_atomic_load(fl, RLX_AGENT) < 4u) { __builtin_amdgcn_s_sleep(1); if (++sp > (1u << 22)) break; }
                            __builtin_amdgcn_fence(__ATOMIC_ACQUIRE, "agent"); asm volatile("s_waitcnt vmcnt(0)" ::: "memory");
                        }
                        __syncthreads();
                    } else { phase_quant((const bf16*)(w + WS_XB), (const float*)(w + ((f & 3) == 3 ? WS_SSQB : WS_SSQ)), w + WS_XQ, (float*)(w + WS_XS), wave0); GRID_BAR(); }
                }
                rstd_table<pg8::StaticOrder, true>(lds, (const float*)(w + WS_XS), S, wave0); }
            else rstd_table(lds, (const float*)(w + ((f & 3) == 3 ? WS_SSQB : WS_SSQ)), S, wave0);
#define GU_PHASE(EPI) do { EPI E{(bf16*)(w + ((PROBE == 13 && rep == 0) ? WS_END : WS_BIG)), (LAS const float*)(lds + RSTD_OFF), PROBE == 13 && rep == 0}; \
                if ((X8_MASK >> f) & 1) { pg8::Gemm g8 = g; g8.A = (const bf16*)(w + WS_X8); g8.K = D_ / 2; pg8::gemm_phase<EPI, pg8::StaticOrder, PG8_ALIGN, PG8_SP2, true, pg8::F8_SCALE_WGU, pg8::F8_SCALE_X>(lds, g8, S, E, wave0); } \
                else pg8::gemm_phase<EPI, pg8::StaticOrder, PG8_ALIGN, PG8_SP2>(lds, g, S, E, wave0); } while (0)
#define GU_PHASE_I8(EPI) do { EPI E{(bf16*)(w + WS_BIG), (LAS const float*)(lds + RSTD_OFF), 0}; \
                pg8::Gemm g8 = g; g8.A = (const bf16*)(w + WS_XQ); g8.K = D_ / 2; pg8::gemm_phase<EPI, pg8::StaticOrder, PG8_ALIGN, PG8_SP2, false, 0, 0, true>(lds, g8, S, E, wave0); } while (0)
            if ((I8_MASK >> f) & 1) { if ((FP8_MASK >> f) & 1) GU_PHASE_I8(EpiSwiGLU_F8I8); else GU_PHASE_I8(EpiSwiGLU_I8); }
            else if ((FP8_MASK >> f) & 1) GU_PHASE(EpiSwiGLUT<true>); else GU_PHASE(EpiSwiGLU);
#undef GU_PHASE
#undef GU_PHASE_I8
            if (TAILCONV && G == 256 && rep == 0 && f < 7 && blockIdx.x >= 128) phase_tailconv(lds, f, wave0);
            GRID_BAR();
        }
        for (int rep = 0; rep < NREP(4) * NREP(14) * NREP(24) * NREP(25); ++rep) {
            unsigned char* w = WSL();
            pg8::Gemm g{(const bf16*)(w + WS_BIG), ws_wd(w, f), S_, D_, FF_}; pg8::StaticOrder S; S.init(S_, D_, G, (int)blockIdx.x);
            EpiResid<false, 1> E{(bf16*)(w + WS_XB), (float*)(w + WS_SSQ), nullptr, (f & 3) == 2 ? (bf16*)(w + WS_HALO) : nullptr, ((f & 1) && f < 7 && ((X8_MASK >> (f + 1)) & 1)) ? w + WS_X8 : nullptr};
            if ((FP8_MASK >> f) & 1) { pg8::Gemm g8 = g; g8.K = FF_ / 2; pg8::gemm_phase<EpiResid<false, 1>, pg8::StaticOrder, false, PG8_SP2, true>(lds, g8, S, E, wave0); }
            else pg8::gemm_phase<EpiResid<false, 1>, pg8::StaticOrder, false, PG8_SP2>(lds, g, S, E, wave0);
            GRID_BAR();
        }
        if ((f & 1) == 0) {
            const int L = f >> 1, mi = L >> 1;
            if ((L & 1) == 0) {
                for (int rep = 0; rep < NREP(6); ++rep) {
                    unsigned char* w = WSL();
                    pg8::Gemm g{(const bf16*)(w + WS_XB), ws_wqkv(w, mi), S_, 3 * D_, D_}; pg8::StaticOrder S; S.init(S_, 3 * D_, G, (int)blockIdx.x);
                    rstd_table(lds, (const float*)(w + WS_SSQ), S, wave0);
                    EpiQKV E{(bf16*)(w + WS_BIG), (LAS const float*)(lds + RSTD_OFF), (float*)(w + WS_KPART)};
                    pg8::gemm_phase<EpiQKV, pg8::StaticOrder, PG8_ALIGN, PG8_SP2>(lds, g, S, E, wave0);
                    GRID_BAR();
                }
                for (int rep = 0; rep < NREP(1); ++rep) {
                    for (int r2 = 0; r2 < NREP(7); ++r2) { unsigned char* w = WSL(); phase_gate((const bf16*)(w + WS_BIG), (const float*)(w + WS_KPART), (unsigned*)(w + WS_SEL), (float*)(w + WS_QN2), (unsigned*)(w + WS_WFFN + (size_t)(mi == 0 ? 4 : 2) * WFFN_STRIDE), (gu32*)(w + WS_CTL) + CW_LC + 1024 * mi, lds, wave0); GRID_BAR(); }
                    for (int r2 = 0; r2 < NREP(8) * NREP(18) * NREP(28) * NREP(29); ++r2) { unsigned char* w = WSL(); bf16* B = (bf16*)(w + WS_BIG);
                      phase_attn_sel(B, B + (size_t)S_ * D_, B + (size_t)2 * S_ * D_, (const unsigned*)(w + WS_WFFN + (size_t)(mi == 0 ? 4 : 2) * WFFN_STRIDE), (const gu32*)(w + WS_CTL) + CW_LC + 1024 * mi, (const float*)(w + WS_QN2), (bf16*)(w + WS_WFFN + (size_t)(mi == 0 ? 2 : 0) * WFFN_STRIDE), (bf16*)(w + WS_XB + 32 * MiB), (float*)(w + WS_LSE), (gu32*)(w + WS_CTL) + CW_QA + 64 * (mi + 2 * (rep + r2)), lds, wave0, (PROBE == 18 || PROBE == 28 || PROBE == 29) && r2 == 0 && ((const unsigned*)(w + WS_CTL))[2] == 0u);
                      GRID_BAR(); }
                    for (int r2 = 0; r2 < NREP(9); ++r2) { unsigned char* w = WSL(); bf16* B = (bf16*)(w + WS_BIG);
                      phase_attn_own(B, B + (size_t)S_ * D_, B + (size_t)2 * S_ * D_, (const unsigned*)(w + WS_SEL), (const float*)(w + WS_QN2), (const bf16*)(w + WS_WFFN + (size_t)(mi == 0 ? 2 : 0) * WFFN_STRIDE), (const bf16*)(w + WS_XB + 32 * MiB), (const float*)(w + WS_LSE), lds, wave0, (rep + r2 + 1) < NREP(1) * NREP(9));
                      GRID_BAR(); }
                }
                for (int rep = 0; rep < NREP(6); ++rep) {
                    unsigned char* w = WSL();
                    pg8::Gemm g{(const bf16*)(w + WS_BIG), ws_wo(w, mi), S_, D_, D_}; pg8::StaticOrder S; S.init(S_, D_, G, (int)blockIdx.x);
                    EpiResid<false, 2> E{(bf16*)(w + WS_XB), (float*)(w + WS_SSQ), nullptr, nullptr, ((X8_MASK >> (f + 1)) & 1) ? w + WS_X8 : nullptr};
                    pg8::gemm_phase<EpiResid<false, 2>, pg8::StaticOrder, false, PG8_SP2>(lds, g, S, E, wave0);
                    GRID_BAR();
                }
            } else {
                for (int rep = 0; rep < NREP(2); ++rep) {
                    { unsigned char* w = WSL(); phase_pool_elem((const bf16*)(w + WS_XB), (const float*)(w + WS_SSQ), KA()->in[1] + (L * 3 + 1) * D_, (bf16*)(w + WS_BIG), (const bf16*)(w + WS_HALO), lds, wave0); }
                    {
                        unsigned char* w = WSL();
                        pg8::Gemm g{(const bf16*)(w + WS_BIG), ws_wp(w, mi), 4 * S_, 256, 256}; PoolOrder S{G, (int)blockIdx.x};
                        if ((X8_MASK >> (f + 1)) & 1) { EpiResid<true, 2, true> E{(bf16*)(w + WS_XB), (float*)(w + WS_SSQB), KA()->in[8] + mi * D_, nullptr, w + WS_X8};
                            pg8::gemm_phase<EpiResid<true, 2, true>, PoolOrder, false, PG8_SP2>(lds, g, S, E, wave0); }
                        else { EpiResid<true, 2, false> E{(bf16*)(w + WS_XB), (float*)(w + WS_SSQB), KA()->in[8] + mi * D_, nullptr, nullptr};
                            pg8::gemm_phase<EpiResid<true, 2, false>, PoolOrder, false, PG8_SP2>(lds, g, S, E, wave0); }
                    }
                    GRID_BAR();
                }
            }
        }
    }
    { Ptrs P2 = make_ptrs(KA()); const bool poison = (__hip_atomic_load((gu32*)(P2.ws + WS_CTL) + CW_BAR + XB_TMO, RLX_AGENT) != 0u) || (G != 256);
      phase_final(P2, poison, wave0); }
}

extern "C" void kernel_launch(void* const* d_in, const int* in_sizes, int n_in, void* d_out, int out_size, void* d_ws, size_t ws_size, hipStream_t stream) {
    static int grid = 0;
    if (grid == 0) {
        if (n_in != 10 || in_sizes[0] != S_ * D_ || out_size != S_ * D_ || ws_size < WS_END) { fprintf(stderr, "kernel_launch: unexpected shapes / workspace (%zu < %zu)\n", ws_size, (size_t)WS_END); grid = -1; return; }
        int dev = 0, cus = 0, per_cu = 0;
        if (hipGetDevice(&dev) != hipSuccess || hipDeviceGetAttribute(&cus, hipDeviceAttributeMultiprocessorCount, dev) != hipSuccess) { grid = -1; return; }
        if (hipFuncSetAttribute((const void*)mk_fwd, hipFuncAttributeMaxDynamicSharedMemorySize, LDS_BYTES) != hipSuccess) { fprintf(stderr, "kernel_launch: hipFuncSetAttribute failed\n"); grid = -1; return; }
        if (hipOccupancyMaxActiveBlocksPerMultiprocessor(&per_cu, (const void*)mk_fwd, NWAVES * 64, LDS_BYTES) != hipSuccess || per_cu < 1) { fprintf(stderr, "kernel_launch: occupancy query says %d\n", per_cu); }
        (void)hipGetLastError();
        grid = cus;
    }
    if (grid < 0) return;
    if (hipMemsetAsync((char*)d_ws + WS_CTL, 0, CTL_ZERO_BYTES, stream) != hipSuccess) return;
    Args a{};
    for (int i = 0; i < 10; ++i) a.in[i] = (const float*)d_in[i];
    a.out = (float*)d_out; a.ws = (unsigned char*)d_ws;
    hipLaunchKernelGGL(mk_fwd, dim3(grid), dim3(NWAVES * 64), LDS_BYTES, stream, a);
}
```

```cpp
#include <hip/hip_runtime.h>
#include <cstdio>
#include <cstdint>
#include <type_traits>
__device__ __forceinline__ float shx(float v, int mask, int lane) { return __builtin_bit_cast(float, __builtin_amdgcn_ds_bpermute((lane ^ mask) << 2, __builtin_bit_cast(int, v))); }
__device__ __forceinline__ unsigned shxu(unsigned v, int mask, int lane) { return (unsigned)__builtin_amdgcn_ds_bpermute((lane ^ mask) << 2, (int)v); }
__device__ __forceinline__ int shi(int v, int src) { return __builtin_amdgcn_ds_bpermute(src << 2, v); }
__device__ __forceinline__ int mk_lane() { int l; asm volatile("v_mbcnt_lo_u32_b32 %0, -1, 0\n\tv_mbcnt_hi_u32_b32 %0, -1, %0" : "=v"(l)); return l; }
namespace pg8 {
#define PG8_LAS __attribute__((address_space(3)))
typedef unsigned short bf16_t;
typedef short bf16x8 __attribute__((ext_vector_type(8)));
typedef float f32x4 __attribute__((ext_vector_type(4)));
typedef unsigned u32x4 __attribute__((ext_vector_type(4)));
typedef int i32x4 __attribute__((ext_vector_type(4)));
typedef int i32x8 __attribute__((ext_vector_type(8)));
constexpr int F8_SCALE_H = 0x7c7c7c7c, F8_SCALE_W = 0x76767676;
constexpr int F8_SCALE_X = 0x7c7c7c7c, F8_SCALE_WGU = 0x77777777;
constexpr float I8_WQ = 127.0f * 32.0f / 3.9f, I8_IWQ = 1.0f / I8_WQ;
constexpr int BM = 256, BK = 64, HALF = 128, HTB = HALF * BK * 2  , STAGE_BYTES = 8 * HTB, NXCD = 8, WGM = 8;

__host__ __device__ __forceinline__ int lds_byte(int r, int c) { const int st = (r >> 4) * 2 + (c >> 5), rr = r & 15, cc = c & 31, ob = rr * 64 + cc * 2; return st * 1024 + (ob ^ (((ob >> 9) & 1) << 5)); }
__host__ __device__ __forceinline__ void stage_rc(int b, int& R, int& C) { const int st = b / 1024, sb = b % 1024, swz = sb ^ (((sb >> 9) & 1) << 5); R = (st >> 1) * 16 + swz / 64; C = (st & 1) * 32 + (swz % 64) / 2; }
__host__ __device__ __forceinline__ int perm32(int rho) { const int n = rho >> 4, i = rho & 15; return 8 * (i >> 2) + 4 * n + (i & 3); }

struct Unit { int pm, pn, idx; };
struct Gemm { const bf16_t* A; const bf16_t* Bt; int M, N, K; };

struct StaticOrder {
    int nM, nN, nwg, G, c;
    __host__ __device__ __forceinline__ void init(int M, int N, int G_, int c_) { nM = M / BM; nN = N / BM; nwg = nM * nN; G = G_; c = c_; }
    __host__ __device__ __forceinline__ bool next(int i, Unit& u) const {
        const long L = (long)i * G + c; if (L >= nwg) return false;
        int wgid = (int)L; { const int q = nwg / NXCD, r = nwg % NXCD, xcd = wgid % NXCD, off = wgid / NXCD; wgid = (xcd < r ? xcd * (q + 1) : r * (q + 1) + (xcd - r) * q) + off; }
        const int nig = WGM * nN, gid = wgid / nig, fm = gid * WGM, gsz = (nM - fm) < WGM ? (nM - fm) : WGM;
        u.pm = fm + ((wgid % nig) % gsz); u.pn = (wgid % nig) / gsz; u.idx = i; return true;
    }
    __device__ __forceinline__ void a_ready(const Unit&) const {}
    __device__ __forceinline__ void done(const Unit&) const {}
};

__device__ __forceinline__ unsigned cvt_pk_bf16(float lo, float hi) { unsigned r; asm volatile("v_cvt_pk_bf16_f32 %0, %1, %2" : "=v"(r) : "v"(lo), "v"(hi)); return r; }
typedef float f32x2 __attribute__((ext_vector_type(2)));
template <class Epi, class Sched, bool ALIGN_EPI = false, bool SP2 = false, bool FP8 = false, int SW = F8_SCALE_W, int SH = F8_SCALE_H, bool I8 = false>
__device__ __forceinline__ void gemm_phase(PG8_LAS unsigned char* lds, const Gemm g, const Sched& S, const Epi& E, const int wave0) {
    int tid_ = wave0 * 64 + mk_lane(); asm volatile("" : "+v"(tid_));
    const int tid = tid_, wid = __builtin_amdgcn_readfirstlane(tid >> 6), lane = tid & 63, wr = wid >> 2, wc = wid & 3, fr = lane & 15, fq = lane >> 4;
    const int K = g.K, nt = K / BK;
    unsigned voffA[2], voffB[2];
#pragma unroll
    for (int i = 0; i < 2; ++i) { int R, C; stage_rc(tid * 16 + i * 8192, R, C); const int Rb = Epi::PERM ? ((R & ~31) + perm32(R & 31)) : R;
        voffA[i] = (unsigned)(R * K + C) * 2u; voffB[i] = (unsigned)(Rb * K + C) * 2u; }
    const size_t kstep = (size_t)(BK * 2);
    const size_t hstep = (size_t)HALF * K * 2;
    const size_t tstep = 2 * hstep;
    const unsigned ldsw = (unsigned)wid * 1024u;
    const int aoff = lds_byte(wr * 64 + fr, fq * 8), boff = lds_byte(wc * 32 + fr, fq * 8);
#define PG8_SA(b, h) (((b) * 2 + (h)) * HTB)
#define PG8_SB(b, h) ((4 + (b) * 2 + (h)) * HTB)
#define PG8_STAGE(bufoff, gbase, voff) do { _Pragma("unroll") for (int _i = 0; _i < 2; ++_i) \
        __builtin_amdgcn_global_load_lds((const unsigned*)((const char*)(gbase) + (voff)[_i]), (PG8_LAS unsigned*)(lds + (bufoff) + ldsw + _i * 8192), 16, 0, 0); } while (0)
#define PG8_LDA(dst, b, h) do { _Pragma("unroll") for (int m = 0; m < 4; ++m) { if constexpr (FP8) { dst##8[m].lo = *(const PG8_LAS i32x4*)(lds + PG8_SA(b, h) + aoff + m * 2048); dst##8[m].hi = *(const PG8_LAS i32x4*)(lds + PG8_SA(b, h) + aoff + m * 2048 + 1024); } \
        else { _Pragma("unroll") for (int k = 0; k < 2; ++k) dst[m][k] = *(const PG8_LAS bf16x8*)(lds + PG8_SA(b, h) + aoff + m * 2048 + k * 1024); } } } while (0)
#define PG8_LDB(dst, b, h) do { _Pragma("unroll") for (int n = 0; n < 2; ++n) { if constexpr (FP8) { dst##8[n].lo = *(const PG8_LAS i32x4*)(lds + PG8_SB(b, h) + boff + n * 2048); dst##8[n].hi = *(const PG8_LAS i32x4*)(lds + PG8_SB(b, h) + boff + n * 2048 + 1024); } \
        else { _Pragma("unroll") for (int k = 0; k < 2; ++k) dst[n][k] = *(const PG8_LAS bf16x8*)(lds + PG8_SB(b, h) + boff + n * 2048 + k * 1024); } } } while (0)
#define PG8_MMA(ai, bj, At, Bt) do { __builtin_amdgcn_s_setprio(1); _Pragma("unroll") for (int m = 0; m < 4; ++m) _Pragma("unroll") for (int n = 0; n < 2; ++n) { \
        if constexpr (FP8) asm volatile("v_mfma_scale_f32_16x16x128_f8f6f4 %0, %1, %2, %0, %3, %4 op_sel_hi:[0,0,0]" : "+v"(acc[ai][bj][m][n]) : "v"(Bt##8[n]), "v"(At##8[m]), "v"(f8sw), "v"(f8sh)); \
        else if constexpr (I8) { _Pragma("unroll") for (int k = 0; k < 2; ++k) acc[ai][bj][m][n] = __builtin_bit_cast(f32x4, __builtin_amdgcn_mfma_i32_16x16x64_i8(__builtin_bit_cast(i32x4, Bt[n][k]), __builtin_bit_cast(i32x4, At[m][k]), __builtin_bit_cast(i32x4, acc[ai][bj][m][n]), 0, 0, 0)); } \
        else { _Pragma("unroll") for (int k = 0; k < 2; ++k) acc[ai][bj][m][n] = __builtin_amdgcn_mfma_f32_16x16x32_bf16(Bt[n][k], At[m][k], acc[ai][bj][m][n], 0, 0, 0); } } \
        __builtin_amdgcn_s_setprio(0); } while (0)
#define PG8_WAIT_V(n) asm volatile("s_waitcnt vmcnt(" #n ")" ::: "memory")
#define PG8_WAIT_L(n) asm volatile("s_waitcnt lgkmcnt(" #n ")" ::: "memory")
#define PG8_BAR __builtin_amdgcn_s_barrier()
#define PG8_SCHED __builtin_amdgcn_sched_barrier(0)
    Unit cur, nxt; int ui = 0;
    if (!S.next(0, cur)) return;
    f32x4 acc[2][2][4][2];
    typename Epi::Pre pre;
    if constexpr (Epi::PRELOAD) E.pre_issue(pre, cur, wr, wc, fr, fq);
    else {
#pragma unroll
    for (int a = 0; a < 2; ++a)
#pragma unroll
        for (int b = 0; b < 2; ++b)
#pragma unroll
            for (int m = 0; m < 4; ++m)
#pragma unroll
                for (int n = 0; n < 2; ++n) acc[a][b][m][n] = (f32x4){0.f, 0.f, 0.f, 0.f};
    }
    bf16x8 At[4][2], B0[2][2], B1[2][2]; i32x8 At8[4], B08[2], B18[2];
    int f8sw = SW, f8sh = SH; if constexpr (FP8) asm volatile("" : "+v"(f8sw), "+v"(f8sh));
    const char* cA = (const char*)g.A + (size_t)cur.pm * tstep; const char* cB = (const char*)g.Bt + (size_t)cur.pn * tstep;
    S.a_ready(cur);
    if constexpr (SP2) {
        PG8_STAGE(PG8_SB(0, 0), cB, voffB); PG8_STAGE(PG8_SB(0, 1), cB + hstep, voffB); PG8_STAGE(PG8_SA(0, 0), cA, voffA); PG8_STAGE(PG8_SA(0, 1), cA + hstep, voffA);
        if constexpr (Epi::PRELOAD) E.pre_finish(acc, pre);
        if (wr == 1) PG8_BAR;
        PG8_WAIT_V(2); PG8_BAR;
        PG8_STAGE(PG8_SB(1, 0), cB + kstep, voffB); PG8_STAGE(PG8_SA(1, 0), cA + kstep, voffA); PG8_STAGE(PG8_SB(1, 1), cB + hstep + kstep, voffB);
        PG8_WAIT_V(6); PG8_BAR;
    } else {
        PG8_STAGE(PG8_SB(0, 0), cB, voffB); PG8_STAGE(PG8_SA(0, 0), cA, voffA); PG8_STAGE(PG8_SB(0, 1), cB + hstep, voffB); PG8_STAGE(PG8_SA(0, 1), cA + hstep, voffA);
        if constexpr (Epi::PRELOAD) E.pre_finish(acc, pre);
        if (wr == 1) PG8_BAR;
        PG8_WAIT_V(4); PG8_BAR;
        PG8_STAGE(PG8_SB(1, 0), cB + kstep, voffB); PG8_STAGE(PG8_SA(1, 0), cA + kstep, voffA); PG8_STAGE(PG8_SB(1, 1), cB + hstep + kstep, voffB);
        PG8_WAIT_V(6); PG8_BAR;
    }
    for (;;) {
        const bool has_next = S.next(ui + 1, nxt);
        const char* nA = has_next ? (const char*)g.A + (size_t)nxt.pm * tstep : cA; const char* nB = has_next ? (const char*)g.Bt + (size_t)nxt.pn * tstep : cB;
        for (int t = 0; t < nt; t += 2) {
            const bool last = (t == nt - 2);
            const char* a1 = cA + (size_t)(t + 1) * kstep;
            const char* a2 = last ? nA : cA + (size_t)(t + 2) * kstep; const char* b2 = last ? nB : cB + (size_t)(t + 2) * kstep;
            const char* a3 = a2 + kstep; const char* b3 = b2 + kstep;
            if (last && has_next) S.a_ready(nxt);
            if constexpr (SP2) {
            PG8_LDB(B0, 0, 0); PG8_LDB(B1, 0, 1); PG8_SCHED; PG8_LDA(At, 0, 0); PG8_STAGE(PG8_SA(1, 1), a1 + hstep, voffA);
            PG8_WAIT_V(8); PG8_WAIT_L(0); PG8_BAR; PG8_MMA(0, 0, At, B0); PG8_MMA(0, 1, At, B1); PG8_BAR; PG8_SCHED;
            PG8_LDA(At, 0, 1); PG8_STAGE(PG8_SB(0, 0), b2, voffB); PG8_STAGE(PG8_SB(0, 1), b2 + hstep, voffB); PG8_STAGE(PG8_SA(0, 0), a2, voffA);
            PG8_WAIT_V(8); PG8_WAIT_L(0); PG8_BAR; PG8_MMA(1, 0, At, B0); PG8_MMA(1, 1, At, B1); PG8_BAR; PG8_SCHED;
            PG8_LDB(B0, 1, 0); PG8_LDB(B1, 1, 1); PG8_SCHED; PG8_LDA(At, 1, 0); PG8_STAGE(PG8_SA(0, 1), a2 + hstep, voffA);
            PG8_WAIT_V(8); PG8_WAIT_L(0); PG8_BAR; PG8_MMA(0, 0, At, B0); PG8_MMA(0, 1, At, B1); PG8_BAR; PG8_SCHED;
            PG8_LDA(At, 1, 1); PG8_STAGE(PG8_SB(1, 0), b3, voffB); PG8_STAGE(PG8_SB(1, 1), b3 + hstep, voffB); PG8_STAGE(PG8_SA(1, 0), a3, voffA);
            PG8_WAIT_V(8); PG8_WAIT_L(0); PG8_BAR; PG8_MMA(1, 0, At, B0); PG8_MMA(1, 1, At, B1); PG8_BAR; PG8_SCHED;
            } else {
            PG8_LDB(B0, 0, 0); PG8_SCHED; PG8_LDA(At, 0, 0); PG8_STAGE(PG8_SA(1, 1), a1 + hstep, voffA);
            PG8_WAIT_L(8); PG8_BAR; PG8_WAIT_L(0); PG8_MMA(0, 0, At, B0); PG8_BAR; PG8_SCHED;
            PG8_LDB(B1, 0, 1); PG8_STAGE(PG8_SB(0, 0), b2, voffB);
            PG8_BAR; PG8_WAIT_L(0); PG8_MMA(0, 1, At, B1); PG8_BAR;
            PG8_LDA(At, 0, 1); PG8_STAGE(PG8_SA(0, 0), a2, voffA);
            PG8_BAR; PG8_WAIT_L(0); PG8_MMA(1, 0, At, B0); PG8_BAR; PG8_SCHED;
            PG8_STAGE(PG8_SB(0, 1), b2 + hstep, voffB);
            PG8_WAIT_V(6); PG8_BAR; PG8_MMA(1, 1, At, B1); PG8_BAR;
            PG8_LDB(B0, 1, 0); PG8_SCHED; PG8_LDA(At, 1, 0); PG8_STAGE(PG8_SA(0, 1), a2 + hstep, voffA);
            PG8_WAIT_L(8); PG8_BAR; PG8_WAIT_L(0); PG8_MMA(0, 0, At, B0); PG8_BAR; PG8_SCHED;
            PG8_LDB(B1, 1, 1); PG8_STAGE(PG8_SB(1, 0), b3, voffB);
            PG8_BAR; PG8_WAIT_L(0); PG8_MMA(0, 1, At, B1); PG8_BAR;
            PG8_LDA(At, 1, 1); PG8_STAGE(PG8_SA(1, 0), a3, voffA);
            PG8_BAR; PG8_WAIT_L(0); PG8_MMA(1, 0, At, B0); PG8_BAR; PG8_SCHED;
            PG8_STAGE(PG8_SB(1, 1), b3 + hstep, voffB);
            PG8_WAIT_V(6); PG8_BAR; PG8_MMA(1, 1, At, B1); PG8_BAR;
            }
        }
        if constexpr (FP8) asm volatile("s_nop 15\n\ts_nop 15" ::: "memory");
        if constexpr (ALIGN_EPI) { if (wr == 0) PG8_BAR; }
        if constexpr (!Epi::AFTER_DRAIN) { E(acc, cur, wr, wc, fr, fq); S.done(cur); }
        if (!has_next) break;
        if constexpr (Epi::PRELOAD) { typename Epi::Pre pre2; E.pre_issue(pre2, nxt, wr, wc, fr, fq); E.pre_finish(acc, pre2); }
        else {
#pragma unroll
        for (int a = 0; a < 2; ++a)
#pragma unroll
            for (int b = 0; b < 2; ++b)
#pragma unroll
                for (int m = 0; m < 4; ++m)
#pragma unroll
                    for (int n = 0; n < 2; ++n) acc[a][b][m][n] = (f32x4){0.f, 0.f, 0.f, 0.f};
        }
        cur = nxt; cA = nA; cB = nB; ++ui;
        if constexpr (ALIGN_EPI) { if (wr == 1) PG8_BAR; }
    }
    PG8_WAIT_V(0);
    if constexpr (!ALIGN_EPI) { if (wr == 0) PG8_BAR; }
    PG8_BAR;
    if constexpr (Epi::AFTER_DRAIN) { E.fused(acc, cur, wr, wc, fr, fq, lds, wid, lane); S.done(cur); }
#undef PG8_SA
#undef PG8_SB
#undef PG8_STAGE
#undef PG8_LDA
#undef PG8_LDB
#undef PG8_MMA
#undef PG8_WAIT_V
#undef PG8_WAIT_L
#undef PG8_BAR
#undef PG8_SCHED
}
}

#ifndef PROBE
#define PROBE 0
#endif
#ifndef I8_MASK
#define I8_MASK 0xFF
#endif
#ifndef X8_MASK
#define X8_MASK 0x00
#endif
#ifndef FP8_MASK
#define FP8_MASK 0xFC
#endif
#ifndef PG8_SP2
#define PG8_SP2 true
#endif
#ifndef PG8_ALIGN
#define PG8_ALIGN true
#endif

#define GAS __attribute__((address_space(1)))
#define LAS __attribute__((address_space(3)))
typedef unsigned short bf16;
typedef pg8::f32x4 f32x4;
typedef pg8::f32x2 f32x2;
typedef pg8::u32x4 u32x4;
typedef pg8::bf16x8 bf16x8;
typedef unsigned u32x2 __attribute__((ext_vector_type(2)));
typedef GAS unsigned gu32;
#define RLX_AGENT __ATOMIC_RELAXED, __HIP_MEMORY_SCOPE_AGENT
#define LDS_WAIT() asm volatile("s_waitcnt lgkmcnt(0)" ::: "memory")
#define VM_WAIT() asm volatile("s_waitcnt vmcnt(0)" ::: "memory")
using pg8::cvt_pk_bf16;

constexpr int S_ = 16384, D_ = 1024, FF_ = 2816, NGU = 2 * FF_, NH = 16, HD = 64, NBLK = 64, BS = 256;
constexpr int NWAVES = 8;
constexpr float EPS = 1e-6f, LOG2E = 1.4426950408889634f;

constexpr size_t MiB = 1u << 20;
constexpr size_t WS_CTL = 0, CTL_ZERO_BYTES = 64 * 1024;
constexpr size_t WS_SSQ = 1 * MiB;
constexpr size_t WS_KPART = 2 * MiB;
constexpr size_t WS_SEL = 3 * MiB;
constexpr size_t WS_LSE = 4 * MiB;
constexpr size_t WS_QN2 = 348 * MiB;
constexpr size_t WS_WP = 7 * MiB;
constexpr size_t WS_WATT = 8 * MiB, WATT_STRIDE = 8 * MiB, WATT_WO = 6 * MiB;
constexpr size_t WS_WFFN = 24 * MiB, WFFN_STRIDE = 17301504, WFFN_WD = 11 * MiB;
constexpr size_t WS_XB = 156 * MiB;
constexpr size_t WS_BIG = 252 * MiB;
constexpr size_t WS_HALO = 349 * MiB;
constexpr size_t WS_SSQB = 351 * MiB;
constexpr size_t WS_XS = 352 * MiB;
constexpr size_t WS_END = 352 * MiB + 65536;
static_assert(WS_WFFN + 8 * WFFN_STRIDE == WS_XB, "ws map");
constexpr size_t WS_X8 = WS_WFFN + 4 * WFFN_STRIDE;
static_assert((X8_MASK & 0x1f) == 0 && (X8_MASK & I8_MASK) == 0, "x8 copy region");
constexpr size_t WS_XQ = WS_XB + 32 * MiB;
constexpr int CW_RB = 12288;
constexpr int CW_BAR = 4096, CW_QA = 8192, CW_LC = 10240;
static_assert((CW_RB + 64 * 16) * 4 <= (int)CTL_ZERO_BYTES && CW_LC + 2 * 1024 <= CW_RB && (CW_LC + 2 * 1024) * 4 <= (int)CTL_ZERO_BYTES && CW_QA + 64 * 16 <= CW_LC, "list counters inside the memset region");
constexpr int LIST_HEAD = 256 * 2016;
__host__ __device__ __forceinline__ int list_off(int n) { return 256 * (63 * n - ((n * (n - 1)) >> 1)); }
static_assert((CW_QA + 64 * 16) * 4 <= (int)CTL_ZERO_BYTES && (CW_BAR + 3456) <= CW_QA, "control words inside the memset region");

constexpr int RING_BYTES = 131072, LDSCTL_OFF = RING_BYTES, MISC_OFF = LDSCTL_OFF + 320, RSTD_OFF = MISC_OFF + 128, LDS_BYTES = 147456;
static_assert(RSTD_OFF + 6 * 1024 <= LDS_BYTES, "LDS map");
constexpr int A_KS = 0, A_VT = 32768, A_LIST = 65536, A_CNT = A_LIST + 32768, A_OST = A_CNT + 256, A_OPITCH = 144;
constexpr int A_WROW = A_OST + 8 * 16 * A_OPITCH;
static_assert(A_WROW + 512 <= RING_BYTES, "attention LDS");

#define XB_TMO      128
#define XB_XCNT(j)  (256  + 64 * (j))
#define XB_XSUB(j)  (1280 + 64 * (j))
#define XB_XGEN(j)  (2304 + 64 * (j))
#define XB_TOP      3328
#define XB_TOPGEN   3392
#define XCD_BAR_WORDS 3456
#define XB_SPIN_CAP (1u << 18)

__device__ __forceinline__ unsigned xb_ld(unsigned* p)              { return __hip_atomic_load(p, __ATOMIC_RELAXED, __HIP_MEMORY_SCOPE_AGENT); }
__device__ __forceinline__ unsigned xb_add(unsigned* p, unsigned v) { return __hip_atomic_fetch_add(p, v, __ATOMIC_RELAXED, __HIP_MEMORY_SCOPE_AGENT); }
__device__ __forceinline__ unsigned xb_xcc_id() { return (unsigned)__builtin_amdgcn_s_getreg((3 << 11) | 20) & 0xFu; }
#define XB_SPIN(cond, bar) do { unsigned _sp = 0; while (cond) { __builtin_amdgcn_s_sleep(1); \
    if ((++_sp & 255u) == 0u) { if (xb_ld(&(bar)[XB_TMO])) break; if (_sp > XB_SPIN_CAP) { atomicAdd(&(bar)[XB_TMO], 1u); break; } } } } while (0)

struct XcdBarrier {
    unsigned* bar; unsigned x;
    volatile LAS unsigned* st;
};

__device__ __forceinline__ XcdBarrier xcd_barrier_post(unsigned* bar, volatile LAS unsigned* st, const bool thread0) {
    XcdBarrier b; b.bar = bar; b.x = xb_xcc_id(); b.st = st;
    if (thread0) (void)xb_add(&bar[XB_XCNT(b.x)], 1u);
    return b;
}
__device__ __forceinline__ void xcd_barrier_complete(unsigned* bar, unsigned x, unsigned& nloc, unsigned& nx) {
    const unsigned G = gridDim.x * gridDim.y * gridDim.z;
    unsigned sum, cnt, mine, sp = 0u;
    for (;;) {
        sum = 0u; cnt = 0u; mine = 0u;
#pragma unroll
        for (unsigned j = 0; j < 16; ++j) { const unsigned c = xb_ld(&bar[XB_XCNT(j)]); sum += c; cnt += (c > 0u) ? 1u : 0u; mine = (j == x) ? c : mine; }
        if (sum == G) break;
        __builtin_amdgcn_s_sleep(1);
        if ((++sp & 255u) == 0u) { if (xb_ld(&bar[XB_TMO])) break; if (sp > XB_SPIN_CAP) { atomicAdd(&bar[XB_TMO], 1u); break; } }
    }
    nloc = mine > 0u ? mine : 1u; nx = cnt > 0u ? cnt : 1u;
}

__device__ __forceinline__ void xcd_barrier(const XcdBarrier& b, const bool thread0) {
    asm volatile("s_waitcnt vmcnt(0)" ::: "memory");
    __syncthreads();
    if (thread0) {
        unsigned* bar = b.bar;
        __builtin_amdgcn_s_waitcnt(0);
        unsigned nloc = b.st[0], nx = b.st[1];
        if (nloc == 0u) { xcd_barrier_complete(bar, b.x, nloc, nx); b.st[0] = nloc; b.st[1] = nx; }
        const unsigned old = xb_add(&bar[XB_XSUB(b.x)], 1u);
        const unsigned gen = old / nloc;
        if (old + 1u == (gen + 1u) * nloc) {
            __builtin_amdgcn_fence(__ATOMIC_RELEASE, "agent");
            asm volatile("s_waitcnt vmcnt(0)" ::: "memory");
            (void)xb_add(&bar[XB_TOP], 1u);
        }
        XB_SPIN(xb_ld(&bar[XB_TOP]) < (gen + 1u) * nx, bar);
        __builtin_amdgcn_fence(__ATOMIC_ACQUIRE, "agent");
        asm volatile("s_waitcnt vmcnt(0)" ::: "memory");
    }
    __syncthreads();
}
__device__ __forceinline__ float row_rstd(const float* ssq, int row) {
    const f32x4* p = (const f32x4*)(ssq + (size_t)row * 16);
    const f32x4 a = p[0], b = p[1], c = p[2], d = p[3];
    const float s = (((a.x + a.y) + (a.z + a.w)) + ((b.x + b.y) + (b.z + b.w))) + (((c.x + c.y) + (c.z + c.w)) + ((d.x + d.y) + (d.z + d.w)));
    return __builtin_amdgcn_rsqf(s * (1.0f / 1024.0f) + EPS);
}
template <class Sched, bool XS = false> __device__ __forceinline__ void rstd_table(LAS unsigned char* lds, const float* ssq, const Sched& S, const int wave0) {
    int tid = wave0 * 64 + mk_lane(); asm volatile("" : "+v"(tid));
    LAS float* T = (LAS float*)(lds + RSTD_OFF);
#pragma unroll
    for (int i2 = 0; i2 < 3; ++i2) { pg8::Unit u; const int i = 2 * i2 + (tid >> 8); if (S.next(i, u)) T[i * 256 + (tid & 255)] = XS ? ssq[u.pm * 256 + (tid & 255)] : row_rstd(ssq, u.pm * 256 + (tid & 255)); }
    __syncthreads();
}
__device__ __forceinline__ float bf_lo(unsigned w) { return __uint_as_float(w << 16); }
__device__ __forceinline__ float bf_hi(unsigned w) { return __uint_as_float(w & 0xffff0000u); }

struct EpiNull {
    static constexpr bool PERM = false, AFTER_DRAIN = false;
    float* dummy;
    __device__ __forceinline__ void operator()(const f32x4 (&acc)[2][2][4][2], const pg8::Unit& u, int wr, int wc, int fr, int fq) const {
        f32x4 s = {0.f, 0.f, 0.f, 0.f};
#pragma unroll
        for (int ai = 0; ai < 2; ++ai)
#pragma unroll
            for (int bj = 0; bj < 2; ++bj)
#pragma unroll
                for (int m = 0; m < 4; ++m)
#pragma unroll
                    for (int n = 0; n < 2; ++n) s += acc[ai][bj][m][n];
        dummy[(size_t)blockIdx.x * 512 + (wr * 4 + wc) * 64 + fq * 16 + fr] = (s.x + s.y) + (s.z + s.w);
    }
};
struct NoPre {};
template <bool F8, bool I8 = false> struct EpiSwiGLUT {
    static constexpr bool PERM = true, AFTER_DRAIN = false, PRELOAD = false; typedef NoPre Pre;
    bf16* H; LAS const float* rt; int nullmode;
    __device__ __forceinline__ void operator()(const f32x4 (&acc)[2][2][4][2], const pg8::Unit& u, int wr, int wc, int fr, int fq) const {
#if PROBE == 13
        if (nullmode) { EpiNull en{(float*)H}; en(acc, u, wr, wc, fr, fq); return; }
#endif
        const int row0 = u.pm * 256 + wr * 64 + fr, col0 = u.pn * 128 + wc * 32 + 8 * fq;
#pragma unroll
        for (int ai = 0; ai < 2; ++ai)
#pragma unroll
            for (int m = 0; m < 4; ++m) {
                const int row = row0 + ai * 128 + m * 16;
                const float rs = rt[u.idx * 256 + (row & 255)], rsl = rs * (-LOG2E), irs2 = __builtin_amdgcn_rcpf(rs * rs * (F8 ? 8.0f : 1.0f));
                float hv[8];
#pragma unroll
                for (int n = 0; n < 2; ++n)
#pragma unroll
                    for (int e = 0; e < 4; ++e) {
                        const float ga = I8 ? (float)__float_as_int(acc[ai][0][m][n][e]) : acc[ai][0][m][n][e], ua = I8 ? (float)__float_as_int(acc[ai][1][m][n][e]) : acc[ai][1][m][n][e];
                        const float ex = __builtin_amdgcn_exp2f(ga * rsl);
                        hv[n * 4 + e] = (ga * ua) * __builtin_amdgcn_rcpf(__builtin_fmaf(ex, irs2, irs2));
                    }
                if constexpr (F8) {
                    int w0 = 0, w1 = 0;
                    w0 = __builtin_amdgcn_cvt_pk_fp8_f32(hv[0], hv[1], w0, false); w0 = __builtin_amdgcn_cvt_pk_fp8_f32(hv[2], hv[3], w0, true);
                    w1 = __builtin_amdgcn_cvt_pk_fp8_f32(hv[4], hv[5], w1, false); w1 = __builtin_amdgcn_cvt_pk_fp8_f32(hv[6], hv[7], w1, true);
                    u32x2 w8; w8.x = (unsigned)w0; w8.y = (unsigned)w1;
                    *(u32x2*)((unsigned char*)H + (size_t)row * FF_ + col0) = w8;
                } else {
                u32x4 w; w.x = cvt_pk_bf16(hv[0], hv[1]); w.y = cvt_pk_bf16(hv[2], hv[3]); w.z = cvt_pk_bf16(hv[4], hv[5]); w.w = cvt_pk_bf16(hv[6], hv[7]);
                *(u32x4*)(H + (size_t)row * FF_ + col0) = w;
                }
            }
    }
};
typedef EpiSwiGLUT<false> EpiSwiGLU;
typedef EpiSwiGLUT<true, true> EpiSwiGLU_F8I8;
typedef EpiSwiGLUT<false, true> EpiSwiGLU_I8;

template <bool POOL, int ALPHA2, bool X8OUT = !POOL> struct EpiResid {
    static constexpr bool PERM = true, AFTER_DRAIN = false;
    static constexpr bool PRELOAD = !POOL;
    struct PreTile { u32x4 r[16]; };
    typedef typename std::conditional<POOL, NoPre, PreTile>::type Pre;
    static constexpr float alpha = 0.5f * (float)ALPHA2;
    bf16* xb; float* ssq; const float* cscale; bf16* halo; unsigned char* x8;
    __device__ __forceinline__ void pre_issue(PreTile& pre, const pg8::Unit& u, int wr, int wc, int fr, int fq) const {
        const int row0 = u.pm * 256 + wr * 64 + fr, col0 = u.pn * 256 + wc * 32 + 8 * fq;
#pragma unroll
        for (int ai = 0; ai < 2; ++ai)
#pragma unroll
            for (int m = 0; m < 4; ++m)
#pragma unroll
                for (int bj = 0; bj < 2; ++bj) pre.r[(ai * 4 + m) * 2 + bj] = *(const u32x4*)(xb + (size_t)(row0 + ai * 128 + m * 16) * D_ + col0 + bj * 128);
    }
    __device__ __forceinline__ void pre_finish(f32x4 (&acc)[2][2][4][2], const PreTile& pre) const {
        const float ia = 1.0f / alpha;
#pragma unroll
        for (int ai = 0; ai < 2; ++ai)
#pragma unroll
            for (int m = 0; m < 4; ++m)
#pragma unroll
                for (int bj = 0; bj < 2; ++bj) { const u32x4 b = pre.r[(ai * 4 + m) * 2 + bj];
                    acc[ai][bj][m][0] = (f32x4){bf_lo(b.x), bf_hi(b.x), bf_lo(b.y), bf_hi(b.y)} * ia; acc[ai][bj][m][1] = (f32x4){bf_lo(b.z), bf_hi(b.z), bf_lo(b.w), bf_hi(b.w)} * ia; }
    }
    __device__ __forceinline__ void operator()(const f32x4 (&acc)[2][2][4][2], const pg8::Unit& u, int wr, int wc, int fr, int fq) const {
        if (POOL) { const int l2 = mk_lane(); fr = l2 & 15; fq = l2 >> 4; }
        const int pmr = POOL ? (u.pm & 63) : u.pm;
        const int row0 = pmr * 256 + wr * 64 + fr, col0 = u.pn * 256 + wc * 32 + 8 * fq;
        f32x4 cs[2][2];
#pragma unroll
        for (int bj = 0; bj < 2; ++bj)
#pragma unroll
            for (int n = 0; n < 2; ++n) { if (POOL) cs[bj][n] = *(const f32x4*)(cscale + col0 + bj * 128 + 4 * n) * alpha; }
#pragma unroll
        for (int ai = 0; ai < 2; ++ai) {
            u32x4 bx[4][2];
            constexpr int MB = POOL ? 2 : 4;
#pragma unroll
            for (int m = 0; m < 4; ++m) {
                if (POOL && (m % MB) == 0) {
#pragma unroll
                    for (int m2 = m; m2 < m + MB; ++m2)
#pragma unroll
                        for (int bj = 0; bj < 2; ++bj) bx[m2][bj] = *(const u32x4*)(xb + (size_t)(row0 + ai * 128 + m2 * 16) * D_ + col0 + bj * 128);
                }
                const int row = row0 + ai * 128 + m * 16; float s = 0.f;
#pragma unroll
                for (int bj = 0; bj < 2; ++bj) {
                    f32x4 v0, v1;
                    if (POOL) { v0 = acc[ai][bj][m][0] * cs[bj][0]; v1 = acc[ai][bj][m][1] * cs[bj][1]; } else { v0 = acc[ai][bj][m][0] * alpha; v1 = acc[ai][bj][m][1] * alpha; }
                    if (POOL) { const u32x4 b = bx[m][bj]; v0 += (f32x4){bf_lo(b.x), bf_hi(b.x), bf_lo(b.y), bf_hi(b.y)}; v1 += (f32x4){bf_lo(b.z), bf_hi(b.z), bf_lo(b.w), bf_hi(b.w)}; }
                    s += ((v0.x * v0.x + v0.y * v0.y) + (v0.z * v0.z + v0.w * v0.w)) + ((v1.x * v1.x + v1.y * v1.y) + (v1.z * v1.z + v1.w * v1.w));
                    u32x4 w; w.x = cvt_pk_bf16(v0.x, v0.y); w.y = cvt_pk_bf16(v0.z, v0.w); w.z = cvt_pk_bf16(v1.x, v1.y); w.w = cvt_pk_bf16(v1.z, v1.w);
                    *(u32x4*)(xb + (size_t)row * D_ + col0 + bj * 128) = w;
                    if (X8OUT && x8) { int p0 = 0, p1 = 0;
                        p0 = __builtin_amdgcn_cvt_pk_fp8_f32(v0.x * 8.0f, v0.y * 8.0f, p0, false); p0 = __builtin_amdgcn_cvt_pk_fp8_f32(v0.z * 8.0f, v0.w * 8.0f, p0, true);
                        p1 = __builtin_amdgcn_cvt_pk_fp8_f32(v1.x * 8.0f, v1.y * 8.0f, p1, false); p1 = __builtin_amdgcn_cvt_pk_fp8_f32(v1.z * 8.0f, v1.w * 8.0f, p1, true);
                        u32x2 w8; w8.x = (unsigned)p0; w8.y = (unsigned)p1; *(u32x2*)(x8 + (size_t)row * D_ + col0 + bj * 128) = w8; }
                    if (!POOL && ai == 1 && m == 3) { if (halo && wr == 1) *(u32x4*)(halo + ((size_t)u.pm * 16 + fr) * D_ + col0 + bj * 128) = w; }
                }
                s += shx(s, 16, fq * 16 + fr); s += shx(s, 32, fq * 16 + fr);
                if (fq == 0) ssq[(size_t)row * 16 + u.pn * 4 + wc] = s;
            }
        }
    }
};

struct EpiQKV {
    static constexpr bool PERM = true, AFTER_DRAIN = false, PRELOAD = false; typedef NoPre Pre;
    bf16* QKV; LAS const float* rt; float* kpart;
    __device__ __forceinline__ void operator()(const f32x4 (&acc)[2][2][4][2], const pg8::Unit& u, int wr, int wc, int fr, int fq) const {
        const int t = u.pn >> 2, colt = (u.pn & 3) * 256;
        bf16* dst = QKV + (size_t)t * S_ * D_;
        const int row0 = u.pm * 256 + wr * 64 + fr, col0 = colt + wc * 32 + 8 * fq;
        f32x4 csum[2][2];
#pragma unroll
        for (int bj = 0; bj < 2; ++bj)
#pragma unroll
            for (int n = 0; n < 2; ++n) csum[bj][n] = (f32x4){0.f, 0.f, 0.f, 0.f};
#pragma unroll
        for (int ai = 0; ai < 2; ++ai)
#pragma unroll
            for (int m = 0; m < 4; ++m) {
                const int row = row0 + ai * 128 + m * 16;
                const float rs = rt[u.idx * 256 + (row & 255)];
#pragma unroll
                for (int bj = 0; bj < 2; ++bj) {
                    const f32x4 v0 = acc[ai][bj][m][0] * rs, v1 = acc[ai][bj][m][1] * rs;
                    u32x4 w; w.x = cvt_pk_bf16(v0.x, v0.y); w.y = cvt_pk_bf16(v0.z, v0.w); w.z = cvt_pk_bf16(v1.x, v1.y); w.w = cvt_pk_bf16(v1.z, v1.w);
                    *(u32x4*)(dst + (size_t)row * D_ + col0 + bj * 128) = w;
                    csum[bj][0] += v0; csum[bj][1] += v1;
                }
            }
        if (t == 1) {
#pragma unroll
            for (int bj = 0; bj < 2; ++bj)
#pragma unroll
                for (int n = 0; n < 2; ++n) {
                    f32x4 c = csum[bj][n];
#pragma unroll
                    for (int e = 0; e < 4; ++e) { float x = c[e]; x += shx(x, 1, fq * 16 + fr); x += shx(x, 2, fq * 16 + fr); x += shx(x, 4, fq * 16 + fr); x += shx(x, 8, fq * 16 + fr); c[e] = x; }
                    if (fr == 0) *(f32x4*)(kpart + ((size_t)wr * NBLK + u.pm) * D_ + col0 + bj * 128 + 4 * n) = c;
                }
        }
    }
};


struct PoolOrder {
    int G, c;
    __device__ __forceinline__ bool next(int i, pg8::Unit& u) const { const int L = i * G + c; if (L >= 256) return false; u.pm = L; u.pn = L >> 6; u.idx = i; return true; }
    __device__ __forceinline__ void a_ready(const pg8::Unit&) const {}
    __device__ __forceinline__ void done(const pg8::Unit&) const {}
};
__device__ __forceinline__ float wave_sum(float v, int lane) {
#pragma unroll
    for (int o = 1; o < 64; o <<= 1) v += shx(v, o, lane);
    return v;
}
__device__ __forceinline__ void tr_item(const float* src, int N, int k0, int n0, bf16* dst, int dpitch, int drow0, const float* gain, float cs, LAS float* scr, int lane, int f8 = 0) {
    f32x4 v[8];
#pragma unroll
    for (int i = 0; i < 8; ++i) v[i] = __builtin_nontemporal_load((const f32x4*)(src + (size_t)(k0 + 8 * i + (lane >> 3)) * N + n0 + 4 * (lane & 7)));
#pragma unroll
    for (int i = 0; i < 8; ++i) {
        const int kk = 8 * i + (lane >> 3);
        const float g = gain ? gain[k0 + kk] * cs : cs;
        LAS float* d = scr + kk * 33 + 4 * (lane & 7);
        d[0] = v[i].x * g; d[1] = v[i].y * g; d[2] = v[i].z * g; d[3] = v[i].w * g;
    }
    LDS_WAIT(); asm volatile("" ::: "memory");
    const int c = lane & 7;
#pragma unroll
    for (int j = 0; j < 4; ++j) {
        const int n = (lane >> 3) + 8 * j; const LAS float* s = scr + (8 * c) * 33 + n;
        if (f8 == 2) {
            unsigned o8[2];
#pragma unroll
            for (int hh = 0; hh < 2; ++hh) { unsigned wv = 0u;
#pragma unroll
                for (int b = 0; b < 4; ++b) { const int q = max(-127, min(127, (int)__builtin_rintf(s[(hh * 4 + b) * 33]))); wv |= ((unsigned)q & 255u) << (8 * b); }
                o8[hh] = wv; }
            u32x2 ov; ov.x = o8[0]; ov.y = o8[1];
            *(u32x2*)((unsigned char*)dst + (size_t)(drow0 + n) * dpitch + k0 + 8 * c) = ov;
        } else if (f8) {
            int w0 = 0, w1 = 0;
            w0 = __builtin_amdgcn_cvt_pk_fp8_f32(s[0 * 33], s[1 * 33], w0, false); w0 = __builtin_amdgcn_cvt_pk_fp8_f32(s[2 * 33], s[3 * 33], w0, true);
            w1 = __builtin_amdgcn_cvt_pk_fp8_f32(s[4 * 33], s[5 * 33], w1, false); w1 = __builtin_amdgcn_cvt_pk_fp8_f32(s[6 * 33], s[7 * 33], w1, true);
            u32x2 o8; o8.x = (unsigned)w0; o8.y = (unsigned)w1;
            *(u32x2*)((unsigned char*)dst + (size_t)(drow0 + n) * dpitch + k0 + 8 * c) = o8;
        } else {
        u32x4 o; o.x = cvt_pk_bf16(s[0 * 33], s[1 * 33]); o.y = cvt_pk_bf16(s[2 * 33], s[3 * 33]); o.z = cvt_pk_bf16(s[4 * 33], s[5 * 33]); o.w = cvt_pk_bf16(s[6 * 33], s[7 * 33]);
        *(u32x4*)(dst + (size_t)(drow0 + n) * dpitch + k0 + 8 * c) = o;
        }
    }
    LDS_WAIT(); asm volatile("" ::: "memory");
}
__device__ __forceinline__ unsigned char* launder_s(unsigned char* p) { unsigned long long v = (unsigned long long)p; asm volatile("" : "+s"(v)); return (unsigned char*)v; }
struct Ptrs {
    const float *x, *ln, *wg, *wu, *wd, *wqkv, *wo, *pw, *ps, *fg;
    float* out; unsigned char* ws;
};
__device__ __forceinline__ bf16* ws_wgu(unsigned char* ws, int f) { return (bf16*)(ws + WS_WFFN + (size_t)f * WFFN_STRIDE); }
__device__ __forceinline__ bf16* ws_wd(unsigned char* ws, int f) { return (bf16*)(ws + WS_WFFN + (size_t)f * WFFN_STRIDE + WFFN_WD); }
__device__ __forceinline__ bf16* ws_wqkv(unsigned char* ws, int a) { return (bf16*)(ws + WS_WATT + (size_t)a * WATT_STRIDE); }
__device__ __forceinline__ bf16* ws_wo(unsigned char* ws, int a) { return (bf16*)(ws + WS_WATT + (size_t)a * WATT_STRIDE + WATT_WO); }
__device__ __forceinline__ bf16* ws_wp(unsigned char* ws, int p) { return (bf16*)(ws + WS_WP + (size_t)p * 524288); }

constexpr int IT_F = 1408, IT_FFN = 3 * IT_F, IT_ATT = 2048, IT_QKV = 1536, IT_POOL = 128;
constexpr int IT_TOTAL = 8 * IT_FFN + 2 * IT_ATT + 2 * IT_POOL;
__device__ __forceinline__ void convert_items(const Ptrs& P, LAS unsigned char* lds, int it_lo, int it_hi, int ww, int n_ww, int wave, int lane) {
    LAS float* scr = (LAS float*)(lds + wave * 16384);
    for (int it = it_lo + ww; it < it_hi; it += n_ww) {
        if (it < 8 * IT_FFN) {
            const int f = it / IT_FFN, r = it % IT_FFN, m = r / IT_F, q = r % IT_F;
            if (m < 2) {
                const int kb = q / 88, nb = q % 88, n0 = 32 * nb;
                const float* src = (m == 0 ? P.wg : P.wu) + (size_t)f * D_ * FF_;
                const float* gain = P.ln + ((f >> 1) * 3 + ((f & 1) ? 2 : 0)) * D_;
                const bool x8 = ((X8_MASK >> f) & 1) != 0, i8 = ((I8_MASK >> f) & 1) != 0;
                tr_item(src, FF_, 64 * kb, n0, ws_wgu(P.ws, f), D_, (n0 >> 7) * 256 + m * 128 + (n0 & 127), gain, i8 ? pg8::I8_WQ : x8 ? 256.0f : 1.0f, scr, lane, i8 ? 2 : (x8 ? 1 : 0));
            } else {
                const int kb = q / 32, nb = q % 32;
                const bool f8 = ((FP8_MASK >> f) & 1) != 0;
                tr_item(P.wd + (size_t)f * D_ * FF_, D_, 64 * kb, 32 * nb, ws_wd(P.ws, f), FF_, 32 * nb, nullptr, f8 ? 512.0f : 1.0f, scr, lane, f8 ? 1 : 0);
            }
        } else if (it < 8 * IT_FFN + 2 * IT_ATT) {
            const int r = it - 8 * IT_FFN, a = r / IT_ATT; int q = r % IT_ATT;
            if (q < IT_QKV) {
                const int kb = q / 96, nb = q % 96, n0 = 32 * nb;
                tr_item(P.wqkv + (size_t)a * D_ * 3 * D_, 3 * D_, 64 * kb, n0, ws_wqkv(P.ws, a), D_, n0, P.ln + ((2 * a) * 3 + 1) * D_, n0 < D_ ? 0.125f * LOG2E : 1.0f, scr, lane);
            } else {
                q -= IT_QKV; const int kb = q / 32, nb = q % 32;
                tr_item(P.wo + (size_t)a * D_ * D_, D_, 64 * kb, 32 * nb, ws_wo(P.ws, a), D_, 32 * nb, nullptr, 1.0f, scr, lane);
            }
        } else {
            const int r = it - 8 * IT_FFN - 2 * IT_ATT, p = r / IT_POOL, g = (r % IT_POOL) / 32, q = r % 32, kb = q / 8, nb = q % 8;
            tr_item(P.pw + (size_t)(p * 4 + g) * 65536, 256, 64 * kb, 32 * nb, ws_wp(P.ws, p), 256, g * 256 + 32 * nb, nullptr, 1.0f, scr, lane);
        }
    }
}
#ifndef TAILCONV
#define TAILCONV 1
#endif
__device__ __forceinline__ void phase_prologue(const Ptrs& P, LAS unsigned char* lds, const int wave0) {
    int tid = wave0 * 64 + mk_lane(); asm volatile("" : "+v"(tid)); const int lane = tid & 63, wave = __builtin_amdgcn_readfirstlane(tid >> 6); (void)lane; (void)wave;
    const int gw = blockIdx.x * NWAVES + wave, NGW = gridDim.x * NWAVES;
    if (TAILCONV && gridDim.x == 256) {
        convert_items(P, lds, 0, IT_FFN, gw, NGW, wave, lane);
        convert_items(P, lds, 8 * IT_FFN, 8 * IT_FFN + IT_ATT, gw, NGW, wave, lane);
    } else convert_items(P, lds, 0, IT_TOTAL, gw, NGW, wave, lane);
    bf16* XB = (bf16*)(P.ws + WS_XB); float* ssq = (float*)(P.ws + WS_SSQ);
    for (int row = gw; row < S_; row += NGW) {
        const f32x4* xr = (const f32x4*)(P.x + (size_t)row * D_) + lane;
        f32x4 v[4]; float s = 0.f;
#pragma unroll
        for (int j = 0; j < 4; ++j) { v[j] = __builtin_nontemporal_load(xr + 64 * j); s += (v[j].x * v[j].x + v[j].y * v[j].y) + (v[j].z * v[j].z + v[j].w * v[j].w); }
        s = wave_sum(s, lane);
        if ((I8_MASK & 1) != 0) {
            float am = 0.f;
#pragma unroll
            for (int j = 0; j < 4; ++j) am = fmaxf(fmaxf(am, fmaxf(fabsf(v[j].x), fabsf(v[j].y))), fmaxf(fabsf(v[j].z), fabsf(v[j].w)));
            am = fmaxf(am, shx(am, 1, lane)); am = fmaxf(am, shx(am, 2, lane)); am = fmaxf(am, shx(am, 4, lane)); am = fmaxf(am, shx(am, 8, lane)); am = fmaxf(am, shx(am, 16, lane)); am = fmaxf(am, shx(am, 32, lane));
            am = fmaxf(am, 1e-20f); const float qs = 127.0f / am;
            unsigned* oq = (unsigned*)(P.ws + WS_XQ + (size_t)row * D_) + lane;
#pragma unroll
            for (int j = 0; j < 4; ++j) { const int q0 = (int)__builtin_rintf(v[j].x * qs), q1 = (int)__builtin_rintf(v[j].y * qs), q2 = (int)__builtin_rintf(v[j].z * qs), q3 = (int)__builtin_rintf(v[j].w * qs);
                oq[64 * j] = ((unsigned)q0 & 255u) | (((unsigned)q1 & 255u) << 8) | (((unsigned)q2 & 255u) << 16) | (((unsigned)q3 & 255u) << 24); }
            if (lane == 0) ((float*)(P.ws + WS_XS))[row] = am * __builtin_amdgcn_rsqf(s * (1.0f / 1024.0f) + EPS) * (pg8::I8_IWQ / 127.0f);
        }
        u32x2* o8 = (u32x2*)(XB + (size_t)row * D_) + lane;
#pragma unroll
        for (int j = 0; j < 4; ++j) { u32x2 w; w.x = cvt_pk_bf16(v[j].x, v[j].y); w.y = cvt_pk_bf16(v[j].z, v[j].w); o8[64 * j] = w; }
        if (lane < 16) ssq[(size_t)row * 16 + lane] = lane == 0 ? s : 0.f;
    }
}

__device__ __forceinline__ void phase_final(const Ptrs& P, bool poison, const int wave0) {
    int tid = wave0 * 64 + mk_lane(); asm volatile("" : "+v"(tid)); const int lane = tid & 63, wave = __builtin_amdgcn_readfirstlane(tid >> 6); (void)lane; (void)wave;
    const int gw = blockIdx.x * NWAVES + wave, NGW = gridDim.x * NWAVES;
    const float* ssq = (const float*)(P.ws + WS_SSQ);
    const float qnan = __builtin_nanf("");
    for (int row = gw; row < S_; row += NGW) {
        const float rs = row_rstd(ssq, row);
        f32x4* xr = (f32x4*)(P.out + (size_t)row * D_) + lane; const f32x4* gr = (const f32x4*)P.fg + lane;
        const u32x2* h8 = (const u32x2*)((const bf16*)(P.ws + WS_XB) + (size_t)row * D_) + lane;
#pragma unroll
        for (int j = 0; j < 4; ++j) { const u32x2 hv = h8[64 * j]; f32x4 x4 = {bf_lo(hv.x), bf_hi(hv.x), bf_lo(hv.y), bf_hi(hv.y)};
            f32x4 v = x4 * gr[64 * j] * rs; if (poison) v = (f32x4){qnan, qnan, qnan, qnan}; __builtin_nontemporal_store(v, xr + 64 * j); }
    }
}

__device__ __forceinline__ void phase_pool_elem(const bf16* xhi, const float* ssq, const float* gain, bf16* Y, const bf16* halo, LAS unsigned char* lds, const int wave0) {
    int tid = wave0 * 64 + mk_lane(); asm volatile("" : "+v"(tid)); const int lane = tid & 63, wave = __builtin_amdgcn_readfirstlane(tid >> 6); (void)lane; (void)wave;
    LAS float* rs = (LAS float*)lds;
    const int L = blockIdx.x, g = L >> 6, strip = wave >> 1;
    const int t0 = (L & 63) * 256 + strip * 64;
    if (tid < 320) { const int st = tid / 80, r = (L & 63) * 256 + st * 64 - 16 + tid % 80; rs[tid] = r >= 0 ? row_rstd(ssq, r) : 0.f; }
    __syncthreads();
    const int cg = 2 * (tid & 127), c = g * 256 + cg;
    const f32x2 gn = *(const f32x2*)(gain + c);
    f32x2 hist[16], S2 = {0.f, 0.f}, S4 = {0.f, 0.f}, S8 = {0.f, 0.f}, S16 = {0.f, 0.f};
#pragma unroll
    for (int i = 0; i < 16; ++i) hist[i] = (f32x2){0.f, 0.f};
    const int w = 2 << g;
    bf16* Yg = Y + (size_t)g * S_ * 256 + cg;
    LAS const float* rss = rs + strip * 80;
    unsigned hwv[80];
#pragma unroll
    for (int r = 0; r < 80; ++r) {
        const int row = t0 - 16 + r; hwv[r] = 0u;
        if (row >= 0) { const bf16* src = (r < 16 && strip == 0) ? halo + ((size_t)((L & 63) - 1) * 16 + r) * D_ + c : xhi + (size_t)row * D_ + c; hwv[r] = *(const unsigned*)src; }
    }
#pragma unroll
    for (int b = 0; b < 5; ++b) {
#pragma unroll
        for (int i = 0; i < 16; ++i) {
            const int r = 16 * b + i, row = t0 - 16 + r;
            const unsigned hw = hwv[r];
            const f32x2 hv = (f32x2){bf_lo(hw), bf_hi(hw)} * gn * rss[r];
            S16 += hv - hist[i]; S8 += hv - hist[(i + 8) & 15]; S4 += hv - hist[(i + 12) & 15]; S2 += hv - hist[(i + 14) & 15]; hist[i] = hv;
            if (b > 0) {
                const f32x2 sw = g == 0 ? S2 : g == 1 ? S4 : g == 2 ? S8 : S16;
                const int cnt = row + 1 < w ? row + 1 : w;
                const f32x2 y = sw * (1.0f / (float)cnt) - hv;
                *(unsigned*)(Yg + (size_t)row * 256) = cvt_pk_bf16(y.x, y.y);
            }
        }
    }
    asm volatile("s_waitcnt vmcnt(0)" ::: "memory");
    __builtin_amdgcn_fence(__ATOMIC_ACQUIRE, "agent");
    asm volatile("s_waitcnt vmcnt(0)" ::: "memory");
    __syncthreads();
}

__device__ __forceinline__ bool alibi_dead(float slope2, int t, int n) { return slope2 * (float)(t - n * BS - (BS - 1)) >= 160.0f; }
__device__ __forceinline__ float head_slope2(int h) { return exp2f(-0.5f * (float)(h + 1)) * LOG2E; }
__device__ __forceinline__ void top3_insert(float gt, unsigned n, float& v0, float& v1, float& v2, unsigned& i0, unsigned& i1, unsigned& i2) {
    const bool g0 = gt > v0, g1 = gt > v1, g2 = gt > v2;
    v2 = g1 ? v1 : (g2 ? gt : v2); i2 = g1 ? i1 : (g2 ? n : i2);
    v1 = g0 ? v0 : (g1 ? gt : v1); i1 = g0 ? i0 : (g1 ? n : i1);
    v0 = g0 ? gt : v0;             i0 = g0 ? n : i0;
}
__device__ __forceinline__ void phase_gate(const bf16* Q, const float* kpart, unsigned* sel, float* qn2, unsigned* lists, gu32* lc, LAS unsigned char* lds, const int wave0) {
    int tid = wave0 * 64 + mk_lane(); asm volatile("" : "+v"(tid)); const int lane = tid & 63, wave = __builtin_amdgcn_readfirstlane(tid >> 6);
    const int fr = lane & 15, fq = lane >> 4;
    constexpr int KP = 144, LO = 64 * KP;
    for (int wgt = blockIdx.x; wgt < 256; wgt += gridDim.x) {
        const int h = wgt & 15, part = wgt >> 4;
        const float slope2g = head_slope2(h);
        unsigned apos[8], aent[8];
        bf16x8 qa[8][2];
#pragma unroll
        for (int i = 0; i < 8; ++i) { const bf16* qrow = Q + (size_t)(part * 1024 + (wave + 8 * i) * 16 + fr) * D_ + h * 64; qa[i][0] = *(const bf16x8*)(qrow + 8 * fq); qa[i][1] = *(const bf16x8*)(qrow + 32 + 8 * fq); }
        {
            const int n = tid >> 3, d0 = (tid & 7) * 8;
            const float* pa = kpart + (size_t)n * D_ + h * 64 + d0; const float* pb = pa + (size_t)NBLK * D_;
            const f32x4 a0 = *(const f32x4*)pa, a1 = *(const f32x4*)(pa + 4), b0 = *(const f32x4*)pb, b1 = *(const f32x4*)(pb + 4);
            const f32x4 s0 = a0 + b0, s1 = a1 + b1;
            u32x4 hi; hi.x = cvt_pk_bf16(s0.x, s0.y); hi.y = cvt_pk_bf16(s0.z, s0.w); hi.z = cvt_pk_bf16(s1.x, s1.y); hi.w = cvt_pk_bf16(s1.z, s1.w);
            u32x4 lo; lo.x = cvt_pk_bf16(s0.x - bf_lo(hi.x), s0.y - bf_hi(hi.x)); lo.y = cvt_pk_bf16(s0.z - bf_lo(hi.y), s0.w - bf_hi(hi.y));
            lo.z = cvt_pk_bf16(s1.x - bf_lo(hi.z), s1.y - bf_hi(hi.z)); lo.w = cvt_pk_bf16(s1.z - bf_lo(hi.w), s1.w - bf_hi(hi.w));
            *(LAS u32x4*)(lds + n * KP + d0 * 2) = hi; *(LAS u32x4*)(lds + LO + n * KP + d0 * 2) = lo;
        }
        LAS unsigned* lcn = (LAS unsigned*)(lds + 2 * LO + 2048);
        if (tid < 64) lcn[tid] = 0u;
        __syncthreads();
#pragma unroll
        for (int ti = 0; ti < 8; ++ti) {
            const int tile = wave + 8 * ti;
            const int t0 = part * 1024 + tile * 16, j = t0 >> 8, t = t0 + fr;
            const bf16x8 q0 = qa[ti][0], q1 = qa[ti][1];
            float v0 = -INFINITY, v1 = -INFINITY, v2 = -INFINITY; unsigned i0 = 255u, i1 = 255u, i2 = 255u;
            LAS const unsigned char* kp = lds + fr * KP + fq * 16;
#pragma unroll
            for (int bt = 0; bt < 4; ++bt) {
                if (16 * bt < j) {
                    const bf16x8 h0 = *(LAS const bf16x8*)(kp + bt * 16 * KP), h1 = *(LAS const bf16x8*)(kp + bt * 16 * KP + 64);
                    const bf16x8 l0 = *(LAS const bf16x8*)(kp + LO + bt * 16 * KP), l1 = *(LAS const bf16x8*)(kp + LO + bt * 16 * KP + 64);
                    f32x4 z = {0.f, 0.f, 0.f, 0.f};
                    z = __builtin_amdgcn_mfma_f32_16x16x32_bf16(l0, q0, z, 0, 0, 0); z = __builtin_amdgcn_mfma_f32_16x16x32_bf16(l1, q1, z, 0, 0, 0);
                    z = __builtin_amdgcn_mfma_f32_16x16x32_bf16(h0, q0, z, 0, 0, 0); z = __builtin_amdgcn_mfma_f32_16x16x32_bf16(h1, q1, z, 0, 0, 0);
#pragma unroll
                    for (int e = 0; e < 4; ++e) { const int n = 16 * bt + 4 * fq + e; if (n < j) top3_insert(z[e], (unsigned)n, v0, v1, v2, i0, i1, i2); }
                }
            }
#pragma unroll
            for (int sh = 16; sh <= 32; sh <<= 1) {
                const float p0 = shx(v0, sh, lane), p1 = shx(v1, sh, lane), p2 = shx(v2, sh, lane);
                const unsigned q0i = shxu(i0, sh, lane), q1i = shxu(i1, sh, lane), q2i = shxu(i2, sh, lane);
                if (q0i != 255u) top3_insert(p0, q0i, v0, v1, v2, i0, i1, i2);
                if (q1i != 255u) top3_insert(p1, q1i, v0, v1, v2, i0, i1, i2);
                if (q2i != 255u) top3_insert(p2, q2i, v0, v1, v2, i0, i1, i2);
            }
            float qq = 0.f;
#pragma unroll
            for (int i = 0; i < 8; ++i) { const float a = __uint_as_float((unsigned)(unsigned short)q0[i] << 16), b = __uint_as_float((unsigned)(unsigned short)q1[i] << 16); qq = __builtin_fmaf(a, a, qq); qq = __builtin_fmaf(b, b, qq); }
            qq += shx(qq, 16, lane); qq += shx(qq, 32, lane);
            const unsigned word = i0 | (i1 << 8) | (i2 << 16) | 0xff000000u;
            if (fq == 0) { sel[(size_t)h * S_ + t] = word; qn2[(size_t)h * S_ + t] = qq; }
            const unsigned w0 = (unsigned)shi((int)word, fr);
            const unsigned nk = fq < 3 ? ((w0 >> (8 * fq)) & 255u) : 255u;
            apos[ti] = 0u; aent[ti] = 0xffffffffu;
            if (nk != 255u && !alibi_dead(slope2g, t, (int)nk)) { apos[ti] = __hip_atomic_fetch_add(lcn + nk, 1u, __ATOMIC_RELAXED, __HIP_MEMORY_SCOPE_WORKGROUP); aent[ti] = (nk << 16) | (unsigned)t | ((unsigned)fq << 14); }
        }
        __syncthreads();
        if (tid < 64) { const unsigned c = lcn[tid]; lcn[64 + tid] = c ? __hip_atomic_fetch_add(lc + h * 64 + tid, c, RLX_AGENT) : 0u; }
        __syncthreads();
#pragma unroll
        for (int ti = 0; ti < 8; ++ti) if (aent[ti] != 0xffffffffu) { const int n = (int)(aent[ti] >> 16); lists[(size_t)h * LIST_HEAD + list_off(n) + lcn[64 + n] + apos[ti]] = aent[ti] & 0xffffu; }
        __syncthreads();
    }
}

template <bool CAUSAL, bool FOLD = false>
__device__ __forceinline__ void attn_tile(LAS const unsigned char* Ks, LAS const unsigned char* Vt, bf16x8 q0, bf16x8 q1, float lcm, float slope2, int tq_rel, int nch, int fr, int fq,
                                          f32x4 (&o)[4], float& l_out, LAS const unsigned char* Wr = nullptr) {
    const int rowbase = 8 * (fr >> 2) + (fr & 3), sw = (((fr >> 1) & 1) << 1) | (((fr >> 3) & 1) << 2);
    LAS const unsigned char* kp0 = Ks + rowbase * 128 + ((fq ^ sw) * 16);
    LAS const unsigned char* kp1 = Ks + rowbase * 128 + (((4 | fq) ^ sw) * 16);
    const float thr_f = (float)(tq_rel - 8 * fq);
    f32x4 s[16];
    bf16x8 kf[3][4];
#define AT_LOADK(buf, c) do { _Pragma("unroll") for (int u = 0; u < 2; ++u) { const int ro = (32 * (c) + 4 * u) * 128; \
        kf[buf][2 * u] = *(LAS const bf16x8*)(kp0 + ro); kf[buf][2 * u + 1] = *(LAS const bf16x8*)(kp1 + ro); } } while (0)
    AT_LOADK(0, 0);
    if (!CAUSAL || 1 < nch) AT_LOADK(1, 1);
#pragma unroll
    for (int c = 0; c < 8; ++c) {
        if (!CAUSAL || c < nch) {
            if (c < 6) { if (!CAUSAL || c + 2 < nch) AT_LOADK((c + 2) % 3, c + 2); }
            __builtin_amdgcn_sched_barrier(0);
            f32x4 c0, c1;
            float lcc = lcm, thc = thr_f; asm volatile("" : "+v"(lcc), "+v"(thc));
            if constexpr (FOLD) { c0 = (f32x4){lcc, lcc, lcc, lcc}; c1 = c0; } else {
#pragma unroll
            for (int e = 0; e < 4; ++e) {
                c0[e] = __builtin_fmaf(slope2, (float)(32 * c + e), lcc); c1[e] = __builtin_fmaf(slope2, (float)(32 * c + 4 + e), lcc);
                if (CAUSAL) { c0[e] = __builtin_fmaf(fminf(thc - (float)(32 * c + e), 0.f), 1e9f, c0[e]); c1[e] = __builtin_fmaf(fminf(thc - (float)(32 * c + 4 + e), 0.f), 1e9f, c1[e]); }
            }
            }
            const f32x4 z0 = __builtin_amdgcn_mfma_f32_16x16x32_bf16(kf[c % 3][0], q0, c0, 0, 0, 0);
            const f32x4 z1 = __builtin_amdgcn_mfma_f32_16x16x32_bf16(kf[c % 3][2], q0, c1, 0, 0, 0);
            s[2 * c] = __builtin_amdgcn_mfma_f32_16x16x32_bf16(kf[c % 3][1], q1, z0, 0, 0, 0);
            s[2 * c + 1] = __builtin_amdgcn_mfma_f32_16x16x32_bf16(kf[c % 3][3], q1, z1, 0, 0, 0);
        }
    }
#undef AT_LOADK
    const int lanev16 = (fq ^ (2 * (fr & 7))) * 16;
    LAS const unsigned char* vp = Vt + fr * 512;
    bf16x8 vf[2][4], wf[2];
#define AT_LOADV(buf, c) do { const int co = (64 * (c)) ^ lanev16; \
        _Pragma("unroll") for (int dt = 0; dt < 4; ++dt) vf[buf][dt] = *(LAS const bf16x8*)(vp + dt * 8192 + co); \
        if constexpr (FOLD) wf[buf] = *(LAS const bf16x8*)(Wr + (32 * (c) + 8 * fq) * 2); } while (0)
    AT_LOADV(0, 0);
#pragma unroll
    for (int kt = 0; kt < 16; ++kt) {
        if (!CAUSAL || (kt >> 1) < nch) {
#pragma unroll
            for (int e = 0; e < 4; ++e) s[kt][e] = __builtin_amdgcn_exp2f(s[kt][e]);
        }
    }
#pragma unroll
    for (int dt = 0; dt < 4; ++dt) o[dt] = (f32x4){0.f, 0.f, 0.f, 0.f};
    f32x4 lsum = {0.f, 0.f, 0.f, 0.f};
    const bf16x8 ones = {(short)0x3f80, (short)0x3f80, (short)0x3f80, (short)0x3f80, (short)0x3f80, (short)0x3f80, (short)0x3f80, (short)0x3f80};
#pragma unroll
    for (int c = 0; c < 8; ++c) {
        if (!CAUSAL || c < nch) {
            if (c < 7) { if (!CAUSAL || c + 1 < nch) AT_LOADV((c + 1) & 1, c + 1); }
            u32x4 pw; pw.x = cvt_pk_bf16(s[2 * c][0], s[2 * c][1]); pw.y = cvt_pk_bf16(s[2 * c][2], s[2 * c][3]); pw.z = cvt_pk_bf16(s[2 * c + 1][0], s[2 * c + 1][1]); pw.w = cvt_pk_bf16(s[2 * c + 1][2], s[2 * c + 1][3]);
            const bf16x8 pf = __builtin_bit_cast(bf16x8, pw);
#pragma unroll
            for (int dt = 0; dt < 4; ++dt) o[dt] = __builtin_amdgcn_mfma_f32_16x16x32_bf16(vf[c & 1][dt], pf, o[dt], 0, 0, 0);
            lsum = __builtin_amdgcn_mfma_f32_16x16x32_bf16(FOLD ? wf[c & 1] : ones, pf, lsum, 0, 0, 0);
        }
    }
    const float l = lsum[0];
#undef AT_LOADV
    l_out = l;
}
__device__ __forceinline__ void kv_load(const bf16* K, const bf16* V, int n, int h, u32x4 (&kv)[4], u32x4 (&vv)[4], int tid, int wave, int lane) {
#pragma unroll
    for (int it = 0; it < 4; ++it) kv[it] = *(const u32x4*)(K + (size_t)(n * BS + it * 64 + (tid >> 3)) * D_ + h * 64 + (tid & 7) * 8);
#pragma unroll
    for (int it = 0; it < 4; ++it) vv[it] = *(const u32x4*)(V + (size_t)(n * BS + wave * 32 + (lane & 31)) * D_ + h * 64 + ((lane >> 5) * 4 + it) * 8);
}
template <bool FOLD = false>
__device__ __forceinline__ void kv_write(const u32x4 (&kv)[4], const u32x4 (&vv)[4], LAS unsigned char* lds, LAS unsigned* kmaxw, int tid, int wave, int lane, float slope2 = 0.f) {
    float kn = 0.f;
#pragma unroll
    for (int it = 0; it < 4; ++it) { const int r = it * 64 + (tid >> 3), c16 = tid & 7, swz = (((r >> 1) & 1) << 1) | (((r >> 4) & 1) << 2);
        *(LAS u32x4*)(lds + A_KS + r * 128 + ((c16 ^ swz) * 16)) = kv[it];
        float sq = 0.f;
#pragma unroll
        for (int w = 0; w < 4; ++w) { const float a = bf_lo(kv[it][w]), b = bf_hi(kv[it][w]); sq = __builtin_fmaf(a, a, sq); sq = __builtin_fmaf(b, b, sq); }
        sq += shx(sq, 1, lane); sq += shx(sq, 2, lane); sq += shx(sq, 4, lane); kn = fmaxf(kn, sq); }
    kn = fmaxf(kn, shx(kn, 8, lane)); kn = fmaxf(kn, shx(kn, 16, lane)); kn = fmaxf(kn, shx(kn, 32, lane));
    if (lane == 0) __hip_atomic_fetch_max(kmaxw, __float_as_uint(kn), __ATOMIC_RELAXED, __HIP_MEMORY_SCOPE_WORKGROUP);
#pragma unroll
    for (int it = 0; it < 4; ++it) {
        const int key = wave * 32 + (lane & 31), pc = (lane >> 5) * 4 + it;
        u32x4 v = vv[it];
        if constexpr (FOLD) {
            const float wk = __builtin_amdgcn_exp2f(slope2 * (float)(key - (BS - 1)));
            v.x = cvt_pk_bf16(bf_lo(v.x) * wk, bf_hi(v.x) * wk); v.y = cvt_pk_bf16(bf_lo(v.y) * wk, bf_hi(v.y) * wk); v.z = cvt_pk_bf16(bf_lo(v.z) * wk, bf_hi(v.z) * wk); v.w = cvt_pk_bf16(bf_lo(v.w) * wk, bf_hi(v.w) * wk);
            if (pc == 0) *(LAS unsigned short*)(lds + A_WROW + key * 2) = (unsigned short)(cvt_pk_bf16(wk, wk) & 0xffffu);
        }
        LAS unsigned char* vb = lds + A_VT + (pc * 8) * 512 + (key & 7) * 2; const int kc = key >> 3;
#define ST_VT(e, val) *(LAS unsigned short*)(vb + (e) * 512 + ((kc ^ (2 * (e))) * 16)) = (unsigned short)(val)
        ST_VT(0, v.x & 0xffffu); ST_VT(1, v.x >> 16); ST_VT(2, v.y & 0xffffu); ST_VT(3, v.y >> 16);
        ST_VT(4, v.z & 0xffffu); ST_VT(5, v.z >> 16); ST_VT(6, v.w & 0xffffu); ST_VT(7, v.w >> 16);
#undef ST_VT
    }
}

constexpr int SEL_NU = 1284;
__device__ const unsigned sel_unit_tab[SEL_NU] = {
    0xa0005u, 0xa0015u, 0xa0025u, 0xa0006u, 0xa0016u, 0xa0026u, 0xa0036u, 0xa0007u, 0x141407u, 0xa0017u, 0xa0027u, 0xa0037u, 0xa0047u, 0xa0008u, 0x141408u, 0xa0018u,
    0x141418u, 0xa0028u, 0xa0038u, 0xa0048u, 0xa0058u, 0xa0068u, 0xa0078u, 0xa0009u, 0x141409u, 0xa0019u, 0x141419u, 0xa0029u, 0x141429u, 0xa0039u, 0xa0049u, 0xa0059u,
    0xa0069u, 0xa0079u, 0xa0089u, 0xa0099u, 0xa00a9u, 0xa000au, 0x14140au, 0x1e280au, 0xa001au, 0x14141au, 0xa002au, 0x14142au, 0xa003au, 0x14143au, 0xa004au, 0x14144au,
    0xa005au, 0xa006au, 0xa007au, 0xa008au, 0xa009au, 0xa00aau, 0xa00bau, 0xa00cau, 0xa00dau, 0xa00eau, 0xa000bu, 0x14140bu, 0x1e280bu, 0xa001bu, 0x14141bu, 0x1e281bu,
    0xa002bu, 0x14142bu, 0xa003bu, 0x14143bu, 0xa004bu, 0x14144bu, 0xa005bu, 0x14145bu, 0xa006bu, 0xa007bu, 0xa008bu, 0xa009bu, 0xa00abu, 0xa00bbu, 0xa00cbu, 0xa00dbu,
    0xa00ebu, 0xa00fbu, 0xa010bu, 0xa011bu, 0xa012bu, 0xa013bu, 0xa014bu, 0xa000cu, 0x14140cu, 0x1e280cu, 0x283c0cu, 0xa001cu, 0x14141cu, 0x1e281cu, 0xa002cu, 0x14142cu,
    0x1e282cu, 0xa003cu, 0x14143cu, 0xa004cu, 0x14144cu, 0xa005cu, 0x14145cu, 0xa006cu, 0x14146cu, 0xa007cu, 0x14147cu, 0xa008cu, 0x14148cu, 0xa009cu, 0xa00acu, 0xa00bcu,
    0xa00ccu, 0xa00dcu, 0xa00ecu, 0xa00fcu, 0xa010cu, 0xa011cu, 0xa012cu, 0xa013cu, 0xa014cu, 0xa015cu, 0xa016cu, 0xa017cu, 0xa018cu, 0xa019cu, 0xa01acu, 0xa01bcu,
    0xa000du, 0x14140du, 0x1e280du, 0x283c0du, 0xa001du, 0x14141du, 0x1e281du, 0x283c1du, 0xa002du, 0x14142du, 0x1e282du, 0xa003du, 0x14143du, 0x1e283du, 0xa004du, 0x14144du,
    0x1e284du, 0xa005du, 0x14145du, 0xa006du, 0x14146du, 0xa007du, 0x14147du, 0xa008du, 0x14148du, 0xa009du, 0x14149du, 0xa00adu, 0x1414adu, 0xa00bdu, 0x1414bdu, 0xa00cdu,
    0xa00ddu, 0xa00edu, 0xa00fdu, 0xa010du, 0xa011du, 0xa012du, 0xa013du, 0xa014du, 0xa015du, 0xa016du, 0xa017du, 0xa018du, 0xa019du, 0xa01adu, 0xa01bdu, 0xa000eu,
    0x14140eu, 0x1e280eu, 0x283c0eu, 0xa001eu, 0x14141eu, 0x1e281eu, 0x283c1eu, 0xa002eu, 0x14142eu, 0x1e282eu, 0xa003eu, 0x14143eu, 0x1e283eu, 0xa004eu, 0x14144eu, 0x1e284eu,
    0xa005eu, 0x14145eu, 0xa006eu, 0x14146eu, 0xa007eu, 0x14147eu, 0xa008eu, 0x14148eu, 0xa009eu, 0x14149eu, 0xa00aeu, 0x1414aeu, 0xa00beu, 0x1414beu, 0xa00ceu, 0xa00deu,
    0xa00eeu, 0xa00feu, 0xa010eu, 0xa011eu, 0xa012eu, 0xa013eu, 0xa014eu, 0xa015eu, 0xa016eu, 0xa017eu, 0xa018eu, 0xa019eu, 0xa01aeu, 0xa01beu, 0xa000fu, 0x14140fu,
    0x1e280fu, 0x283c0fu, 0xa001fu, 0x14141fu, 0x1e281fu, 0x283c1fu, 0xa002fu, 0x14142fu, 0x1e282fu, 0xa003fu, 0x14143fu, 0x1e283fu, 0xa004fu, 0x14144fu, 0x1e284fu, 0xa005fu,
    0x14145fu, 0xa006fu, 0x14146fu, 0xa007fu, 0x14147fu, 0xa008fu, 0x14148fu, 0xa009fu, 0x14149fu, 0xa00afu, 0x1414afu, 0xa00bfu, 0x1414bfu, 0xa00cfu, 0xa00dfu, 0xa00efu,
    0xa00ffu, 0xa010fu, 0xa011fu, 0xa012fu, 0xa013fu, 0xa014fu, 0xa015fu, 0xa016fu, 0xa017fu, 0xa018fu, 0xa019fu, 0xa01afu, 0xa01bfu, 0x1e283cu, 0xa015bu, 0x14146bu,
    0x1e282bu, 0xa00fau, 0xfe0004u, 0xfe0057u, 0xfe016bu, 0xfe01ccu, 0xfe01cdu, 0xfe01ceu, 0xfe01cfu, 0x14149cu, 0x1e281au, 0xfe14cdu, 0xfe14ceu, 0xfe14cfu, 0xfe00b9u, 0xfe010au,
    0xfe017bu, 0xfe0014u, 0xfe285eu, 0xfe285fu, 0xfe01dcu, 0xfe01ddu, 0xfe01deu, 0xfe01dfu, 0xfe0088u, 0xfe1439u, 0xfe018bu, 0xfe1428u, 0xfe011au, 0xfe00c9u, 0xfe2809u, 0xfe285du,
    0xfe019bu, 0xfe0046u, 0xfe01ecu, 0xfe01edu, 0xfe01eeu, 0xfe01efu, 0xfe3c2eu, 0xfe3c2fu, 0xfe0067u, 0xfe012au, 0xfe14acu, 0xfe01abu, 0xfe14ddu, 0xfe14deu, 0xfe14dfu, 0xfe147bu,
    0xfe1417u, 0xfe0098u, 0xfe00d9u, 0xfe01fcu, 0xfe01fdu, 0xfe01feu, 0xfe01ffu, 0xfe01bbu, 0xfe013au, 0xfe145au, 0xfe0035u, 0xfe01cbu, 0xfe0024u, 0xfe014au, 0xfe00e9u, 0xfe020cu,
    0xfe020du, 0xfe020eu, 0xfe020fu, 0xfe01dbu, 0xfe00a8u, 0xfe0077u, 0xfe14bcu, 0xfe015au, 0xfe01ebu, 0xfe14edu, 0xfe14eeu, 0xfe14efu, 0xfe021cu, 0xfe021du, 0xfe021eu, 0xfe021fu,
    0xfe00f9u, 0xfe3c2du, 0xfe0056u, 0xfe01fbu, 0xfe016au, 0xfe3c1cu, 0xfe020bu, 0xfe00b8u, 0xfe148bu, 0xfe286eu, 0xfe286fu, 0xfe022cu, 0xfe022du, 0xfe022eu, 0xfe022fu, 0xfe0109u,
    0xfe017au, 0xfe284cu, 0xfe021bu, 0xfe1406u, 0xfe0087u, 0xfe022bu, 0xfe018au, 0xfe286du, 0xfe14ccu, 0xfe3c0bu, 0xfe0119u, 0xfe023cu, 0xfe023du, 0xfe023eu, 0xfe023fu, 0xfe00c8u,
    0xfe023bu, 0xfe0003u, 0xfe0013u, 0xfe14fdu, 0xfe14feu, 0xfe14ffu, 0xfe1449u, 0xfe019au, 0xfe0045u, 0xfe500eu, 0xfe500fu, 0xfe0066u, 0xfe0129u, 0xfe146au, 0xfe024bu, 0xfe024cu,
    0xfe024du, 0xfe024eu, 0xfe024fu, 0xfe01aau, 0xfe0097u, 0xfe00d8u, 0xfe01bau, 0xfe0139u, 0xfe149bu, 0xfe14dcu, 0xfe025bu, 0xfe025cu, 0xfe025du, 0xfe025eu, 0xfe025fu, 0xfe0034u,
    0xfe01cau, 0xfe283bu, 0xfe0149u, 0xfe00e8u, 0xfe0023u, 0xfe150du, 0xfe150eu, 0xfe150fu, 0xfe01dau, 0xfe00a7u, 0xfe282au, 0xfe0076u, 0xfe026bu, 0xfe026cu, 0xfe026du, 0xfe026eu,
    0xfe026fu, 0xfe1438u, 0xfe0159u, 0xfe01eau, 0xfe00f8u, 0xfe1427u, 0xfe0055u, 0xfe01fau, 0xfe0169u, 0xfe14ecu, 0xfe2819u, 0xfe027bu, 0xfe027cu, 0xfe027du, 0xfe027eu, 0xfe027fu,
    0xfe020au, 0xfe00b7u, 0xfe287eu, 0xfe287fu, 0xfe0108u, 0xfe0179u, 0xfe021au, 0xfe287du, 0xfe14abu, 0xfe151du, 0xfe151eu, 0xfe151fu, 0xfe0086u, 0xfe147au, 0xfe022au, 0xfe028bu,
    0xfe028cu, 0xfe028du, 0xfe028eu, 0xfe028fu, 0xfe0189u, 0xfe0118u, 0xfe00c7u, 0xfe023au, 0xfe500du, 0xfe0199u, 0xfe1416u, 0xfe0044u, 0xfe024au, 0xfe14fcu, 0xfe285cu, 0xfe0065u,
    0xfe029bu, 0xfe029cu, 0xfe029du, 0xfe029eu, 0xfe029fu, 0xfe0128u, 0xfe1459u, 0xfe01a9u, 0xfe025au, 0xfe0096u, 0xfe00d7u, 0xfe026au, 0xfe2808u, 0xfe01b9u, 0xfe0002u, 0xfe0012u,
    0xfe0138u, 0xfe027au, 0xfe02abu, 0xfe02acu, 0xfe02adu, 0xfe02aeu, 0xfe02afu, 0xfe152du, 0xfe152eu, 0xfe152fu, 0xfe01c9u, 0xfe0033u, 0xfe3c3eu, 0xfe3c3fu, 0xfe028au, 0xfe14bbu,
    0xfe0148u, 0xfe00e7u, 0xfe0022u, 0xfe029au, 0xfe01d9u, 0xfe150cu, 0xfe00a6u, 0xfe02aau, 0xfe0075u, 0xfe02bbu, 0xfe02bcu, 0xfe02bdu, 0xfe02beu, 0xfe02bfu, 0xfe0158u, 0xfe01e9u,
    0xfe02bau, 0xfe00f7u, 0xfe0054u, 0xfe01f9u, 0xfe148au, 0xfe0168u, 0xfe02cau, 0xfe02cbu, 0xfe02ccu, 0xfe02cdu, 0xfe02ceu, 0xfe02cfu, 0xfe0209u, 0xfe00b6u, 0xfe0107u, 0xfe0178u,
    0xfe153du, 0xfe153eu, 0xfe153fu, 0xfe0219u, 0xfe288du, 0xfe288eu, 0xfe288fu, 0xfe151cu, 0xfe0085u, 0xfe0229u, 0xfe0188u, 0xfe14cbu, 0xfe0117u, 0xfe02dau, 0xfe02dbu, 0xfe02dcu,
    0xfe02ddu, 0xfe02deu, 0xfe02dfu, 0xfe00c6u, 0xfe0239u, 0xfe0198u, 0xfe0249u, 0xfe0043u, 0xfe1448u, 0xfe3c3du, 0xfe0127u, 0xfe0064u, 0xfe01a8u, 0xfe0259u, 0xfe02eau, 0xfe02ebu,
    0xfe02ecu, 0xfe02edu, 0xfe02eeu, 0xfe02efu, 0xfe0095u, 0xfe00d6u, 0xfe3c2cu, 0xfe0269u, 0xfe1469u, 0xfe01b8u, 0xfe152cu, 0xfe0137u, 0xfe0279u, 0xfe284bu, 0xfe154du, 0xfe154eu,
    0xfe154fu, 0xfe01c8u, 0xfe0032u, 0xfe0289u, 0xfe0147u, 0xfe00e6u, 0xfe02fau, 0xfe02fbu, 0xfe02fcu, 0xfe02fdu, 0xfe02feu, 0xfe02ffu, 0xfe0299u, 0xfe0001u, 0xfe0011u, 0xfe0021u,
    0xfe01d8u, 0xfe149au, 0xfe3c1bu, 0xfe00a5u, 0xfe1405u, 0xfe286cu, 0xfe14dbu, 0xfe02a9u, 0xfe0074u, 0xfe0157u, 0xfe01e8u, 0xfe02b9u, 0xfe00f6u, 0xfe02c9u, 0xfe0053u, 0xfe01f8u,
    0xfe030au, 0xfe030bu, 0xfe030cu, 0xfe030du, 0xfe030eu, 0xfe030fu, 0xfe153cu, 0xfe0167u, 0xfe02d9u, 0xfe0208u, 0xfe00b5u, 0xfe02e9u, 0xfe0106u, 0xfe0177u, 0xfe0218u, 0xfe02f9u,
    0xfe1437u, 0xfe0084u, 0xfe0309u, 0xfe0228u, 0xfe155du, 0xfe155eu, 0xfe155fu, 0xfe031au, 0xfe031bu, 0xfe031cu, 0xfe031du, 0xfe031eu, 0xfe031fu, 0xfe0187u, 0xfe0319u, 0xfe0116u,
    0xfe1426u, 0xfe3c0au, 0xfe00c5u, 0xfe0238u, 0xfe0197u, 0xfe0248u, 0xfe0042u, 0xfe154cu, 0xfe14ebu, 0xfe0126u, 0xfe0063u, 0xfe289du, 0xfe289eu, 0xfe289fu, 0xfe01a7u, 0xfe0258u,
    0xfe0329u, 0xfe032au, 0xfe032bu, 0xfe032cu, 0xfe032du, 0xfe032eu, 0xfe032fu, 0xfe0094u, 0xfe501eu, 0xfe501fu, 0xfe00d5u, 0xfe0268u, 0xfe01b7u, 0xfe0136u, 0xfe0278u, 0xfe14aau,
    0xfe01c7u, 0xfe283au, 0xfe0288u, 0xfe0031u, 0xfe0146u, 0xfe00e5u, 0xfe1479u, 0xfe0298u, 0xfe01d7u, 0xfe0339u, 0xfe033au, 0xfe033bu, 0xfe033cu, 0xfe033du, 0xfe033eu, 0xfe033fu,
    0xfe00a4u, 0xfe02a8u, 0xfe0073u, 0xfe2829u, 0xfe0156u, 0xfe01e7u, 0xfe155cu, 0xfe156du, 0xfe156eu, 0xfe156fu, 0xfe02b8u, 0xfe0000u, 0xfe0010u, 0xfe0020u, 0xfe00f5u, 0xfe02c8u,
    0xfe01f7u, 0xfe0052u, 0xfe0166u, 0xfe02d8u, 0xfe0207u, 0xfe00b4u, 0xfe14fbu, 0xfe02e8u, 0xfe0105u, 0xfe0349u, 0xfe034au, 0xfe034bu, 0xfe034cu, 0xfe034du, 0xfe034eu, 0xfe034fu,
    0xfe0176u, 0xfe1458u, 0xfe0217u, 0xfe02f8u, 0xfe0083u, 0xfe0308u, 0xfe0227u, 0xfe0186u, 0xfe0318u, 0xfe0115u, 0xfe00c4u, 0xfe0237u, 0xfe0328u, 0xfe1415u, 0xfe0196u, 0xfe156cu,
    0xfe0338u, 0xfe0247u, 0xfe0041u, 0xfe0125u, 0xfe0359u, 0xfe035au, 0xfe035bu, 0xfe035cu, 0xfe035du, 0xfe035eu, 0xfe035fu, 0xfe0348u, 0xfe0062u, 0xfe01a6u, 0xfe0257u, 0xfe2818u,
    0xfe0358u, 0xfe0093u, 0xfe00d4u, 0xfe0267u, 0xfe01b6u, 0xfe0135u, 0xfe0277u, 0xfe287cu, 0xfe14bau, 0xfe157du, 0xfe157eu, 0xfe157fu, 0xfe01c6u, 0xfe0287u, 0xfe0145u, 0xfe00e4u,
    0xfe0297u, 0xfe01d6u, 0xfe0368u, 0xfe0369u, 0xfe036au, 0xfe036bu, 0xfe036cu, 0xfe036du, 0xfe036eu, 0xfe036fu, 0xfe150bu, 0xfe0030u, 0xfe00a3u, 0xfe02a7u, 0xfe0072u, 0xfe0155u,
    0xfe01e6u, 0xfe157cu, 0xfe02b7u, 0xfe00f4u, 0xfe3c4eu, 0xfe3c4fu, 0xfe02c7u, 0xfe01f6u, 0xfe0051u, 0xfe0165u, 0xfe02d7u, 0xfe0206u, 0xfe00b3u, 0xfe02e7u, 0xfe0104u, 0xfe0175u,
    0xfe0216u, 0xfe02f7u, 0xfe0378u, 0xfe0379u, 0xfe037au, 0xfe037bu, 0xfe037cu, 0xfe037du, 0xfe037eu, 0xfe037fu, 0xfe0307u, 0xfe0082u, 0xfe1489u, 0xfe0226u, 0xfe28adu, 0xfe28aeu,
    0xfe28afu, 0xfe0185u, 0xfe0317u, 0xfe0114u, 0xfe285bu, 0xfe0236u, 0xfe00c3u, 0xfe0327u, 0xfe0195u, 0xfe0337u, 0xfe0246u, 0xfe0124u, 0xfe0347u, 0xfe0061u, 0xfe0256u, 0xfe01a5u,
    0xfe0040u, 0xfe0357u, 0xfe0092u, 0xfe00d3u, 0xfe0266u, 0xfe0367u, 0xfe501du, 0xfe158cu, 0xfe158du, 0xfe158eu, 0xfe158fu, 0xfe01b5u, 0xfe0134u, 0xfe0377u, 0xfe0276u, 0xfe0388u,
    0xfe0389u, 0xfe038au, 0xfe038bu, 0xfe038cu, 0xfe038du, 0xfe038eu, 0xfe038fu, 0xfe151bu, 0xfe0387u, 0xfe01c5u, 0xfe0286u, 0xfe0144u, 0xfe00e3u, 0xfe0296u, 0xfe01d5u, 0xfe14cau,
    0xfe00a2u, 0xfe02a6u, 0xfe0071u, 0xfe0154u, 0xfe01e5u, 0xfe02b6u, 0xfe00f3u, 0xfe02c6u, 0xfe01f5u, 0xfe0164u, 0xfe02d6u, 0xfe0050u, 0xfe0205u, 0xfe00b2u, 0xfe02e6u, 0xfe0103u,
    0xfe0397u, 0xfe0398u, 0xfe0399u, 0xfe039au, 0xfe039bu, 0xfe039cu, 0xfe039du, 0xfe039eu, 0xfe039fu, 0xfe0174u, 0xfe0215u, 0xfe02f6u, 0xfe1447u, 0xfe0306u, 0xfe0081u, 0xfe0225u,
    0xfe0184u, 0xfe0316u, 0xfe0113u, 0xfe0235u, 0xfe00c2u, 0xfe0326u, 0xfe500cu, 0xfe0194u, 0xfe0336u, 0xfe0245u, 0xfe0346u, 0xfe0123u, 0xfe0255u, 0xfe01a4u, 0xfe0356u, 0xfe3c4du,
    0xfe0060u, 0xfe0091u, 0xfe00d2u, 0xfe0265u, 0xfe0366u, 0xfe01b4u, 0xfe1468u, 0xfe0133u, 0xfe0376u, 0xfe0275u, 0xfe0386u, 0xfe2807u, 0xfe01c4u, 0xfe152bu, 0xfe0285u, 0xfe03a7u,
    0xfe03a8u, 0xfe03a9u, 0xfe03aau, 0xfe03abu, 0xfe03acu, 0xfe03adu, 0xfe03aeu, 0xfe03afu, 0xfe0396u, 0xfe0143u, 0xfe00e2u, 0xfe03a6u, 0xfe0295u, 0xfe01d4u, 0xfe159cu, 0xfe159du,
    0xfe159eu, 0xfe159fu, 0xfe00a1u, 0xfe02a5u, 0xfe0153u, 0xfe01e4u, 0xfe02b5u, 0xfe0070u, 0xfe00f2u, 0xfe02c5u, 0xfe01f4u, 0xfe0163u, 0xfe02d5u, 0xfe0204u, 0xfe00b1u, 0xfe02e5u,
    0xfe0102u, 0xfe0173u, 0xfe0214u, 0xfe02f5u, 0xfe0305u, 0xfe0224u, 0xfe0183u, 0xfe0080u, 0xfe0315u, 0xfe0112u, 0xfe0234u, 0xfe00c1u, 0xfe0325u, 0xfe1499u, 0xfe0193u, 0xfe0335u,
    0xfe03b6u, 0xfe03b7u, 0xfe03b8u, 0xfe03b9u, 0xfe03bau, 0xfe03bbu, 0xfe03bcu, 0xfe03bdu, 0xfe03beu, 0xfe03bfu, 0xfe0244u, 0xfe0345u, 0xfe0122u, 0xfe14dau, 0xfe0254u, 0xfe01a3u,
    0xfe0355u, 0xfe00d1u, 0xfe0264u, 0xfe0365u, 0xfe0090u, 0xfe01b3u, 0xfe0132u, 0xfe0375u, 0xfe0274u, 0xfe0385u, 0xfe01c3u, 0xfe0284u, 0xfe0395u, 0xfe288cu, 0xfe0142u, 0xfe00e1u,
    0xfe03a5u, 0xfe0294u, 0xfe01d3u, 0xfe03b5u, 0xfe02a4u, 0xfe00a0u, 0xfe0152u, 0xfe01e3u, 0xfe02b4u, 0xfe00f1u, 0xfe02c4u, 0xfe01f3u, 0xfe0162u, 0xfe02d4u, 0xfe0203u, 0xfe02e4u,
    0xfe153bu, 0xfe00b0u, 0xfe0101u, 0xfe0172u, 0xfe0213u, 0xfe02f4u, 0xfe0304u, 0xfe0223u, 0xfe0182u, 0xfe03c5u, 0xfe03c6u, 0xfe03c7u, 0xfe03c8u, 0xfe03c9u, 0xfe03cau, 0xfe03cbu,
    0xfe03ccu, 0xfe03cdu, 0xfe03ceu, 0xfe03cfu, 0xfe0314u, 0xfe0111u, 0xfe0233u, 0xfe0324u, 0xfe00c0u, 0xfe0192u, 0xfe0334u, 0xfe0243u, 0xfe0344u, 0xfe0121u, 0xfe0253u, 0xfe01a2u,
    0xfe0354u, 0xfe0364u, 0xfe0263u, 0xfe00d0u, 0xfe01b2u, 0xfe0131u, 0xfe0374u, 0xfe0273u, 0xfe0384u, 0xfe01c2u, 0xfe0283u, 0xfe28bdu, 0xfe28beu, 0xfe28bfu, 0xfe0394u, 0xfe0141u,
    0xfe03a4u, 0xfe0293u, 0xfe00e0u, 0xfe01d2u, 0xfe15acu, 0xfe15adu, 0xfe15aeu, 0xfe15afu, 0xfe03b4u, 0xfe02a3u, 0xfe03c4u, 0xfe0151u, 0xfe01e2u, 0xfe02b3u, 0xfe1436u, 0xfe02c3u,
    0xfe00f0u, 0xfe01f2u, 0xfe0161u, 0xfe02d3u, 0xfe0202u, 0xfe02e3u, 0xfe0171u, 0xfe0100u, 0xfe0212u, 0xfe02f3u, 0xfe0303u, 0xfe0222u, 0xfe0181u, 0xfe0313u, 0xfe0110u, 0xfe0232u,
    0xfe0323u, 0xfe0191u, 0xfe0333u, 0xfe0242u, 0xfe0343u, 0xfe0120u, 0xfe0252u, 0xfe03d4u, 0xfe03d5u, 0xfe03d6u, 0xfe03d7u, 0xfe03d8u, 0xfe03d9u, 0xfe03dau, 0xfe03dbu, 0xfe03dcu,
    0xfe03ddu, 0xfe03deu, 0xfe03dfu, 0xfe01a1u, 0xfe0353u, 0xfe0363u, 0xfe0262u, 0xfe01b1u, 0xfe0373u, 0xfe0130u, 0xfe0272u, 0xfe0383u, 0xfe01c1u, 0xfe0282u, 0xfe0393u, 0xfe03a3u,
    0xfe0140u, 0xfe0292u, 0xfe01d1u, 0xfe03b3u, 0xfe02a2u, 0xfe03c3u, 0xfe01e1u, 0xfe03d3u, 0xfe0150u, 0xfe02b2u, 0xfe1425u, 0xfe02c2u, 0xfe01f1u, 0xfe0160u, 0xfe02d2u, 0xfe0201u,
    0xfe02e2u, 0xfe0170u, 0xfe0211u, 0xfe02f2u, 0xfe0302u, 0xfe0221u, 0xfe0180u, 0xfe0312u, 0xfe0231u, 0xfe0322u, 0xfe0190u, 0xfe0332u, 0xfe0241u, 0xfe0342u, 0xfe0251u, 0xfe01a0u,
    0xfe0352u, 0xfe0362u, 0xfe0261u, 0xfe154bu, 0xfe0372u, 0xfe01b0u, 0xfe14eau, 0xfe0271u, 0xfe0382u, 0xfe0281u, 0xfe0392u, 0xfe01c0u, 0xfe03a2u, 0xfe0291u, 0xfe03b2u, 0xfe01d0u,
    0xfe02a1u, 0xfe03c2u, 0xfe03d2u, 0xfe01e0u, 0xfe02b1u, 0xfe02c1u, 0xfe01f0u, 0xfe02d1u, 0xfe0200u, 0xfe02e1u, 0xfe02f1u, 0xfe0210u, 0xfe0301u, 0xfe0220u, 0xfe0311u, 0xfe0230u,
    0xfe0321u, 0xfe0331u, 0xfe0240u, 0xfe0341u, 0xfe0250u, 0xfe0351u, 0xfe03e2u, 0xfe03e3u, 0xfe03e4u, 0xfe03e5u, 0xfe03e6u, 0xfe03e7u, 0xfe03e8u, 0xfe03e9u, 0xfe03eau, 0xfe03ebu,
    0xfe03ecu, 0xfe03edu, 0xfe03eeu, 0xfe03efu, 0xfe0361u, 0xfe0260u, 0xfe0371u, 0xfe0270u, 0xfe0381u, 0xfe0391u, 0xfe0280u, 0xfe03a1u, 0xfe0290u, 0xfe03b1u, 0xfe02a0u, 0xfe03c1u,
    0xfe03d1u, 0xfe02b0u, 0xfe03e1u, 0xfe02c0u, 0xfe02d0u, 0xfe02e0u, 0xfe02f0u, 0xfe0300u, 0xfe0310u, 0xfe0320u, 0xfe0330u, 0xfe0340u, 0xfe0350u, 0xfe0360u, 0xfe0370u, 0xfe0380u,
    0xfe0390u, 0xfe03a0u, 0xfe03b0u, 0xfe03c0u, 0xfe03d0u, 0xfe03e0u, 0xfe284au, 0xfe14a9u, 0xfe15bcu, 0xfe15bdu, 0xfe15beu, 0xfe15bfu, 0xfe1478u, 0xfe3c1au, 0xfe14fau, 0xfe3c2bu,
    0xfe286bu, 0xfe155bu, 0xfe3c3cu, 0xfe289cu,
};
__device__ __forceinline__ void phase_attn_sel(const bf16* Q, const bf16* K, const bf16* V, const unsigned* lists, const gu32* lc, const float* qn2, bf16* part0, bf16* part12, float* lse, gu32* qctr, LAS unsigned char* lds, const int wave0, bool nostore = false) {
    int tid = wave0 * 64 + mk_lane(); asm volatile("" : "+v"(tid)); const int lane = tid & 63, wave = __builtin_amdgcn_readfirstlane(tid >> 6);
    const int fr = lane & 15, fq = lane >> 4;
    LAS unsigned* cw = (LAS unsigned*)(lds + A_CNT);
    LAS unsigned short* list = (LAS unsigned short*)(lds + A_LIST);
    constexpr int NU = SEL_NU;
    if (tid == 0) { cw[4] = __hip_atomic_fetch_add(qctr, 1u, RLX_AGENT); cw[0] = 0u; cw[1] = 0u; cw[2] = 0u; cw[3] = 0u; }
    __syncthreads();
    int unit = (int)cw[4];
    u32x4 kv[4], vv[4]; int pnt = 0; unsigned pl0 = 0u, pl1 = 0u;
#define SEL_PREFETCH(u_) do { const unsigned te2 = sel_unit_tab[u_]; const int h2 = (int)(te2 & 15u), n2 = (int)((te2 >> 4) & 63u), plo2 = (int)((te2 >> 10) & 127u); \
        kv_load(K, V, n2, h2, kv, vv, tid, wave, lane); pnt = (int)lc[h2 * 64 + n2]; \
        const unsigned* gl2 = lists + (size_t)h2 * LIST_HEAD + list_off(n2) + plo2 * 128; pl0 = gl2[tid]; pl1 = gl2[tid + NWAVES * 64]; } while (0)
    if (unit < NU) SEL_PREFETCH(unit);
    for (int par = 0; unit < NU; par ^= 1) {
        const unsigned te = sel_unit_tab[unit];
        const int h = (int)(te & 15u), n = (int)((te >> 4) & 63u), plo = (int)((te >> 10) & 127u), phi = (int)((te >> 17) & 127u);
        const float slope2 = head_slope2(h);
        const int ntot = pnt, e0 = plo * 128, e1 = phi == 127 ? ntot : min(ntot, phi * 128), N = max(e1 - e0, 0);
        { if (tid < N) list[tid] = (unsigned short)pl0;
          if (tid + NWAVES * 64 < N) list[tid + NWAVES * 64] = (unsigned short)pl1;
          const unsigned* gl = lists + (size_t)h * LIST_HEAD + list_off(n) + e0;
          for (int i = tid + 2 * NWAVES * 64; i < N; i += NWAVES * 64) list[i] = (unsigned short)gl[i]; }
        kv_write<true>(kv, vv, lds, cw + 2 + par, tid, wave, lane, slope2);
        if (tid == 0) { cw[4 + (par ^ 1)] = __hip_atomic_fetch_add(qctr, 1u, RLX_AGENT); cw[2 + (par ^ 1)] = 0u; }
        __syncthreads();
        const int ntiles = (N + 15) >> 4;
        const float kmax2 = __uint_as_float(cw[2 + par]);
        const int nunit = (int)cw[4 + (par ^ 1)];
        int tile = wave; bool valid = false; int t = 0, k = 0; bf16x8 q0 = {}, q1 = {}; float qn = 0.f;
        if (tile < ntiles) { int idx = tile * 16 + fr; valid = idx < N; if (!valid) idx = N - 1; const unsigned e = list[idx]; t = (int)(e & 0x3fffu); k = (int)(e >> 14);
            const bf16* qrow = Q + (size_t)t * D_ + h * 64; q0 = *(const bf16x8*)(qrow + 8 * fq); q1 = *(const bf16x8*)(qrow + 32 + 8 * fq); qn = qn2[(size_t)h * S_ + t]; }
        if (nunit < NU) SEL_PREFETCH(nunit);
        while (tile < ntiles) {
            const int ntile = tile + NWAVES; bool nvalid = false; int nt = 0, nk = 0; bf16x8 nq0 = {}, nq1 = {}; float nqn = 0.f;
            if (ntile < ntiles) { int idx = ntile * 16 + fr; nvalid = idx < N; if (!nvalid) idx = N - 1; const unsigned e = list[idx]; nt = (int)(e & 0x3fffu); nk = (int)(e >> 14);
                const bf16* qrow = Q + (size_t)nt * D_ + h * 64; nq0 = *(const bf16x8*)(qrow + 8 * fq); nq1 = *(const bf16x8*)(qrow + 32 + 8 * fq); nqn = qn2[(size_t)h * S_ + nt]; }
            const float m = __builtin_amdgcn_sqrtf(qn * kmax2) * 1.0005f + 0.01f;
            const float lcm = slope2 * (float)(n * BS + (BS - 1) - t) - m;
            f32x4 o[4]; float l;
            attn_tile<false, true>(lds + A_KS, lds + A_VT, q0, q1, lcm, slope2, 0, 8, fr, fq, o, l, lds + A_WROW);
            const bool lok = l > 1e-30f;
            const float il = lok ? 1.0f / l : 0.f;
            {
                LAS unsigned char* ost = lds + A_OST + wave * (16 * A_OPITCH);
#pragma unroll
                for (int dt = 0; dt < 4; ++dt) { u32x2 w; w.x = cvt_pk_bf16(o[dt][0] * il, o[dt][1] * il); w.y = cvt_pk_bf16(o[dt][2] * il, o[dt][3] * il); *(LAS u32x2*)(ost + fr * A_OPITCH + (16 * dt + 4 * fq) * 2) = w; }
                LDS_WAIT(); asm volatile("" ::: "memory");
#pragma unroll
                for (int i = 0; i < 2; ++i) {
                    const int q = (lane >> 3) + 8 * i, p = lane & 7;
                    const u32x4 v = *(LAS const u32x4*)(ost + q * A_OPITCH + p * 16);
                    const int tq = shi(t, q), kq = shi(k, q), vq = shi((int)valid, q);
                    if (vq && !nostore) *(u32x4*)((kq == 0 ? part0 : part12 + (size_t)(kq - 1) * S_ * D_) + (size_t)tq * D_ + h * 64 + p * 8) = v;
                }
                if (valid && fq == 0) lse[((size_t)k * S_ + t) * NH + h] = lok ? m + __builtin_amdgcn_logf(l) : -INFINITY;
                LDS_WAIT(); asm volatile("" ::: "memory");
            }
            tile = ntile; valid = nvalid; t = nt; k = nk; q0 = nq0; q1 = nq1; qn = nqn;
        }
        __syncthreads();
        unit = nunit;
    }
}
__device__ __forceinline__ void phase_attn_own(bf16* Q, const bf16* K, const bf16* V, const unsigned* sel, const float* qn2, const bf16* part0, const bf16* part12, const float* lse, LAS unsigned char* lds, const int wave0, bool nostore = false) {
    int tid = wave0 * 64 + mk_lane(); asm volatile("" : "+v"(tid)); const int lane = tid & 63, wave = __builtin_amdgcn_readfirstlane(tid >> 6);
    const int fr = lane & 15, fq = lane >> 4;
    LAS unsigned* cw = (LAS unsigned*)(lds + A_CNT);
    if (tid == 0) { cw[2] = 0u; cw[3] = 0u; }
    __syncthreads();
    int par = 0;
    u32x4 kv[4], vv[4];
    { const int u0 = (int)blockIdx.x; kv_load(K, V, u0 >> 4, ((u0 & 15) + 4 * (u0 >> 8)) & 15, kv, vv, tid, wave, lane); }
    for (int unit = blockIdx.x; unit < NBLK * NH; unit += gridDim.x, par ^= 1) {
        const int j = unit >> 4, h = ((unit & 15) + 4 * (unit >> 8)) & 15;
        const int nv = j < 3 ? j : 3;
        bf16x8 qf[2][2]; float qnv[2]; unsigned selv[2];
#pragma unroll
        for (int half = 0; half < 2; ++half) {
            const int t = j * BS + (half ? 15 - wave : wave) * 16 + fr;
            const bf16* qrow = Q + (size_t)t * D_ + h * 64;
            qf[half][0] = *(const bf16x8*)(qrow + 8 * fq); qf[half][1] = *(const bf16x8*)(qrow + 32 + 8 * fq);
            qnv[half] = qn2[(size_t)h * S_ + t];
            selv[half] = nv > 0 ? sel[(size_t)h * S_ + t] : 0xffffffffu;
        }
        kv_write(kv, vv, lds, cw + 2 + par, tid, wave, lane);
        if (tid == 0) cw[2 + (par ^ 1)] = 0u;
        __syncthreads();
        const float kmax2 = __uint_as_float(cw[2 + par]);
        const float slope2 = head_slope2(h);
#pragma unroll
        for (int half = 0; half < 2; ++half) {
            const int tile = half ? 15 - wave : wave;
            const int tq = tile * 16 + fr, t = j * BS + tq;
            const bf16x8 q0 = qf[half][0], q1 = qf[half][1];
            float lk[3]; u32x2 pv[3][4];
            const unsigned selw = selv[half];
#pragma unroll
            for (int k = 0; k < 3; ++k) {
                lk[k] = -INFINITY;
#pragma unroll
                for (int dt = 0; dt < 4; ++dt) pv[k][dt] = (u32x2){0u, 0u};
                if (k < nv && !alibi_dead(slope2, t, (int)((selw >> (8 * k)) & 0xffu))) {
                    lk[k] = lse[((size_t)k * S_ + t) * NH + h];
                    const bf16* pp = (k == 0 ? part0 : part12 + (size_t)(k - 1) * S_ * D_) + (size_t)t * D_ + h * 64 + 4 * fq;
#pragma unroll
                    for (int dt = 0; dt < 4; ++dt) pv[k][dt] = *(const u32x2*)(pp + dt * 16);
                }
            }
            if (half == 0) {
                const int nu = unit + (int)gridDim.x;
                if (nu < NBLK * NH) kv_load(K, V, nu >> 4, ((nu & 15) + 4 * (nu >> 8)) & 15, kv, vv, tid, wave, lane);
            }
            const float m = __builtin_amdgcn_sqrtf(qnv[half] * kmax2) * 1.0005f + 0.01f;
            const float lcm = slope2 * (float)(8 * fq - tq) - m;
            f32x4 o[4]; float l;
            attn_tile<true>(lds + A_KS, lds + A_VT, q0, q1, lcm, slope2, tq, (tile >> 1) + 1, fr, fq, o, l);
            const float lown = m + __builtin_amdgcn_logf(l), il = 1.0f / l;
            const float M = fmaxf(fmaxf(lown, lk[0]), fmaxf(lk[1], lk[2]));
            const float e0 = __builtin_amdgcn_exp2f(lown - M), w0 = e0 * il;
            float wsum = e0;
#pragma unroll
            for (int dt = 0; dt < 4; ++dt) o[dt] = o[dt] * w0;
#pragma unroll
            for (int k = 0; k < 3; ++k) {
                const float wk = __builtin_amdgcn_exp2f(lk[k] - M);
                wsum += wk;
#pragma unroll
                for (int dt = 0; dt < 4; ++dt) { o[dt][0] += wk * bf_lo(pv[k][dt].x); o[dt][1] += wk * bf_hi(pv[k][dt].x); o[dt][2] += wk * bf_lo(pv[k][dt].y); o[dt][3] += wk * bf_hi(pv[k][dt].y); }
            }
            const float inv = 1.0f / wsum;
            {
                LAS unsigned char* ost = lds + A_OST + wave * (16 * A_OPITCH);
#pragma unroll
                for (int dt = 0; dt < 4; ++dt) { u32x2 w; w.x = cvt_pk_bf16(o[dt][0] * inv, o[dt][1] * inv); w.y = cvt_pk_bf16(o[dt][2] * inv, o[dt][3] * inv); *(LAS u32x2*)(ost + fr * A_OPITCH + (16 * dt + 4 * fq) * 2) = w; }
                LDS_WAIT(); asm volatile("" ::: "memory");
#pragma unroll
                for (int i = 0; i < 2; ++i) {
                    const int q = (lane >> 3) + 8 * i, p = lane & 7;
                    const u32x4 v = *(LAS const u32x4*)(ost + q * A_OPITCH + p * 16);
                    if (!nostore) *(u32x4*)(Q + (size_t)(j * BS + tile * 16 + q) * D_ + h * 64 + p * 8) = v;
                }
                LDS_WAIT(); asm volatile("" ::: "memory");
            }
        }
        __syncthreads();
    }
}
__device__ __forceinline__ void phase_quant(const bf16* xb, const float* ssq, unsigned char* xq, float* xs, const int wave0, const int rb0 = -1) {
    int tid = wave0 * 64 + mk_lane(); asm volatile("" : "+v"(tid)); const int lane = tid & 63;
    for (int rb = rb0 >= 0 ? rb0 : (int)blockIdx.x; rb < (rb0 >= 0 ? rb0 + 1 : S_ / 64); rb += gridDim.x) {
        const int row = rb * 64 + (tid >> 3);
        u32x4 v[16];
#pragma unroll
        for (int i = 0; i < 16; ++i) v[i] = *(const u32x4*)(xb + (size_t)row * D_ + i * 64 + (tid & 7) * 8);
        const float rs = row_rstd(ssq, row);
        unsigned am = 0u;
#pragma unroll
        for (int i = 0; i < 16; ++i)
#pragma unroll
            for (int w = 0; w < 4; ++w) { const unsigned ww = v[i][w]; am = max(am, ww & 0x7fffu); am = max(am, (ww >> 16) & 0x7fffu); }
        am = max(am, shxu(am, 1, lane)); am = max(am, shxu(am, 2, lane)); am = max(am, shxu(am, 4, lane));
        const float amax = fmaxf(__uint_as_float(am << 16), 1e-20f), qs = 127.0f / amax;
        if ((tid & 7) == 0) { const float xv = amax * rs * (pg8::I8_IWQ / 127.0f); if (rb0 >= 0) __hip_atomic_store((GAS unsigned*)(xs + row), __float_as_uint(xv), RLX_AGENT); else xs[row] = xv; }
#pragma unroll
        for (int i = 0; i < 16; ++i) {
            unsigned o8[2];
#pragma unroll
            for (int hh = 0; hh < 2; ++hh) {
                const unsigned wa = hh ? v[i].z : v[i].x, wb = hh ? v[i].w : v[i].y;
                const int q0 = (int)__builtin_rintf(bf_lo(wa) * qs), q1 = (int)__builtin_rintf(bf_hi(wa) * qs), q2 = (int)__builtin_rintf(bf_lo(wb) * qs), q3 = (int)__builtin_rintf(bf_hi(wb) * qs);
                o8[hh] = ((unsigned)q0 & 255u) | (((unsigned)q1 & 255u) << 8) | (((unsigned)q2 & 255u) << 16) | (((unsigned)q3 & 255u) << 24);
            }
            if (rb0 >= 0) __hip_atomic_store((GAS unsigned long long*)(xq + (size_t)row * D_ + i * 64 + (tid & 7) * 8), ((unsigned long long)o8[1] << 32) | o8[0], RLX_AGENT);
            else { u32x2 ov; ov.x = o8[0]; ov.y = o8[1]; *(u32x2*)(xq + (size_t)row * D_ + i * 64 + (tid & 7) * 8) = ov; }
        }
    }
}
struct Args { const float* in[10]; float* out; unsigned char* ws; };
typedef const __attribute__((address_space(4))) Args* CArgsP;
__device__ __forceinline__ CArgsP KA() { unsigned long long p = (unsigned long long)__builtin_amdgcn_kernarg_segment_ptr(); asm volatile("" : "+s"(p)); return (CArgsP)p; }
__device__ __forceinline__ Ptrs make_ptrs(CArgsP a) { Ptrs P; P.x = a->in[0]; P.ln = a->in[1]; P.wg = a->in[2]; P.wu = a->in[3]; P.wd = a->in[4]; P.wqkv = a->in[5]; P.wo = a->in[6]; P.pw = a->in[7]; P.ps = a->in[8]; P.fg = a->in[9]; P.out = a->out; P.ws = a->ws; return P; }
__device__ __forceinline__ void phase_tailconv(LAS unsigned char* lds, int f, const int wave0) {
    int tid = wave0 * 64 + mk_lane(); asm volatile("" : "+v"(tid)); const int lane = tid & 63, wave = __builtin_amdgcn_readfirstlane(tid >> 6);
    const Ptrs P = make_ptrs(KA());
    const int ww = ((int)blockIdx.x - 128) * NWAVES + wave, n_ww = 128 * NWAVES;
    convert_items(P, lds, (f + 1) * IT_FFN, (f + 2) * IT_FFN, ww, n_ww, wave, lane);
    if (f == 0) convert_items(P, lds, 8 * IT_FFN + 2 * IT_ATT, IT_TOTAL, ww, n_ww, wave, lane);
    if (f == 2) convert_items(P, lds, 8 * IT_FFN + IT_ATT, 8 * IT_FFN + IT_ATT + IT_ATT / 2, ww, n_ww, wave, lane);
    if (f == 3) convert_items(P, lds, 8 * IT_FFN + IT_ATT + IT_ATT / 2, 8 * IT_FFN + 2 * IT_ATT, ww, n_ww, wave, lane);
}
__global__ void __launch_bounds__(NWAVES * 64, 2) mk_fwd(Args args) {
    extern __shared__ __attribute__((aligned(16))) unsigned char lds_raw[];
    LAS unsigned char* lds = (LAS unsigned char*)lds_raw;
    volatile LAS unsigned* MISC = (volatile LAS unsigned*)(lds + MISC_OFF);
    const int G = gridDim.x;
    gu32* ctl = (gu32*)(KA()->ws + WS_CTL);
    for (int u = threadIdx.x; u < (LDS_BYTES - LDSCTL_OFF) / 4; u += NWAVES * 64) ((LAS unsigned*)(lds + LDSCTL_OFF))[u] = 0u;
    __syncthreads();
    const int wave0 = __builtin_amdgcn_readfirstlane((int)threadIdx.x >> 6);
    XcdBarrier bar = xcd_barrier_post((unsigned*)(ctl + CW_BAR), MISC + 8, wave0 == 0 && mk_lane() == 0);
    (void)bar;
#define GRID_BAR() do { unsigned long long wsl_ = (unsigned long long)KA()->ws; XcdBarrier b_; b_.bar = (unsigned*)(wsl_ + WS_CTL) + CW_BAR; b_.x = xb_xcc_id(); \
        b_.st = (volatile LAS unsigned*)(lds + MISC_OFF) + 8; xcd_barrier(b_, wave0 == 0 && mk_lane() == 0); } while (0)
#define NREP(p) ((PROBE == (p)) ? 2 : 1)
    for (int rep = 0; rep < NREP(5); ++rep) { Ptrs P2 = make_ptrs(KA()); phase_prologue(P2, lds, wave0); GRID_BAR(); }
#define WSL() (KA()->ws)
#pragma clang loop unroll(full)
    for (int f = 0; f < 8; ++f) {
        for (int rep = 0; rep < NREP(3) * NREP(13); ++rep) {
            unsigned char* w = WSL();
            pg8::Gemm g{(const bf16*)(w + WS_XB), ws_wgu(w, f), S_, NGU, D_}; pg8::StaticOrder S; S.init(S_, NGU, G, (int)blockIdx.x);
            if ((I8_MASK >> f) & 1) {
                if (rep == 0 && f != 0) {
                    if (G == 256) {
                        pg8::Unit u0; S.next(0, u0);
                        phase_quant((const bf16*)(w + WS_XB), (const float*)(w + ((f & 3) == 3 ? WS_SSQB : WS_SSQ)), w + WS_XQ, (float*)(w + WS_XS), wave0, u0.pm * 4 + ((int)blockIdx.x >> 6));
                        asm volatile("s_waitcnt vmcnt(0)" ::: "memory");
                        __syncthreads();
                        if (wave0 == 0 && mk_lane() == 0) {
                            gu32* fl = (gu32*)(w + WS_CTL) + CW_RB + 16 * u0.pm + f;
                            __hip_atomic_fetch_add(fl, 1u, RLX_AGENT);
                            unsigned sp = 0u; while (__hip_atomic_load(fl, RLX_AGENT) < 4u) { __builtin_amdgcn_s_sleep(1); if (++sp > (1u << 22)) break; }
                            __builtin_amdgcn_fence(__ATOMIC_ACQUIRE, "agent"); asm volatile("s_waitcnt vmcnt(0)" ::: "memory");
                        }
                        __syncthreads();
                    } else { phase_quant((const bf16*)(w + WS_XB), (const float*)(w + ((f & 3) == 3 ? WS_SSQB : WS_SSQ)), w + WS_XQ, (float*)(w + WS_XS), wave0); GRID_BAR(); }
                }
                rstd_table<pg8::StaticOrder, true>(lds, (const float*)(w + WS_XS), S, wave0); }
            else rstd_table(lds, (const float*)(w + ((f & 3) == 3 ? WS_SSQB : WS_SSQ)), S, wave0);
#define GU_PHASE(EPI) do { EPI E{(bf16*)(w + ((PROBE == 13 && rep == 0) ? WS_END : WS_BIG)), (LAS const float*)(lds + RSTD_OFF), PROBE == 13 && rep == 0}; \
                if ((X8_MASK >> f) & 1) { pg8::Gemm g8 = g; g8.A = (const bf16*)(w + WS_X8); g8.K = D_ / 2; pg8::gemm_phase<EPI, pg8::StaticOrder, PG8_ALIGN, PG8_SP2, true, pg8::F8_SCALE_WGU, pg8::F8_SCALE_X>(lds, g8, S, E, wave0); } \
                else pg8::gemm_phase<EPI, pg8::StaticOrder, PG8_ALIGN, PG8_SP2>(lds, g, S, E, wave0); } while (0)
#define GU_PHASE_I8(EPI) do { EPI E{(bf16*)(w + WS_BIG), (LAS const float*)(lds + RSTD_OFF), 0}; \
                pg8::Gemm g8 = g; g8.A = (const bf16*)(w + WS_XQ); g8.K = D_ / 2; pg8::gemm_phase<EPI, pg8::StaticOrder, PG8_ALIGN, PG8_SP2, false, 0, 0, true>(lds, g8, S, E, wave0); } while (0)
            if ((I8_MASK >> f) & 1) { if ((FP8_MASK >> f) & 1) GU_PHASE_I8(EpiSwiGLU_F8I8); else GU_PHASE_I8(EpiSwiGLU_I8); }
            else if ((FP8_MASK >> f) & 1) GU_PHASE(EpiSwiGLUT<true>); else GU_PHASE(EpiSwiGLU);
#undef GU_PHASE
#undef GU_PHASE_I8
            if (TAILCONV && G == 256 && rep == 0 && f < 7 && blockIdx.x >= 128) phase_tailconv(lds, f, wave0);
            GRID_BAR();
        }
        for (int rep = 0; rep < NREP(4) * NREP(14) * NREP(24) * NREP(25); ++rep) {
            unsigned char* w = WSL();
            pg8::Gemm g{(const bf16*)(w + WS_BIG), ws_wd(w, f), S_, D_, FF_}; pg8::StaticOrder S; S.init(S_, D_, G, (int)blockIdx.x);
            EpiResid<false, 1> E{(bf16*)(w + WS_XB), (float*)(w + WS_SSQ), nullptr, (f & 3) == 2 ? (bf16*)(w + WS_HALO) : nullptr, ((f & 1) && f < 7 && ((X8_MASK >> (f + 1)) & 1)) ? w + WS_X8 : nullptr};
            if ((FP8_MASK >> f) & 1) { pg8::Gemm g8 = g; g8.K = FF_ / 2; pg8::gemm_phase<EpiResid<false, 1>, pg8::StaticOrder, false, PG8_SP2, true>(lds, g8, S, E, wave0); }
            else pg8::gemm_phase<EpiResid<false, 1>, pg8::StaticOrder, false, PG8_SP2>(lds, g, S, E, wave0);
            GRID_BAR();
        }
        if ((f & 1) == 0) {
            const int L = f >> 1, mi = L >> 1;
            if ((L & 1) == 0) {
                for (int rep = 0; rep < NREP(6); ++rep) {
                    unsigned char* w = WSL();
                    pg8::Gemm g{(const bf16*)(w + WS_XB), ws_wqkv(w, mi), S_, 3 * D_, D_}; pg8::StaticOrder S; S.init(S_, 3 * D_, G, (int)blockIdx.x);
                    rstd_table(lds, (const float*)(w + WS_SSQ), S, wave0);
                    EpiQKV E{(bf16*)(w + WS_BIG), (LAS const float*)(lds + RSTD_OFF), (float*)(w + WS_KPART)};
                    pg8::gemm_phase<EpiQKV, pg8::StaticOrder, PG8_ALIGN, PG8_SP2>(lds, g, S, E, wave0);
                    GRID_BAR();
                }
                for (int rep = 0; rep < NREP(1); ++rep) {
                    for (int r2 = 0; r2 < NREP(7); ++r2) { unsigned char* w = WSL(); phase_gate((const bf16*)(w + WS_BIG), (const float*)(w + WS_KPART), (unsigned*)(w + WS_SEL), (float*)(w + WS_QN2), (unsigned*)(w + WS_WFFN + (size_t)(mi == 0 ? 4 : 2) * WFFN_STRIDE), (gu32*)(w + WS_CTL) + CW_LC + 1024 * mi, lds, wave0); GRID_BAR(); }
                    for (int r2 = 0; r2 < NREP(8) * NREP(18) * NREP(28) * NREP(29); ++r2) { unsigned char* w = WSL(); bf16* B = (bf16*)(w + WS_BIG);
                      phase_attn_sel(B, B + (size_t)S_ * D_, B + (size_t)2 * S_ * D_, (const unsigned*)(w + WS_WFFN + (size_t)(mi == 0 ? 4 : 2) * WFFN_STRIDE), (const gu32*)(w + WS_CTL) + CW_LC + 1024 * mi, (const float*)(w + WS_QN2), (bf16*)(w + WS_WFFN + (size_t)(mi == 0 ? 2 : 0) * WFFN_STRIDE), (bf16*)(w + WS_XB + 32 * MiB), (float*)(w + WS_LSE), (gu32*)(w + WS_CTL) + CW_QA + 64 * (mi + 2 * (rep + r2)), lds, wave0, (PROBE == 18 || PROBE == 28 || PROBE == 29) && r2 == 0 && ((const unsigned*)(w + WS_CTL))[2] == 0u);
                      GRID_BAR(); }
                    for (int r2 = 0; r2 < NREP(9); ++r2) { unsigned char* w = WSL(); bf16* B = (bf16*)(w + WS_BIG);
                      phase_attn_own(B, B + (size_t)S_ * D_, B + (size_t)2 * S_ * D_, (const unsigned*)(w + WS_SEL), (const float*)(w + WS_QN2), (const bf16*)(w + WS_WFFN + (size_t)(mi == 0 ? 2 : 0) * WFFN_STRIDE), (const bf16*)(w + WS_XB + 32 * MiB), (const float*)(w + WS_LSE), lds, wave0, (rep + r2 + 1) < NREP(1) * NREP(9));
                      GRID_BAR(); }
                }
                for (int rep = 0; rep < NREP(6); ++rep) {
                    unsigned char* w = WSL();
                    pg8::Gemm g{(const bf16*)(w + WS_BIG), ws_wo(w, mi), S_, D_, D_}; pg8::StaticOrder S; S.init(S_, D_, G, (int)blockIdx.x);
                    EpiResid<false, 2> E{(bf16*)(w + WS_XB), (float*)(w + WS_SSQ), nullptr, nullptr, ((X8_MASK >> (f + 1)) & 1) ? w + WS_X8 : nullptr};
                    pg8::gemm_phase<EpiResid<false, 2>, pg8::StaticOrder, false, PG8_SP2>(lds, g, S, E, wave0);
                    GRID_BAR();
                }
            } else {
                for (int rep = 0; rep < NREP(2); ++rep) {
                    { unsigned char* w = WSL(); phase_pool_elem((const bf16*)(w + WS_XB), (const float*)(w + WS_SSQ), KA()->in[1] + (L * 3 + 1) * D_, (bf16*)(w + WS_BIG), (const bf16*)(w + WS_HALO), lds, wave0); }
                    {
                        unsigned char* w = WSL();
                        pg8::Gemm g{(const bf16*)(w + WS_BIG), ws_wp(w, mi), 4 * S_, 256, 256}; PoolOrder S{G, (int)blockIdx.x};
                        if ((X8_MASK >> (f + 1)) & 1) { EpiResid<true, 2, true> E{(bf16*)(w + WS_XB), (float*)(w + WS_SSQB), KA()->in[8] + mi * D_, nullptr, w + WS_X8};
                            pg8::gemm_phase<EpiResid<true, 2, true>, PoolOrder, false, PG8_SP2>(lds, g, S, E, wave0); }
                        else { EpiResid<true, 2, false> E{(bf16*)(w + WS_XB), (float*)(w + WS_SSQB), KA()->in[8] + mi * D_, nullptr, nullptr};
                            pg8::gemm_phase<EpiResid<true, 2, false>, PoolOrder, false, PG8_SP2>(lds, g, S, E, wave0); }
                    }
                    GRID_BAR();
                }
            }
        }
    }
    { Ptrs P2 = make_ptrs(KA()); const bool poison = (__hip_atomic_load((gu32*)(P2.ws + WS_CTL) + CW_BAR + XB_TMO, RLX_AGENT) != 0u) || (G != 256);
      phase_final(P2, poison, wave0); }
}

extern "C" void kernel_launch(void* const* d_in, const int* in_sizes, int n_in, void* d_out, int out_size, void* d_ws, size_t ws_size, hipStream_t stream) {
    static int grid = 0;
    if (grid == 0) {
        if (n_in != 10 || in_sizes[0] != S_ * D_ || out_size != S_ * D_ || ws_size < WS_END) { fprintf(stderr, "kernel_launch: unexpected shapes / workspace (%zu < %zu)\n", ws_size, (size_t)WS_END); grid = -1; return; }
        int dev = 0, cus = 0, per_cu = 0;
        if (hipGetDevice(&dev) != hipSuccess || hipDeviceGetAttribute(&cus, hipDeviceAttributeMultiprocessorCount, dev) != hipSuccess) { grid = -1; return; }
        if (hipFuncSetAttribute((const void*)mk_fwd, hipFuncAttributeMaxDynamicSharedMemorySize, LDS_BYTES) != hipSuccess) { fprintf(stderr, "kernel_launch: hipFuncSetAttribute failed\n"); grid = -1; return; }
        if (hipOccupancyMaxActiveBlocksPerMultiprocessor(&per_cu, (const void*)mk_fwd, NWAVES * 64, LDS_BYTES) != hipSuccess || per_cu < 1) { fprintf(stderr, "kernel_launch: occupancy query says %d\n", per_cu); }
        (void)hipGetLastError();
        grid = cus;
    }
    if (grid < 0) return;
    if (hipMemsetAsync((char*)d_ws + WS_CTL, 0, CTL_ZERO_BYTES, stream) != hipSuccess) return;
    Args a{};
    for (int i = 0; i < 10; ++i) a.in[i] = (const float*)d_in[i];
    a.out = (float*)d_out; a.ws = (unsigned char*)d_ws;
    hipLaunchKernelGGL(mk_fwd, dim3(grid), dim3(NWAVES * 64), LDS_BYTES, stream, a);
}
```
